# Optimizing an MI355X kernel written in HIP

```python
import math
import jax, jax.numpy as jnp
from jax import lax
import numpy as np

D_MODEL = 1024
BATCH = 8
SEQ = 2048
DEPTH = 4

RMS_EPS = 1e-6
NEG_INF = -1e30

MLA_HEADS = 16
MLA_Q_LORA = 512
MLA_KV_LORA = 256
MLA_NOPE = 64
MLA_ROPE = 32
MLA_V = 64
MLA_ROPE_THETA = 10000.0
ATTN_BLOCK = 128

DIL_PATTERN = ((128, 1), (512, 4), (2048, 16))
DIL_GROUPS = 3
DIL_HEADS = 4
DIL_HEAD_DIM = 64
ROPE_THETA = 500000.0
PARTIAL_ROT = DIL_HEAD_DIM // 4

MLA_COLS = MLA_Q_LORA + MLA_KV_LORA + MLA_ROPE
DIL_COLS = DIL_GROUPS * 3 * DIL_HEADS * DIL_HEAD_DIM
GATE_COLS = 2 * D_MODEL
IN_COLS = MLA_COLS + DIL_COLS + GATE_COLS
MLA_OUT = MLA_HEADS * MLA_V
DIL_OUT = DIL_HEADS * DIL_HEAD_DIM

N_GROUPS = 8
EXPERTS_PER_GROUP = 8
N_EXPERTS = N_GROUPS * EXPERTS_PER_GROUP
TOP_K = 2
EXPERT_FF = 256
EXPERT_BLOCK = 128

PLE_DIM = 256

kernel_name = 'hybrid_mla_dilated_hmoe_block'


def rms_norm(x, g):
    xf = x.astype(jnp.float32)
    y = xf * lax.rsqrt(jnp.mean(xf * xf, axis=-1, keepdims=True) + RMS_EPS)
    return (y * g.astype(jnp.float32)).astype(x.dtype)


def apply_rope(x, pos, theta, rot_dim):
    half = rot_dim // 2
    inv = jnp.float32(theta) ** (-jnp.arange(half, dtype=jnp.float32) * 2.0 / rot_dim)
    ang = pos.astype(jnp.float32)[..., None] * inv
    cos = jnp.cos(ang)[:, :, None, :].astype(x.dtype)
    sin = jnp.sin(ang)[:, :, None, :].astype(x.dtype)
    x1 = x[..., :half]
    x2 = x[..., half:rot_dim]
    return jnp.concatenate([x1 * cos - x2 * sin, x1 * sin + x2 * cos, x[..., rot_dim:]], axis=-1)


def causal_block_attention(q, k, v, scale):
    B, S, H, Dq = q.shape
    Dv = v.shape[-1]
    nb = S // ATTN_BLOCK
    qb = q.reshape(B, nb, ATTN_BLOCK, H, Dq).transpose(1, 0, 2, 3, 4)
    kpos = jnp.arange(S)

    def one_block(args):
        qi, b = args
        s = jnp.einsum('bqhd,bkhd->bhqk', qi, k).astype(jnp.float32) * scale
        qpos = b * ATTN_BLOCK + jnp.arange(ATTN_BLOCK)
        s = jnp.where(kpos[None, :] <= qpos[:, None], s, NEG_INF)
        pr = jax.nn.softmax(s, axis=-1).astype(v.dtype)
        return jnp.einsum('bhqk,bkhd->bqhd', pr, v)

    out = lax.map(one_block, (qb, jnp.arange(nb)))
    return out.transpose(1, 0, 2, 3, 4).reshape(B, S, H, Dv)


def dilated_window_attention(q, k, v, dilation, window):
    B, S, H, Dh = q.shape
    nback = window // dilation
    L = S // dilation
    nb = -(-L // nback)
    Lp = nb * nback

    def to_blocks(t):
        t = t.reshape(B, L, dilation, H, Dh).transpose(0, 2, 1, 3, 4)
        t = jnp.pad(t, ((0, 0), (0, 0), (0, Lp - L), (0, 0), (0, 0)))
        return t.reshape(B, dilation, nb, nback, H, Dh)

    def with_prev(t):
        prev = jnp.pad(t[:, :, :-1], ((0, 0), (0, 0), (1, 0), (0, 0), (0, 0), (0, 0)))
        return jnp.concatenate([prev, t], axis=3)

    qb = to_blocks(q)
    kk = with_prev(to_blocks(k))
    vv = with_prev(to_blocks(v))
    s = jnp.einsum('brnqhd,brnkhd->brnhqk', qb, kk).astype(jnp.float32) * (Dh ** -0.5)
    qi = jnp.arange(nback)[:, None]
    kj = jnp.arange(2 * nback)[None, :]
    band = (kj >= qi) & (kj <= qi + nback)
    has_prev = jnp.arange(nb)[:, None, None] > 0
    mask = band[None] & (has_prev | (kj >= nback)[None])
    s = jnp.where(mask[None, None, :, None], s, NEG_INF)
    m = jnp.max(s, axis=-1, keepdims=True)
    e = jnp.exp(s - m)
    den = jnp.sum(e, axis=-1, keepdims=True)
    o = jnp.einsum('brnhqk,brnkhd->brnqhd', (e / den).astype(v.dtype), vv)
    lse = (m + jnp.log(den))[..., 0]
    o = o.reshape(B, dilation, Lp, H, Dh)[:, :, :L].transpose(0, 2, 1, 3, 4).reshape(B, S, H, Dh)
    lse = lse.transpose(0, 1, 2, 4, 3).reshape(B, dilation, Lp, H)[:, :, :L]
    lse = lse.transpose(0, 2, 1, 3).reshape(B, S, H)
    return o, lse


def routed_expert_ffn(hf, expert_idx, gate_w, w1, w3, w2):
    T, D = hf.shape
    A = T * TOP_K
    flat_e = expert_idx.reshape(A)
    flat_tok = jnp.arange(A, dtype=jnp.int32) // TOP_K
    flat_w = gate_w.reshape(A)
    order = jnp.argsort(flat_e)
    e_s = flat_e[order]
    tok_s = flat_tok[order]
    w_s = flat_w[order]
    counts = jnp.bincount(flat_e, length=N_EXPERTS)
    starts = jnp.cumsum(counts) - counts
    pcounts = (counts + EXPERT_BLOCK - 1) // EXPERT_BLOCK * EXPERT_BLOCK
    pends = jnp.cumsum(pcounts)
    pstarts = pends - pcounts
    dest = pstarts[e_s] + (jnp.arange(A, dtype=jnp.int32) - starts[e_s])
    n_blocks = -(-A // EXPERT_BLOCK) + N_EXPERTS
    n_rows = n_blocks * EXPERT_BLOCK
    row_tok = jnp.zeros((n_rows,), jnp.int32).at[dest].set(tok_s)
    xs = hf[row_tok].reshape(n_blocks, EXPERT_BLOCK, D)
    block_e = jnp.minimum(jnp.searchsorted(pends, jnp.arange(n_blocks) * EXPERT_BLOCK, side='right'), N_EXPERTS - 1)

    def one_block(args):
        xb, e = args
        return (jax.nn.silu(xb @ w1[e]) * (xb @ w3[e])) @ w2[e]

    ys = lax.map(one_block, (xs, block_e)).reshape(n_rows, D)
    contrib = ys[dest] * w_s[:, None].astype(hf.dtype)
    return jnp.zeros_like(hf).at[tok_s].add(contrib)


def hier_moe(h, w_grp, b_grp, w_exp, b_exp, w1, w3, w2):
    B, S, D = h.shape
    T = B * S
    hf = h.reshape(T, D)
    g_logits = (hf @ w_grp).astype(jnp.float32) + b_grp.astype(jnp.float32)
    g_prob = jax.nn.softmax(g_logits, axis=-1)
    g_sel = jnp.argmax(g_logits, axis=-1).astype(jnp.int32)
    e_logits = (hf @ w_exp).astype(jnp.float32).reshape(T, N_GROUPS, EXPERTS_PER_GROUP) + b_exp.astype(jnp.float32)
    idx = jnp.broadcast_to(g_sel[:, None, None], (T, 1, EXPERTS_PER_GROUP))
    e_in = jnp.take_along_axis(e_logits, idx, axis=1)[:, 0]
    top_v, top_i = lax.top_k(e_in, TOP_K)
    p_g = jnp.take_along_axis(g_prob, g_sel[:, None], axis=1)
    gate_w = jax.nn.softmax(top_v, axis=-1) * p_g
    expert_idx = g_sel[:, None] * EXPERTS_PER_GROUP + top_i.astype(jnp.int32)
    return routed_expert_ffn(hf, expert_idx, gate_w, w1, w3, w2).reshape(B, S, D)


def setup_inputs(seed: int = 0) -> dict:
    key = jax.random.key(seed)
    ks = jax.random.split(key, 32)
    f32 = jnp.float32

    def w(k, shape, fan_in):
        return jax.random.normal(k, shape, f32) * (fan_in ** -0.5)

    def gain(k, shape):
        return 1.0 + 0.02 * jax.random.normal(k, shape, f32)

    return {
        'x': jax.random.normal(ks[0], (BATCH, SEQ, D_MODEL), f32),
        'p': jax.random.normal(ks[1], (DEPTH, BATCH, SEQ, PLE_DIM), f32),
        'positions': jnp.broadcast_to(jnp.arange(SEQ, dtype=jnp.int32), (BATCH, SEQ)),
        'g_mix': gain(ks[2], (DEPTH, D_MODEL)),
        'w_in': w(ks[3], (DEPTH, D_MODEL, IN_COLS), D_MODEL),
        'g_q_lat': gain(ks[4], (DEPTH, MLA_Q_LORA)),
        'w_q_up': w(ks[5], (DEPTH, MLA_Q_LORA, MLA_HEADS * (MLA_NOPE + MLA_ROPE)), MLA_Q_LORA),
        'g_kv_lat': gain(ks[6], (DEPTH, MLA_KV_LORA)),
        'w_kv_up': w(ks[7], (DEPTH, MLA_KV_LORA, MLA_HEADS * (MLA_NOPE + MLA_V)), MLA_KV_LORA),
        'w_branch_a': w(ks[8], (DEPTH, MLA_OUT, D_MODEL), MLA_OUT),
        'w_branch_b': w(ks[9], (DEPTH, DIL_OUT, D_MODEL), DIL_OUT),
        'w_out': w(ks[10], (DEPTH, D_MODEL, D_MODEL), D_MODEL),
        'g_ffn': gain(ks[11], (DEPTH, D_MODEL)),
        'w_router_grp': w(ks[12], (DEPTH, D_MODEL, N_GROUPS), D_MODEL),
        'b_router_grp': 0.01 * jax.random.normal(ks[13], (DEPTH, N_GROUPS), f32),
        'w_router_exp': w(ks[14], (DEPTH, D_MODEL, N_EXPERTS), D_MODEL),
        'b_router_exp': 0.01 * jax.random.normal(ks[15], (DEPTH, N_GROUPS, EXPERTS_PER_GROUP), f32),
        'w_exp_gate': w(ks[16], (DEPTH, N_EXPERTS, D_MODEL, EXPERT_FF), D_MODEL),
        'w_exp_up': w(ks[17], (DEPTH, N_EXPERTS, D_MODEL, EXPERT_FF), D_MODEL),
        'w_exp_down': w(ks[18], (DEPTH, N_EXPERTS, EXPERT_FF, D_MODEL), EXPERT_FF),
        'g_ple': gain(ks[19], (DEPTH, D_MODEL)),
        'w_ple_gate': w(ks[20], (DEPTH, D_MODEL, D_MODEL), D_MODEL),
        'w_ple_proj': w(ks[21], (DEPTH, PLE_DIM, D_MODEL), PLE_DIM),
        'g_final': gain(ks[22], (D_MODEL,)),
    }


def reference(x, p, positions, g_mix, w_in, g_q_lat, w_q_up, g_kv_lat, w_kv_up, w_branch_a, w_branch_b, w_out, g_ffn, w_router_grp, b_router_grp, w_router_exp, b_router_exp, w_exp_gate, w_exp_up, w_exp_down, g_ple, w_ple_gate, w_ple_proj, g_final):
    B, S, D = x.shape
    splits = [MLA_Q_LORA, MLA_Q_LORA + MLA_KV_LORA, MLA_COLS, MLA_COLS + DIL_COLS]
    for i in range(DEPTH):
        h = rms_norm(x, g_mix[i])
        proj = h @ w_in[i]
        c_q, c_kv, k_pe, dil, gates = jnp.split(proj, splits, axis=-1)

        q = (rms_norm(c_q, g_q_lat[i]) @ w_q_up[i]).reshape(B, S, MLA_HEADS, MLA_NOPE + MLA_ROPE)
        q = jnp.concatenate([q[..., :MLA_NOPE], apply_rope(q[..., MLA_NOPE:], positions, MLA_ROPE_THETA, MLA_ROPE)], axis=-1)
        kv = (rms_norm(c_kv, g_kv_lat[i]) @ w_kv_up[i]).reshape(B, S, MLA_HEADS, MLA_NOPE + MLA_V)
        k_rot = apply_rope(k_pe[:, :, None, :], positions, MLA_ROPE_THETA, MLA_ROPE)
        k = jnp.concatenate([kv[..., :MLA_NOPE], jnp.broadcast_to(k_rot, (B, S, MLA_HEADS, MLA_ROPE))], axis=-1)
        v = kv[..., MLA_NOPE:]
        o_a = causal_block_attention(q, k, v, (MLA_NOPE + MLA_ROPE) ** -0.5).reshape(B, S, MLA_OUT)

        dil = dil.reshape(B, S, DIL_GROUPS, 3, DIL_HEADS, DIL_HEAD_DIM)
        outs = []
        lses = []
        for gi, (win, rate) in enumerate(DIL_PATTERN):
            qg = apply_rope(dil[:, :, gi, 0], positions, ROPE_THETA, PARTIAL_ROT)
            kg = apply_rope(dil[:, :, gi, 1], positions, ROPE_THETA, PARTIAL_ROT)
            o_g, lse_g = dilated_window_attention(qg, kg, dil[:, :, gi, 2], rate, win)
            outs.append(o_g)
            lses.append(lse_g)
        wts = jax.nn.softmax(jnp.stack(lses, axis=0), axis=0)
        o_b = jnp.sum(wts[..., None].astype(x.dtype) * jnp.stack(outs, axis=0), axis=0).reshape(B, S, DIL_OUT)

        g_a, g_b = jnp.split(gates, 2, axis=-1)
        merged = jax.nn.sigmoid(g_a) * (o_a @ w_branch_a[i]) + jax.nn.sigmoid(g_b) * (o_b @ w_branch_b[i])
        x = x + merged @ w_out[i]

        h2 = rms_norm(x, g_ffn[i])
        x = x + hier_moe(h2, w_router_grp[i], b_router_grp[i], w_router_exp[i], b_router_exp[i], w_exp_gate[i], w_exp_up[i], w_exp_down[i])

        e = p[i] @ w_ple_proj[i]
        x = x + jax.nn.sigmoid(rms_norm(x, g_ple[i]) @ w_ple_gate[i]) * e
    return rms_norm(x, g_final)
```

```cpp
#include <hip/hip_runtime.h>
#include <cstdio>
#include <cstdint>

#define LAS __attribute__((address_space(3)))
#define GAS __attribute__((address_space(1)))
#define AS4 __attribute__((address_space(4)))
typedef unsigned short bf16_t;
typedef short bf16x8 __attribute__((ext_vector_type(8)));
typedef float f32x4 __attribute__((ext_vector_type(4)));
typedef float f32x2 __attribute__((ext_vector_type(2)));
typedef unsigned u32x4 __attribute__((ext_vector_type(4)));
typedef unsigned u32x2 __attribute__((ext_vector_type(2)));

#ifndef MK_PER_PHASE
#define MK_PER_PHASE 1
#endif

constexpr int T = 16384, DM = 1024, SEQ = 2048, NBATCH = 8, DEPTH = 4;
constexpr int NIN_SRC = 5152, NIN = 5376;
constexpr int NE = 64;
constexpr int MAXBLK = 192;
constexpr float EPS = 1e-6f;
constexpr int NWAVES = 8, NTHR = 512;

constexpr size_t MiB = 1u << 20, KiB = 1u << 10;
constexpr size_t WS_CTL = 0, CTL_ZERO_BYTES = 2 * MiB;
constexpr int CW_TMO = 0, CW_BAR = 4096;
constexpr size_t CTL_CNT = 128 * KiB;
static_assert(CTL_CNT + 4096 <= CTL_ZERO_BYTES, "ctl");
constexpr size_t WS_ROPE_MLA = 2 * MiB;
constexpr size_t WS_ROPE_DIL = 4 * MiB;
constexpr size_t WS_ROUTE = 5 * MiB;
constexpr size_t RT_TOK_E = WS_ROUTE;
constexpr size_t RT_TOK_W = RT_TOK_E + 128 * KiB;
constexpr size_t RT_TOK_RS = RT_TOK_W + 128 * KiB;
constexpr size_t RT_DEST = RT_TOK_RS + 64 * KiB;
constexpr size_t RT_ROW_TOK = RT_DEST + 128 * KiB;
constexpr size_t RT_ROW_W = RT_ROW_TOK + 192 * KiB;
constexpr size_t RT_ROW_RS = RT_ROW_W + 192 * KiB;
constexpr size_t RT_BLK_E = RT_ROW_RS + 192 * KiB;
static_assert(RT_BLK_E + 1024 <= 8 * MiB, "route");
constexpr size_t WS_WD = 8 * MiB, WD_STRIDE = 21 * MiB;
constexpr size_t WD_IN = 0, WD_Q = 10 * MiB + 512 * KiB, WD_K = 12 * MiB, WD_V = 12 * MiB + 512 * KiB, WD_A = 13 * MiB, WD_B = 15 * MiB,
                 WD_O = 15 * MiB + 512 * KiB, WD_R = 17 * MiB + 512 * KiB, WD_G = 18 * MiB, WD_P = 20 * MiB;
constexpr size_t WS_W13 = 92 * MiB, W13_STRIDE = 64 * MiB;
constexpr size_t WS_W2 = 348 * MiB, W2_STRIDE = 32 * MiB;
constexpr size_t WS_PB = 476 * MiB;
constexpr size_t WS_XB = 508 * MiB, WS_XN = 540 * MiB, WS_CQ = 572 * MiB, WS_CKV = 588 * MiB, WS_KPE = 596 * MiB, WS_Q = 598 * MiB,
                 WS_KN = 646 * MiB, WS_V = 678 * MiB, WS_OA = 710 * MiB, WS_OB = 742 * MiB, WS_TMPB = 750 * MiB, WS_MERGED = 782 * MiB,
                 WS_E = 814 * MiB, WS_RL = 846 * MiB, WS_DIL = 866 * MiB, WS_SG = 938 * MiB, WS_YS = 866 * MiB, WS_H = 962 * MiB,
                 WS_SSQ1 = 1002 * MiB  , WS_SSQ2 = 1007 * MiB  , WS_SSQQ = 1011 * MiB  , WS_SSQKV = 1013 * MiB  , WS_END = 1014 * MiB;

constexpr int RING_BYTES = 131072, LDSCTL_OFF = RING_BYTES, MISC_OFF = LDSCTL_OFF + 320, LDS_BYTES = 147456;

typedef __bf16 bf16x2_t __attribute__((ext_vector_type(2)));
__device__ __forceinline__ unsigned cvt_pk_bf16(float lo, float hi) { f32x2 v = {lo, hi}; bf16x2_t b = __builtin_convertvector(v, bf16x2_t); return __builtin_bit_cast(unsigned, b); }
__device__ __forceinline__ float bf_lo(unsigned w) { return __uint_as_float(w << 16); }
__device__ __forceinline__ float bf_hi(unsigned w) { return __uint_as_float(w & 0xffff0000u); }
__device__ __forceinline__ float sigmoidf_(float x) { return __builtin_amdgcn_rcpf(1.0f + __expf(-x)); }
__device__ __forceinline__ u32x4 pack8(f32x4 a, f32x4 b) { u32x4 w; w.x = cvt_pk_bf16(a[0], a[1]); w.y = cvt_pk_bf16(a[2], a[3]); w.z = cvt_pk_bf16(b[0], b[1]); w.w = cvt_pk_bf16(b[2], b[3]); return w; }
__device__ __forceinline__ void unpack8(u32x4 w, f32x4& a, f32x4& b) { a = (f32x4){bf_lo(w.x), bf_hi(w.x), bf_lo(w.y), bf_hi(w.y)}; b = (f32x4){bf_lo(w.z), bf_hi(w.z), bf_lo(w.w), bf_hi(w.w)}; }
__device__ __forceinline__ float wave_sum(float v) {
#pragma unroll
    for (int o = 1; o < 64; o <<= 1) v += __shfl_xor(v, o);
    return v;
}
template <int NP> __device__ __forceinline__ float part_sum(const float* p) { float t = 0.f;
#pragma unroll
    for (int i = 0; i < NP / 4; ++i) { const f32x4 a = *(const f32x4*)(p + 4 * i); t += (a[0] + a[1]) + (a[2] + a[3]); }
    return t; }
#define LDS_WAIT() asm volatile("s_waitcnt lgkmcnt(0)" ::: "memory")
#define VM_WAIT() asm volatile("s_waitcnt vmcnt(0)" ::: "memory")

namespace pg8 {
constexpr int BM = 256, BK = 64, HALF = 128, HTB = HALF * BK * 2, NXCD = 8, WGM = 8;
__host__ __device__ __forceinline__ int lds_byte(int r, int c) { const int st = (r >> 4) * 2 + (c >> 5), rr = r & 15, cc = c & 31, ob = rr * 64 + cc * 2; return st * 1024 + (ob ^ (((ob >> 9) & 1) << 5)); }
__host__ __device__ __forceinline__ void stage_rc(int b, int& R, int& C) { const int st = b / 1024, sb = b % 1024, swz = sb ^ (((sb >> 9) & 1) << 5); R = (st >> 1) * 16 + swz / 64; C = (st & 1) * 32 + (swz % 64) / 2; }
__host__ __device__ __forceinline__ int perm32(int rho) { const int n = rho >> 4, i = rho & 15; return 8 * (i >> 2) + 4 * n + (i & 3); }

struct Unit { int pm, pn; unsigned a_off, b_off; };
struct Gemm { const bf16_t* A; const bf16_t* Bt; int lda, ldb, K; const int* gather; };

struct DenseOrder {
    int nM, nN, nwg, G, c, lda, ldb;
    __device__ void init(int nM_, int nN_, int lda_, int ldb_, int G_, int c_) { nM = nM_; nN = nN_; nwg = nM * nN; G = G_; c = c_; lda = lda_; ldb = ldb_; }
    __device__ __forceinline__ bool next(int i, Unit& u) const {
        const long L = (long)i * G + c; if (L >= nwg) return false;
        int wgid = (int)L; { const int q = nwg / NXCD, r = nwg % NXCD, xcd = wgid % NXCD, off = wgid / NXCD; wgid = (xcd < r ? xcd * (q + 1) : r * (q + 1) + (xcd - r) * q) + off; }
        const int nig = WGM * nN, gid = wgid / nig, fm = gid * WGM, gsz = (nM - fm) < WGM ? (nM - fm) : WGM;
        u.pm = fm + ((wgid % nig) % gsz); u.pn = (wgid % nig) / gsz;
        u.a_off = (unsigned)u.pm * 256u * (unsigned)lda; u.b_off = (unsigned)u.pn * 256u * (unsigned)ldb; return true;
    }
};

template <class Epi, class Sched, bool GATHER, bool ALIGN_EPI>
__device__ __forceinline__ void gemm_phase(LAS unsigned char* lds, const Gemm g, const Sched& S, const Epi& E) {
    int tid_ = threadIdx.x; asm volatile("; gemm_phase entry" : "+v"(tid_));
    const int tid = tid_, wid = __builtin_amdgcn_readfirstlane(tid >> 6), lane = tid & 63, wr = wid >> 2, wc = wid & 3, fr = lane & 15, fq = lane >> 4;
    const int K = g.K, nt = K / BK, lda = g.lda, ldb = g.ldb;
    unsigned voffB[2], vAc[2][2], vAn[2][2]; int Rst[2], Cst[2];
#pragma unroll
    for (int i = 0; i < 2; ++i) { int R, C; stage_rc(tid * 16 + i * 8192, R, C); const int Rb = (R & ~31) + perm32(R & 31);
        Rst[i] = R; Cst[i] = C; voffB[i] = (unsigned)(Rb * ldb + C) * 2u;
        vAc[0][i] = (unsigned)(R * lda + C) * 2u; vAc[1][i] = (unsigned)((R + HALF) * lda + C) * 2u; vAn[0][i] = vAc[0][i]; vAn[1][i] = vAc[1][i]; }
    const size_t kstep = (size_t)(BK * 2);
    const size_t hstepB = (size_t)HALF * ldb * 2;
    const unsigned ldsw = (unsigned)wid * 1024u;
    const int aoff = lds_byte(wr * 64 + fr, fq * 8), boff = lds_byte(wc * 32 + fr, fq * 8);
#define PG8_SA(b, h) (((b) * 2 + (h)) * HTB)
#define PG8_SB(b, h) ((4 + (b) * 2 + (h)) * HTB)
#define PG8_STAGE(bufoff, gbase, voff) do { _Pragma("unroll") for (int _i = 0; _i < 2; ++_i) \
        __builtin_amdgcn_global_load_lds((const unsigned*)((const char*)(gbase) + (voff)[_i]), (LAS unsigned*)(lds + (bufoff) + ldsw + _i * 8192), 16, 0, 0); } while (0)
#define PG8_STAGE_A(bufoff, gbase, h, nx) do { _Pragma("unroll") for (int _i = 0; _i < 2; ++_i) \
        __builtin_amdgcn_global_load_lds((const unsigned*)((const char*)(gbase) + ((GATHER && (nx)) ? vAn[h][_i] : vAc[h][_i])), (LAS unsigned*)(lds + (bufoff) + ldsw + _i * 8192), 16, 0, 0); } while (0)
#define PG8_LDA(dst, b, h) do { _Pragma("unroll") for (int m = 0; m < 4; ++m) _Pragma("unroll") for (int k = 0; k < 2; ++k) dst[m][k] = *(const LAS bf16x8*)(lds + PG8_SA(b, h) + aoff + m * 2048 + k * 1024); } while (0)
#define PG8_LDB(dst, b, h) do { _Pragma("unroll") for (int n = 0; n < 2; ++n) _Pragma("unroll") for (int k = 0; k < 2; ++k) dst[n][k] = *(const LAS bf16x8*)(lds + PG8_SB(b, h) + boff + n * 2048 + k * 1024); } while (0)
#define PG8_MMA(ai, bj, At, Bt) do { __builtin_amdgcn_s_setprio(1); _Pragma("unroll") for (int m = 0; m < 4; ++m) _Pragma("unroll") for (int n = 0; n < 2; ++n) _Pragma("unroll") for (int k = 0; k < 2; ++k) \
        acc[ai][bj][m][n] = __builtin_amdgcn_mfma_f32_16x16x32_bf16(Bt[n][k], At[m][k], acc[ai][bj][m][n], 0, 0, 0); __builtin_amdgcn_s_setprio(0); } while (0)
#define PG8_WAIT_V(n) asm volatile("s_waitcnt vmcnt(" #n ")" ::: "memory")
#define PG8_WAIT_L(n) asm volatile("s_waitcnt lgkmcnt(" #n ")" ::: "memory")
#define PG8_BAR __builtin_amdgcn_s_barrier()
#define PG8_SCHED __builtin_amdgcn_sched_barrier(0)
    Unit cur, nxt; int ui = 0;
    if (!S.next(0, cur)) return;
    if constexpr (GATHER) {
#pragma unroll
        for (int h = 0; h < 2; ++h)
#pragma unroll
            for (int i = 0; i < 2; ++i) vAc[h][i] = (unsigned)(g.gather[cur.pm * 256 + h * HALF + Rst[i]] * lda + Cst[i]) * 2u;
    }
    f32x4 acc[2][2][4][2];
#pragma unroll
    for (int a = 0; a < 2; ++a)
#pragma unroll
        for (int b = 0; b < 2; ++b)
#pragma unroll
            for (int m = 0; m < 4; ++m)
#pragma unroll
                for (int n = 0; n < 2; ++n) acc[a][b][m][n] = (f32x4){0.f, 0.f, 0.f, 0.f};
    bf16x8 At[4][2], B0[2][2], B1[2][2];
    const char* cA = (const char*)g.A + (size_t)cur.a_off * 2; const char* cB = (const char*)g.Bt + (size_t)cur.b_off * 2;
    PG8_STAGE(PG8_SB(0, 0), cB, voffB); PG8_STAGE(PG8_SB(0, 1), cB + hstepB, voffB); PG8_STAGE_A(PG8_SA(0, 0), cA, 0, false); PG8_STAGE_A(PG8_SA(0, 1), cA, 1, false);
    if (wr == 1) PG8_BAR;
    PG8_WAIT_V(2); PG8_BAR;
    PG8_STAGE(PG8_SB(1, 0), cB + kstep, voffB); PG8_STAGE_A(PG8_SA(1, 0), cA + kstep, 0, false); PG8_STAGE(PG8_SB(1, 1), cB + hstepB + kstep, voffB);
    PG8_WAIT_V(6); PG8_BAR;
    for (;;) {
        const bool has_next = S.next(ui + 1, nxt);
        const char* nA = has_next ? (const char*)g.A + (size_t)nxt.a_off * 2 : cA; const char* nB = has_next ? (const char*)g.Bt + (size_t)nxt.b_off * 2 : cB;
        if constexpr (GATHER) {
#pragma unroll
            for (int h = 0; h < 2; ++h)
#pragma unroll
                for (int i = 0; i < 2; ++i) vAn[h][i] = has_next ? (unsigned)(g.gather[nxt.pm * 256 + h * HALF + Rst[i]] * lda + Cst[i]) * 2u : vAc[h][i];
        }
#pragma unroll 1
        for (int t = 0; t < nt; t += 2) {
            const bool last = (t == nt - 2);
            const char* a1 = cA + (size_t)(t + 1) * kstep;
            const char* a2 = last ? nA : cA + (size_t)(t + 2) * kstep; const char* b2 = last ? nB : cB + (size_t)(t + 2) * kstep;
            const char* a3 = a2 + kstep; const char* b3 = b2 + kstep;
            PG8_LDB(B0, 0, 0); PG8_LDB(B1, 0, 1); PG8_SCHED; PG8_LDA(At, 0, 0); PG8_STAGE_A(PG8_SA(1, 1), a1, 1, false);
            PG8_WAIT_V(8); PG8_WAIT_L(0); PG8_BAR; PG8_MMA(0, 0, At, B0); PG8_MMA(0, 1, At, B1); PG8_BAR; PG8_SCHED;
            PG8_LDA(At, 0, 1); PG8_STAGE(PG8_SB(0, 0), b2, voffB); PG8_STAGE(PG8_SB(0, 1), b2 + hstepB, voffB); PG8_STAGE_A(PG8_SA(0, 0), a2, 0, last);
            PG8_WAIT_V(8); PG8_WAIT_L(0); PG8_BAR; PG8_MMA(1, 0, At, B0); PG8_MMA(1, 1, At, B1); PG8_BAR; PG8_SCHED;
            PG8_LDB(B0, 1, 0); PG8_LDB(B1, 1, 1); PG8_SCHED; PG8_LDA(At, 1, 0); PG8_STAGE_A(PG8_SA(0, 1), a2, 1, last);
            PG8_WAIT_V(8); PG8_WAIT_L(0); PG8_BAR; PG8_MMA(0, 0, At, B0); PG8_MMA(0, 1, At, B1); PG8_BAR; PG8_SCHED;
            PG8_LDA(At, 1, 1); PG8_STAGE(PG8_SB(1, 0), b3, voffB); PG8_STAGE(PG8_SB(1, 1), b3 + hstepB, voffB); PG8_STAGE_A(PG8_SA(1, 0), a3, 0, last);
            PG8_WAIT_V(8); PG8_WAIT_L(0); PG8_BAR; PG8_MMA(1, 0, At, B0); PG8_MMA(1, 1, At, B1); PG8_BAR; PG8_SCHED;
        }
        if constexpr (ALIGN_EPI) { if (wr == 0) PG8_BAR; }
        { int fr_ = fr, fq_ = fq, wr_ = wr, wc_ = wc; asm volatile("; epilogue entry" : "+v"(fr_), "+v"(fq_)); asm volatile("" : "+s"(wr_), "+s"(wc_));
          E(acc, cur, wr_, wc_, fr_, fq_); }
        if (!has_next) break;
#pragma unroll
        for (int a = 0; a < 2; ++a)
#pragma unroll
            for (int b = 0; b < 2; ++b)
#pragma unroll
                for (int m = 0; m < 4; ++m)
#pragma unroll
                    for (int n = 0; n < 2; ++n) acc[a][b][m][n] = (f32x4){0.f, 0.f, 0.f, 0.f};
        cur = nxt; cA = nA; cB = nB; ++ui;
        if constexpr (GATHER) {
#pragma unroll
            for (int h = 0; h < 2; ++h)
#pragma unroll
                for (int i = 0; i < 2; ++i) vAc[h][i] = vAn[h][i];
        }
        if constexpr (ALIGN_EPI) { if (wr == 1) PG8_BAR; }
    }
    PG8_WAIT_V(0);
    if constexpr (!ALIGN_EPI) { if (wr == 0) PG8_BAR; }
    PG8_BAR;
#undef PG8_SA
#undef PG8_SB
#undef PG8_STAGE
#undef PG8_STAGE_A
#undef PG8_LDA
#undef PG8_LDB
#undef PG8_MMA
#undef PG8_WAIT_V
#undef PG8_WAIT_L
#undef PG8_BAR
#undef PG8_SCHED
}
}
using pg8::Unit;

#define XB_TMO      128
#define XB_XCNT(j)  (256  + 64 * (j))
#define XB_XSUB(j)  (1280 + 64 * (j))
#define XB_XGEN(j)  (2304 + 64 * (j))
#define XB_TOP      3328
#define XB_TOPGEN   3392
#define XCD_BAR_WORDS 3456
#define XB_SPIN_CAP (1u << 18)
__device__ __forceinline__ unsigned xb_ld(unsigned* p)              { return __hip_atomic_load(p, __ATOMIC_RELAXED, __HIP_MEMORY_SCOPE_AGENT); }
__device__ __forceinline__ unsigned xb_add(unsigned* p, unsigned v) { return __hip_atomic_fetch_add(p, v, __ATOMIC_RELAXED, __HIP_MEMORY_SCOPE_AGENT); }
__device__ __forceinline__ unsigned xb_xcc_id() { return (unsigned)__builtin_amdgcn_s_getreg((3 << 11) | 20) & 0xFu; }
#define XB_SPIN(cond, bar) do { unsigned _sp = 0; while (cond) { __builtin_amdgcn_s_sleep(1); \
    if ((++_sp & 255u) == 0u) { if (xb_ld(&(bar)[XB_TMO])) break; if (_sp > XB_SPIN_CAP) { atomicAdd(&(bar)[XB_TMO], 1u); break; } } } } while (0)
struct XcdBarrier { unsigned* bar; unsigned x; volatile LAS unsigned* st; };
__device__ __forceinline__ XcdBarrier xcd_barrier_post(unsigned* bar, volatile LAS unsigned* st) {
    XcdBarrier b; b.bar = bar; b.x = xb_xcc_id(); b.st = st;
    if (threadIdx.x == 0) (void)xb_add(&bar[XB_XCNT(b.x)], 1u);
    return b;
}
__device__ __forceinline__ void xcd_barrier_complete(unsigned* bar, unsigned x, unsigned& nloc, unsigned& nx) {
    const unsigned G = gridDim.x * gridDim.y * gridDim.z;
    unsigned sum, cnt, mine, sp = 0u;
    for (;;) {
        sum = 0u; cnt = 0u; mine = 0u;
#pragma unroll
        for (unsigned j = 0; j < 16; ++j) { const unsigned c = xb_ld(&bar[XB_XCNT(j)]); sum += c; cnt += (c > 0u) ? 1u : 0u; mine = (j == x) ? c : mine; }
        if (sum == G) break;
        __builtin_amdgcn_s_sleep(1);
        if ((++sp & 255u) == 0u) { if (xb_ld(&bar[XB_TMO])) break; if (sp > XB_SPIN_CAP) { atomicAdd(&bar[XB_TMO], 1u); break; } }
    }
    nloc = mine > 0u ? mine : 1u; nx = cnt > 0u ? cnt : 1u;
}
__device__ __forceinline__ void xcd_barrier(const XcdBarrier& b) {
    asm volatile("s_waitcnt vmcnt(0)" ::: "memory");
    __syncthreads();
    if (threadIdx.x == 0) {
        unsigned* bar = b.bar;
        __builtin_amdgcn_s_waitcnt(0);
        unsigned nloc = b.st[0], nx = b.st[1];
        if (nloc == 0u) { xcd_barrier_complete(bar, b.x, nloc, nx); b.st[0] = nloc; b.st[1] = nx; }
        const unsigned old = xb_add(&bar[XB_XSUB(b.x)], 1u);
        const unsigned gen = old / nloc;
        if (old + 1u == (gen + 1u) * nloc) {
            __builtin_amdgcn_fence(__ATOMIC_RELEASE, "agent");
            asm volatile("s_waitcnt vmcnt(0)" ::: "memory");
            const unsigned og = xb_add(&bar[XB_TOP], 1u);
            const unsigned tg = og / nx;
            if (og + 1u == (tg + 1u) * nx) xb_add(&bar[XB_TOPGEN], 1u);
            else XB_SPIN(xb_ld(&bar[XB_TOPGEN]) == tg, bar);
            __builtin_amdgcn_fence(__ATOMIC_ACQUIRE, "agent");
            xb_add(&bar[XB_XGEN(b.x)], 1u);
            asm volatile("s_waitcnt vmcnt(0)" ::: "memory");
        } else {
            XB_SPIN(xb_ld(&bar[XB_XGEN(b.x)]) == gen, bar);
            __builtin_amdgcn_fence(__ATOMIC_ACQUIRE, "agent");
            asm volatile("s_waitcnt vmcnt(0)" ::: "memory");
        }
    }
    __syncthreads();
}

struct Args { const void* in[24]; float* out; unsigned char* ws; int ph_lo, ph_hi; };

struct Frame {
    LAS unsigned char* lds;
    int tid, lane, wave, vcu, G;
    unsigned char* ws;
    float* X;
};

#define EPI_ROW(ai, m) (u.pm * 256 + (ai) * 128 + wr * 64 + (m) * 16 + fr)
#define EPI_FOR_ROWS _Pragma("unroll") for (int ai = 0; ai < 2; ++ai) _Pragma("unroll") for (int m = 0; m < 4; ++m)

struct EpiInProj {
    const float* ssq_x; bf16_t *CQ, *CKV, *KPE, *DIL, *SG; float *ssq_q, *ssq_kv; const f32x2* rope_dil; const f32x2* rope_mla;
    __device__ __forceinline__ void operator()(const f32x4 (&acc)[2][2][4][2], const Unit& u, int wr, int wc, int fr, int fq) const {
        const int pn = u.pn;
        if (pn < 3) {
            bf16_t* dst = pn < 2 ? CQ : CKV; const int ld = pn < 2 ? 512 : 256; const int cb = (pn == 1 ? 256 : 0) + wc * 32 + 8 * fq; float* sq = pn < 2 ? ssq_q : ssq_kv;
            EPI_FOR_ROWS { const int row = EPI_ROW(ai, m); const float rs = rsqrtf(part_sum<16>(ssq_x + (size_t)row * 16) * (1.0f / 1024.0f) + EPS); float s = 0.f;
#pragma unroll
                for (int bj = 0; bj < 2; ++bj) { const f32x4 v0 = acc[ai][bj][m][0] * rs, v1 = acc[ai][bj][m][1] * rs;
                    s += (v0[0] * v0[0] + v0[1] * v0[1]) + (v0[2] * v0[2] + v0[3] * v0[3]) + (v1[0] * v1[0] + v1[1] * v1[1]) + (v1[2] * v1[2] + v1[3] * v1[3]);
                    *(u32x4*)(dst + (size_t)row * ld + cb + bj * 128) = pack8(v0, v1); }
                s += __shfl_xor(s, 16); s += __shfl_xor(s, 32);
                if (fq == 0) { if (pn < 2) sq[(size_t)row * 8 + pn * 4 + wc] = s; else sq[(size_t)row * 4 + wc] = s; } }
        } else if (pn < 12) {
            const int t = pn - 3, kind = t % 3; const bool rope = (kind < 2) && ((wc & 1) == 0); const float sgn = fq == 0 ? -1.f : 1.f;
            const int cb = t * 256 + wc * 32 + 8 * fq;
            EPI_FOR_ROWS { const int row = EPI_ROW(ai, m); const float rs = rsqrtf(part_sum<16>(ssq_x + (size_t)row * 16) * (1.0f / 1024.0f) + EPS);
                f32x4 cs[4];
                if (rope) {
#pragma unroll
                    for (int j = 0; j < 4; ++j) cs[j] = *(const f32x4*)(rope_dil + (size_t)row * 8 + 2 * j);
                }
#pragma unroll
                for (int bj = 0; bj < 2; ++bj) { f32x4 v[2] = {acc[ai][bj][m][0] * rs, acc[ai][bj][m][1] * rs};
                    if (rope) {
#pragma unroll
                        for (int n = 0; n < 2; ++n)
#pragma unroll
                            for (int e = 0; e < 4; ++e) { const int j = 4 * n + e; const float c = cs[j >> 1][(j & 1) * 2], sn = cs[j >> 1][(j & 1) * 2 + 1];
                                const float mine = v[n][e], oth = __shfl_xor(mine, 16) * sgn;
                                const float r = mine * c + oth * sn; v[n][e] = fq < 2 ? r : mine; }
                    }
                    *(u32x4*)(DIL + (size_t)row * 2304 + cb + bj * 128) = pack8(v[0], v[1]); } }
        } else if (pn < 20) {
            const int cb = (pn - 12) * 256 + wc * 32 + 8 * fq;
            EPI_FOR_ROWS { const int row = EPI_ROW(ai, m); const float rs = rsqrtf(part_sum<16>(ssq_x + (size_t)row * 16) * (1.0f / 1024.0f) + EPS);
#pragma unroll
                for (int bj = 0; bj < 2; ++bj) { f32x4 v0 = acc[ai][bj][m][0] * rs, v1 = acc[ai][bj][m][1] * rs;
#ifdef EXP_D
                    v0 = acc[ai][bj][m][0] * 0.f + rs; v1 = acc[ai][bj][m][1] * 0.f + rs;
#else
#pragma unroll
                    for (int e = 0; e < 4; ++e) { v0[e] = sigmoidf_(v0[e]); v1[e] = sigmoidf_(v1[e]); }
#endif
                    *(u32x4*)(SG + (size_t)row * 2048 + cb + bj * 128) = pack8(v0, v1); } }
        } else {
            if (wc == 0) {
                EPI_FOR_ROWS { const int row = EPI_ROW(ai, m); const float rs = rsqrtf(part_sum<16>(ssq_x + (size_t)row * 16) * (1.0f / 1024.0f) + EPS);
                    f32x4 v[2] = {acc[ai][0][m][0] * rs, acc[ai][0][m][1] * rs};
                    const int jb = 8 * (fq & 1);
#pragma unroll
                    for (int n = 0; n < 2; ++n) { const f32x4 c01 = *(const f32x4*)(rope_mla + (size_t)row * 16 + jb + 4 * n), c23 = *(const f32x4*)(rope_mla + (size_t)row * 16 + jb + 4 * n + 2);
#pragma unroll
                        for (int e = 0; e < 4; ++e) { const float c = e < 2 ? c01[e * 2] : c23[(e - 2) * 2], sn = e < 2 ? c01[e * 2 + 1] : c23[(e - 2) * 2 + 1];
                            const float mine = v[n][e], oth = __shfl_xor(mine, 32);
                            v[n][e] = fq < 2 ? mine * c - oth * sn : oth * sn + mine * c; } }
                    *(u32x4*)(KPE + (size_t)row * 32 + 8 * fq) = pack8(v[0], v[1]); }
            }
        }
    }
};

struct EpiQup {
    const float* ssq_q; bf16_t* Q; const f32x2* rope_mla;
    __device__ __forceinline__ void operator()(const f32x4 (&acc)[2][2][4][2], const Unit& u, int wr, int wc, int fr, int fq) const {
        EPI_FOR_ROWS { const int row = EPI_ROW(ai, m); const float rs = rsqrtf(part_sum<8>(ssq_q + (size_t)row * 8) * (1.0f / 512.0f) + EPS);
#pragma unroll
            for (int bj = 0; bj < 2; ++bj) { const int cg = u.pn * 8 + bj * 4 + wc; const bool rope = (cg % 3) == 2;
                f32x4 v[2] = {acc[ai][bj][m][0] * rs, acc[ai][bj][m][1] * rs};
                if (rope) { const int jb = 8 * (fq & 1);
#pragma unroll
                    for (int n = 0; n < 2; ++n) { const f32x4 c01 = *(const f32x4*)(rope_mla + (size_t)row * 16 + jb + 4 * n), c23 = *(const f32x4*)(rope_mla + (size_t)row * 16 + jb + 4 * n + 2);
#pragma unroll
                        for (int e = 0; e < 4; ++e) { const float c = e < 2 ? c01[e * 2] : c23[(e - 2) * 2], sn = e < 2 ? c01[e * 2 + 1] : c23[(e - 2) * 2 + 1];
                            const float mine = v[n][e], oth = __shfl_xor(mine, 32);
                            v[n][e] = fq < 2 ? mine * c - oth * sn : oth * sn + mine * c; } } }
                *(u32x4*)(Q + (size_t)row * 1536 + u.pn * 256 + bj * 128 + wc * 32 + 8 * fq) = pack8(v[0], v[1]); } }
    }
};

struct EpiScaleStore {
    const float* ssq; float inv_n; bf16_t* O; int ld;
    __device__ __forceinline__ void operator()(const f32x4 (&acc)[2][2][4][2], const Unit& u, int wr, int wc, int fr, int fq) const {
        EPI_FOR_ROWS { const int row = EPI_ROW(ai, m); const float rs = ssq ? rsqrtf(part_sum<4>(ssq + (size_t)row * 4) * inv_n + EPS) : 1.0f;
#pragma unroll
            for (int bj = 0; bj < 2; ++bj) *(u32x4*)(O + (size_t)row * ld + u.pn * 256 + bj * 128 + wc * 32 + 8 * fq) = pack8(acc[ai][bj][m][0] * rs, acc[ai][bj][m][1] * rs); }
    }
};

template <int MODE> struct EpiGate {
    const bf16_t* G; int goff; const bf16_t* ADD; bf16_t* O;
    __device__ __forceinline__ void operator()(const f32x4 (&acc)[2][2][4][2], const Unit& u, int wr, int wc, int fr, int fq) const {
        EPI_FOR_ROWS { const int row = EPI_ROW(ai, m);
#pragma unroll
            for (int bj = 0; bj < 2; ++bj) { const int col = u.pn * 256 + bj * 128 + wc * 32 + 8 * fq;
                f32x4 g0, g1; unpack8(*(const u32x4*)(G + (size_t)row * 2048 + goff + col), g0, g1);
                f32x4 v0 = acc[ai][bj][m][0] * g0, v1 = acc[ai][bj][m][1] * g1;
                if (MODE == 1) { f32x4 a0, a1; unpack8(*(const u32x4*)(ADD + (size_t)row * 1024 + col), a0, a1); v0 += a0; v1 += a1; }
                *(u32x4*)(O + (size_t)row * 1024 + col) = pack8(v0, v1); } }
    }
};

template <int MODE> struct EpiResid {
    float* X; bf16_t* XB; float* ssq; const bf16_t* Eb;
    __device__ __forceinline__ void operator()(const f32x4 (&acc)[2][2][4][2], const Unit& u, int wr, int wc, int fr, int fq) const {
        EPI_FOR_ROWS { const int row = EPI_ROW(ai, m); float s = 0.f;
#pragma unroll
            for (int bj = 0; bj < 2; ++bj) { const int col = u.pn * 256 + bj * 128 + wc * 32 + 8 * fq;
                float* xp = X + (size_t)row * 1024 + col;
                f32x4 x0 = *(const f32x4*)xp, x1 = *(const f32x4*)(xp + 4);
                f32x4 d0 = acc[ai][bj][m][0], d1 = acc[ai][bj][m][1];
                if (MODE == 1) { f32x4 e0, e1; unpack8(*(const u32x4*)(Eb + (size_t)row * 1024 + col), e0, e1);
#pragma unroll
                    for (int e = 0; e < 4; ++e) { d0[e] = sigmoidf_(d0[e]) * e0[e]; d1[e] = sigmoidf_(d1[e]) * e1[e]; } }
                x0 += d0; x1 += d1;
                *(f32x4*)xp = x0; *(f32x4*)(xp + 4) = x1;
                if (XB) *(u32x4*)(XB + (size_t)row * 1024 + col) = pack8(x0, x1);
                s += (x0[0] * x0[0] + x0[1] * x0[1]) + (x0[2] * x0[2] + x0[3] * x0[3]) + (x1[0] * x1[0] + x1[1] * x1[1]) + (x1[2] * x1[2] + x1[3] * x1[3]); }
            s += __shfl_xor(s, 16); s += __shfl_xor(s, 32);
            if (fq == 0) ssq[(size_t)row * 16 + u.pn * 4 + wc] = s; }
    }
};

struct EpiRouter {
    float* RL;
    __device__ __forceinline__ void operator()(const f32x4 (&acc)[2][2][4][2], const Unit& u, int wr, int wc, int fr, int fq) const {
        const int c0 = wc * 32 + 8 * fq;
        if (c0 < 72) {
            EPI_FOR_ROWS { const int row = EPI_ROW(ai, m); float* p = RL + ((size_t)u.pn * T + row) * 72 + c0;
                *(f32x4*)p = acc[ai][0][m][0]; *(f32x4*)(p + 4) = acc[ai][0][m][1]; }
        }
    }
};

struct EpiExp1 {
    const float* row_rs; bf16_t* H;
    __device__ __forceinline__ void operator()(const f32x4 (&acc)[2][2][4][2], const Unit& u, int wr, int wc, int fr, int fq) const {
        EPI_FOR_ROWS { const int row = EPI_ROW(ai, m); const float rs = row_rs[row];
            f32x4 h[2];
#pragma unroll
            for (int n = 0; n < 2; ++n)
#pragma unroll
                for (int e = 0; e < 4; ++e) { const float gt = acc[ai][0][m][n][e] * rs, up = acc[ai][1][m][n][e] * rs; h[n][e] = gt * sigmoidf_(gt) * up; }
            *(u32x4*)(H + (size_t)row * 256 + u.pn * 128 + wc * 32 + 8 * fq) = pack8(h[0], h[1]); }
    }
};
struct EpiExp2 {
    const float* row_w; bf16_t* YS;
    __device__ __forceinline__ void operator()(const f32x4 (&acc)[2][2][4][2], const Unit& u, int wr, int wc, int fr, int fq) const {
        EPI_FOR_ROWS { const int row = EPI_ROW(ai, m); const float w = row_w[row];
#pragma unroll
            for (int bj = 0; bj < 2; ++bj) *(u32x4*)(YS + (size_t)row * 1024 + u.pn * 256 + bj * 128 + wc * 32 + 8 * fq) = pack8(acc[ai][bj][m][0] * w, acc[ai][bj][m][1] * w); }
    }
};

struct RouterOrder {
    int G, c;
    __device__ __forceinline__ bool next(int i, Unit& u) const { const int L = i * G + c; if (L >= 256) return false;
        u.pm = L >> 2; u.pn = L & 3; u.a_off = (unsigned)u.pm * 256u * 1024u + (unsigned)u.pn * 256u; u.b_off = (unsigned)u.pn * 256u; return true; }
};
template <int NJ> struct ExpertOrder {
    const int* blk_e; int G, c;
    __device__ __forceinline__ bool next(int i, Unit& u) const { const int nblk = blk_e[255]; const int L = i * G + c; if (L >= nblk * NJ) return false;
        const int blk = L / NJ, j = L % NJ, e = blk_e[blk]; u.pm = blk; u.pn = j;
        if (NJ == 2) { u.a_off = 0u; u.b_off = (unsigned)(e * 512 + j * 256) * 1024u; } else { u.a_off = (unsigned)blk * 256u * 256u; u.b_off = (unsigned)(e * 1024 + j * 256) * 256u; }
        return true; }
};

__device__ __forceinline__ void tr_item(const float* W, int ldw, int n_src0, const float* g, bf16_t* WT, int K, int n_dst0, int k0, LAS float* scr, int lane) {
#pragma unroll 8
    for (int i = 0; i < 32; ++i) { const int kk = 2 * i + (lane >> 5); float v = W[(size_t)(k0 + kk) * ldw + n_src0 + (lane & 31)]; if (g) v *= g[k0 + kk]; scr[kk * 33 + (lane & 31)] = v; }
    LDS_WAIT(); asm volatile("" ::: "memory");
    const int c = lane & 7;
#pragma unroll
    for (int j = 0; j < 4; ++j) { const int n = (lane >> 3) + 8 * j; const LAS float* s = scr + (8 * c) * 33 + n;
        u32x4 o; o.x = cvt_pk_bf16(s[0 * 33], s[1 * 33]); o.y = cvt_pk_bf16(s[2 * 33], s[3 * 33]); o.z = cvt_pk_bf16(s[4 * 33], s[5 * 33]); o.w = cvt_pk_bf16(s[6 * 33], s[7 * 33]);
        *(u32x4*)(WT + (size_t)(n_dst0 + n) * K + k0 + 8 * c) = o; }
    LDS_WAIT(); asm volatile("" ::: "memory");
}

__device__ __forceinline__ void prologue(Frame& F, const AS4 Args* a) {
    LAS float* scr = (LAS float*)(F.lds + F.wave * 16384);
    const int gw = F.vcu * NWAVES + F.wave, NGW = F.G * NWAVES;
    const float* x = (const float*)a->in[0]; const float* p = (const float*)a->in[1]; const int* pos = (const int*)a->in[2];
    const float* g_mix = (const float*)a->in[3]; const float* w_in = (const float*)a->in[4]; const float* g_q = (const float*)a->in[5]; const float* w_q = (const float*)a->in[6];
    const float* g_kv = (const float*)a->in[7]; const float* w_kv = (const float*)a->in[8]; const float* w_a = (const float*)a->in[9]; const float* w_b = (const float*)a->in[10];
    const float* w_o = (const float*)a->in[11]; const float* g_ffn = (const float*)a->in[12]; const float* w_rg = (const float*)a->in[13]; const float* w_re = (const float*)a->in[15];
    const float* w_eg = (const float*)a->in[17]; const float* w_eu = (const float*)a->in[18]; const float* w_ed = (const float*)a->in[19];
    const float* w_pg = (const float*)a->in[21]; const float* w_pp = (const float*)a->in[22];
    unsigned char* ws = F.ws;
    constexpr int I_IN = 16 * 161, I_Q = 8 * 48, I_KV = 4 * 64, I_A = 16 * 32, I_B = 4 * 32, I_E13 = 64 * 256, I_E2 = 64 * 128;
    constexpr int I_LAYER = I_IN + I_Q + I_KV + I_A + I_B + I_A + I_A + I_B + I_E13 + I_E2;
    for (int it = gw; it < DEPTH * I_LAYER; it += NGW) {
        const int l = it / I_LAYER; int r = it % I_LAYER;
        unsigned char* wd = ws + WS_WD + (size_t)l * WD_STRIDE;
        if (r < I_IN) { const int kb = r / 161, nb = r % 161, ns = nb * 32; const int nd = ns < 768 ? ns : (ns < 800 ? 5120 : ns - 32);
            tr_item(w_in + (size_t)l * 1024 * NIN_SRC, NIN_SRC, ns, g_mix + l * 1024, (bf16_t*)(wd + WD_IN), 1024, nd, kb * 64, scr, F.lane); continue; } r -= I_IN;
        if (r < I_Q) { const int kb = r / 48, nb = r % 48;
            tr_item(w_q + (size_t)l * 512 * 1536, 1536, nb * 32, g_q + l * 512, (bf16_t*)(wd + WD_Q), 512, nb * 32, kb * 64, scr, F.lane); continue; } r -= I_Q;
        if (r < I_KV) { const int kb = r / 64, nb = r % 64, h = nb >> 2, part = nb & 3;
            tr_item(w_kv + (size_t)l * 256 * 2048, 2048, nb * 32, g_kv + l * 256, (bf16_t*)(wd + (part < 2 ? WD_K : WD_V)), 256, h * 64 + (part & 1) * 32, kb * 64, scr, F.lane); continue; } r -= I_KV;
        if (r < I_A) { const int kb = r / 32, nb = r % 32; tr_item(w_a + (size_t)l * 1024 * 1024, 1024, nb * 32, nullptr, (bf16_t*)(wd + WD_A), 1024, nb * 32, kb * 64, scr, F.lane); continue; } r -= I_A;
        if (r < I_B) { const int kb = r / 32, nb = r % 32; tr_item(w_b + (size_t)l * 256 * 1024, 1024, nb * 32, nullptr, (bf16_t*)(wd + WD_B), 256, nb * 32, kb * 64, scr, F.lane); continue; } r -= I_B;
        if (r < I_A) { const int kb = r / 32, nb = r % 32; tr_item(w_o + (size_t)l * 1024 * 1024, 1024, nb * 32, nullptr, (bf16_t*)(wd + WD_O), 1024, nb * 32, kb * 64, scr, F.lane); continue; } r -= I_A;
        if (r < I_A) { const int kb = r / 32, nb = r % 32; tr_item(w_pg + (size_t)l * 1024 * 1024, 1024, nb * 32, nullptr, (bf16_t*)(wd + WD_G), 1024, nb * 32, kb * 64, scr, F.lane); continue; } r -= I_A;
        if (r < I_B) { const int kb = r / 32, nb = r % 32; tr_item(w_pp + (size_t)l * 256 * 1024, 1024, nb * 32, nullptr, (bf16_t*)(wd + WD_P), 256, nb * 32, kb * 64, scr, F.lane); continue; } r -= I_B;
        if (r < I_E13) { const int e = r >> 8, q = r & 255, up = q >> 7, kb = (q & 127) >> 3, nb = q & 7; const int f0 = nb * 32, nd = (f0 >> 7) * 256 + up * 128 + (f0 & 127);
            tr_item((up ? w_eu : w_eg) + ((size_t)l * 64 + e) * 1024 * 256, 256, f0, g_ffn + l * 1024, (bf16_t*)(ws + WS_W13 + (size_t)l * W13_STRIDE) + (size_t)e * 512 * 1024, 1024, nd, kb * 64, scr, F.lane); continue; } r -= I_E13;
        { const int e = r >> 7, q = r & 127, kb = q >> 5, nb = q & 31;
            tr_item(w_ed + ((size_t)l * 64 + e) * 256 * 1024, 1024, nb * 32, nullptr, (bf16_t*)(ws + WS_W2 + (size_t)l * W2_STRIDE) + (size_t)e * 1024 * 256, 256, nb * 32, kb * 64, scr, F.lane); }
    }
    const int gt = F.vcu * NTHR + F.tid, NGT = F.G * NTHR;
    for (int i = gt; i < DEPTH * 256 * 1024; i += NGT) { const int l = i >> 18, n = (i >> 10) & 255, k = i & 1023;
        float v = 0.f; if (n < 8) v = w_rg[((size_t)l * 1024 + k) * 8 + n] * g_ffn[l * 1024 + k]; else if (n < 72) v = w_re[((size_t)l * 1024 + k) * 64 + (n - 8)] * g_ffn[l * 1024 + k];
        ((bf16_t*)(ws + WS_WD + (size_t)l * WD_STRIDE + WD_R))[n * 1024 + k] = (bf16_t)(cvt_pk_bf16(v, 0.f) & 0xffffu); }
    for (int i = gt; i < T * 16; i += NGT) { const int row = i >> 4, j = i & 15; const float inv = exp2f(-(float)j * (1.0f / 16.0f) * 13.287712379549449f);
        const float ang = (float)pos[row] * inv; ((f32x2*)(ws + WS_ROPE_MLA))[i] = (f32x2){cosf(ang), sinf(ang)}; }
    for (int i = gt; i < T * 8; i += NGT) { const int row = i >> 3, j = i & 7; const float inv = exp2f(-(float)j * (1.0f / 8.0f) * 18.931568569324174f);
        const float ang = (float)pos[row] * inv; ((f32x2*)(ws + WS_ROPE_DIL))[i] = (f32x2){cosf(ang), sinf(ang)}; }
    for (size_t i = gt; i < (size_t)DEPTH * T * 256 / 8; i += NGT) { const f32x4 a0 = ((const f32x4*)p)[2 * i], a1 = ((const f32x4*)p)[2 * i + 1]; ((u32x4*)(ws + WS_PB))[i] = pack8(a0, a1); }
    float* ssq1 = (float*)(ws + WS_SSQ1); bf16_t* XB = (bf16_t*)(ws + WS_XB);
    for (int m = gw; m < T; m += NGW) { const f32x4* xr = (const f32x4*)(x + (size_t)m * 1024) + F.lane; f32x4 v[4]; float s = 0.f;
#pragma unroll
        for (int j = 0; j < 4; ++j) { v[j] = xr[64 * j]; s += (v[j][0] * v[j][0] + v[j][1] * v[j][1]) + (v[j][2] * v[j][2] + v[j][3] * v[j][3]); }
        s = wave_sum(s); if (F.lane < 16) ssq1[(size_t)m * 16 + F.lane] = F.lane == 0 ? s : 0.f;
#pragma unroll
        for (int j = 0; j < 4; ++j) { ((f32x4*)(F.X + (size_t)m * 1024))[F.lane + 64 * j] = v[j];
            ((u32x2*)(XB + (size_t)m * 1024))[F.lane + 64 * j] = (u32x2){cvt_pk_bf16(v[j][0], v[j][1]), cvt_pk_bf16(v[j][2], v[j][3])}; } }
}

__device__ __forceinline__ void mla_attn_scalar(Frame& F) {
    unsigned char* ws = F.ws;
    const bf16_t* Q = (const bf16_t*)(ws + WS_Q); const bf16_t* KN = (const bf16_t*)(ws + WS_KN); const bf16_t* KPE = (const bf16_t*)(ws + WS_KPE); const bf16_t* V = (const bf16_t*)(ws + WS_V);
    bf16_t* OA = (bf16_t*)(ws + WS_OA);
    LAS float* Ks = (LAS float*)F.lds; LAS float* Vs = Ks + 32 * 96;
    const float scale = 0.10206207261596575f;
    for (int u = F.vcu; u < 512; u += F.G) {
        const int qc = 3 - (u >> 7), bh = u & 127, b = bh >> 4, h = bh & 15;
        const int tq = qc * 512 + F.tid; const size_t rowq = (size_t)b * SEQ + tq;
        float q[96], o[64];
#pragma unroll
        for (int c = 0; c < 12; ++c) { f32x4 a0, a1; unpack8(*(const u32x4*)(Q + rowq * 1536 + h * 96 + c * 8), a0, a1);
#pragma unroll
            for (int e = 0; e < 4; ++e) { q[c * 8 + e] = a0[e] * scale; q[c * 8 + 4 + e] = a1[e] * scale; } }
#pragma unroll
        for (int d = 0; d < 64; ++d) o[d] = 0.f;
        float mx = -1e30f, l = 0.f;
        const int nkt = (qc * 512 + 512) / 32; const int tq_wmax = qc * 512 + (F.tid | 63);
        for (int kt = 0; kt < nkt; ++kt) {
            __syncthreads();
            for (int c = F.tid; c < 640; c += NTHR) { const int key = c / 20, part = c % 20; const size_t row = (size_t)b * SEQ + kt * 32 + key;
                const bf16_t* src = part < 8 ? KN + row * 1024 + h * 64 + part * 8 : (part < 12 ? KPE + row * 32 + (part - 8) * 8 : V + row * 1024 + h * 64 + (part - 12) * 8);
                LAS float* dst = part < 12 ? Ks + key * 96 + part * 8 : Vs + key * 64 + (part - 12) * 8;
                f32x4 a0, a1; unpack8(*(const u32x4*)src, a0, a1); *(LAS f32x4*)dst = a0; *(LAS f32x4*)(dst + 4) = a1; }
            __syncthreads();
            if (kt * 32 <= tq_wmax) {
                for (int key = 0; key < 32; ++key) { const int kpos = kt * 32 + key; float s = 0.f;
#pragma unroll
                    for (int d = 0; d < 96; d += 4) { const f32x4 kk = *(const LAS f32x4*)(Ks + key * 96 + d); s += q[d] * kk[0] + q[d + 1] * kk[1] + q[d + 2] * kk[2] + q[d + 3] * kk[3]; }
                    if (kpos <= tq) { const float mn = fmaxf(mx, s), al = __expf(mx - mn), pp = __expf(s - mn); l = l * al + pp; mx = mn;
#pragma unroll
                        for (int d = 0; d < 64; d += 4) { const f32x4 vv = *(const LAS f32x4*)(Vs + key * 64 + d); o[d] = o[d] * al + pp * vv[0]; o[d + 1] = o[d + 1] * al + pp * vv[1]; o[d + 2] = o[d + 2] * al + pp * vv[2]; o[d + 3] = o[d + 3] * al + pp * vv[3]; } } }
            }
        }
        const float il = 1.0f / l;
#pragma unroll
        for (int c = 0; c < 8; ++c) { u32x4 w; w.x = cvt_pk_bf16(o[c * 8] * il, o[c * 8 + 1] * il); w.y = cvt_pk_bf16(o[c * 8 + 2] * il, o[c * 8 + 3] * il); w.z = cvt_pk_bf16(o[c * 8 + 4] * il, o[c * 8 + 5] * il); w.w = cvt_pk_bf16(o[c * 8 + 6] * il, o[c * 8 + 7] * il);
            *(u32x4*)(OA + rowq * 1024 + h * 64 + c * 8) = w; }
    }
    __syncthreads();
}

__device__ __forceinline__ void dil_attn_scalar(Frame& F) {
    unsigned char* ws = F.ws; const bf16_t* DIL = (const bf16_t*)(ws + WS_DIL); bf16_t* OB = (bf16_t*)(ws + WS_OB);
    for (int u = F.vcu; u < 128; u += F.G) {
        const int id = u * NTHR + F.tid, t = id & 2047, h = (id >> 11) & 3, b = id >> 13; const size_t row = (size_t)b * SEQ + t;
        float o[64]; float mx = -1e30f, l = 0.f;
#pragma unroll
        for (int d = 0; d < 64; ++d) o[d] = 0.f;
#pragma unroll 1
        for (int g = 0; g < 3; ++g) { const int dil = g == 0 ? 1 : (g == 1 ? 4 : 16);
            float q[64];
#pragma unroll
            for (int c = 0; c < 8; ++c) { f32x4 a0, a1; unpack8(*(const u32x4*)(DIL + row * 2304 + g * 768 + h * 64 + c * 8), a0, a1);
#pragma unroll
                for (int e = 0; e < 4; ++e) { q[c * 8 + e] = a0[e] * 0.125f; q[c * 8 + 4 + e] = a1[e] * 0.125f; } }
#pragma unroll 1
            for (int j = 0; j <= 128; ++j) { const int tk = t - j * dil; const bool valid = tk >= 0; if (!__any(valid)) break;
                if (valid) { const bf16_t* kp = DIL + ((size_t)b * SEQ + tk) * 2304 + g * 768 + 256 + h * 64; float s = 0.f;
#pragma unroll
                    for (int c = 0; c < 8; ++c) { f32x4 a0, a1; unpack8(*(const u32x4*)(kp + c * 8), a0, a1);
#pragma unroll
                        for (int e = 0; e < 4; ++e) s += q[c * 8 + e] * a0[e] + q[c * 8 + 4 + e] * a1[e]; }
                    const float mn = fmaxf(mx, s), al = __expf(mx - mn), pp = __expf(s - mn); l = l * al + pp; mx = mn;
#pragma unroll
                    for (int c = 0; c < 8; ++c) { f32x4 a0, a1; unpack8(*(const u32x4*)(kp + 256 + c * 8), a0, a1);
#pragma unroll
                        for (int e = 0; e < 4; ++e) { o[c * 8 + e] = o[c * 8 + e] * al + pp * a0[e]; o[c * 8 + 4 + e] = o[c * 8 + 4 + e] * al + pp * a1[e]; } } } }
        }
        const float il = 1.0f / l;
#pragma unroll
        for (int c = 0; c < 8; ++c) { u32x4 w; w.x = cvt_pk_bf16(o[c * 8] * il, o[c * 8 + 1] * il); w.y = cvt_pk_bf16(o[c * 8 + 2] * il, o[c * 8 + 3] * il); w.z = cvt_pk_bf16(o[c * 8 + 4] * il, o[c * 8 + 5] * il); w.w = cvt_pk_bf16(o[c * 8 + 6] * il, o[c * 8 + 7] * il);
            *(u32x4*)(OB + row * 256 + h * 64 + c * 8) = w; }
    }
}

__device__ __forceinline__ void dispatch1(Frame& F, const float* b_g, const float* b_e, int l) {
    unsigned char* ws = F.ws; const float* RL = (const float*)(ws + WS_RL); const float* ssq2 = (const float*)(ws + WS_SSQ2) + (size_t)l * T * 16;
    int* tok_e = (int*)(ws + RT_TOK_E); float* tok_w = (float*)(ws + RT_TOK_W); float* tok_rs = (float*)(ws + RT_TOK_RS);
    int* cnt = (int*)(ws + CTL_CNT) + l * 64;
    LAS int* hist = (LAS int*)F.lds;
    if (F.tid < 64) hist[F.tid] = 0;
    __syncthreads();
    for (int t = F.vcu * NTHR + F.tid; t < T; t += F.G * NTHR) {
        const float rs = rsqrtf(part_sum<16>(ssq2 + (size_t)t * 16) * (1.0f / 1024.0f) + EPS);
        float gl[8];
#pragma unroll
        for (int j = 0; j < 8; ++j) { float s = 0.f;
#pragma unroll
            for (int ks = 0; ks < 4; ++ks) s += RL[((size_t)ks * T + t) * 72 + j];
            gl[j] = s * rs + b_g[j]; }
        int gs = 0; float gm = gl[0];
#pragma unroll
        for (int j = 1; j < 8; ++j) if (gl[j] > gm) { gm = gl[j]; gs = j; }
        float den = 0.f;
#pragma unroll
        for (int j = 0; j < 8; ++j) den += __expf(gl[j] - gm);
        const float pg = 1.0f / den;
        float el[8];
#pragma unroll
        for (int j = 0; j < 8; ++j) { float s = 0.f;
#pragma unroll
            for (int ks = 0; ks < 4; ++ks) s += RL[((size_t)ks * T + t) * 72 + 8 + gs * 8 + j];
            el[j] = s * rs + b_e[gs * 8 + j]; }
        int i0 = 0; float v0 = el[0];
#pragma unroll
        for (int j = 1; j < 8; ++j) if (el[j] > v0) { v0 = el[j]; i0 = j; }
        int i1 = -1; float v1 = -3.0e38f;
#pragma unroll
        for (int j = 0; j < 8; ++j) if (j != i0 && el[j] > v1) { v1 = el[j]; i1 = j; }
        const float ex = __expf(v1 - v0), w0 = pg / (1.0f + ex), w1 = pg * ex / (1.0f + ex);
        const int e0 = gs * 8 + i0, e1 = gs * 8 + i1;
        tok_e[2 * t] = e0; tok_e[2 * t + 1] = e1; tok_w[2 * t] = w0; tok_w[2 * t + 1] = w1; tok_rs[t] = rs;
        atomicAdd((int*)&hist[e0], 1); atomicAdd((int*)&hist[e1], 1);
    }
    __syncthreads();
    if (F.tid < 64 && hist[F.tid]) atomicAdd(cnt + F.tid, hist[F.tid]);
    __syncthreads();
}
__device__ __forceinline__ void dispatch2(Frame& F, int l) {
    unsigned char* ws = F.ws;
    const int* tok_e = (const int*)(ws + RT_TOK_E); const float* tok_w = (const float*)(ws + RT_TOK_W); const float* tok_rs = (const float*)(ws + RT_TOK_RS);
    int* dest = (int*)(ws + RT_DEST); int* row_tok = (int*)(ws + RT_ROW_TOK); float* row_w = (float*)(ws + RT_ROW_W); float* row_rs = (float*)(ws + RT_ROW_RS); int* blk_e = (int*)(ws + RT_BLK_E);
    const int* cnt = (const int*)(ws + CTL_CNT) + l * 64; int* fill = (int*)(ws + CTL_CNT) + 256 + l * 64;
    LAS int* pst = (LAS int*)F.lds;
    if (F.tid < 64) pst[64 + F.tid] = cnt[F.tid];
    __syncthreads();
    if (F.tid == 0) { int acc = 0; for (int e = 0; e < 64; ++e) { pst[e] = acc; acc += (pst[64 + e] + 255) & ~255; } pst[128] = acc; }
    __syncthreads();
    for (int t = F.vcu * NTHR + F.tid; t < T; t += F.G * NTHR) {
#pragma unroll
        for (int k = 0; k < 2; ++k) { const int e = tok_e[2 * t + k]; const int slot = pst[e] + atomicAdd(fill + e, 1);
            row_tok[slot] = t; row_w[slot] = tok_w[2 * t + k]; row_rs[slot] = tok_rs[t]; dest[2 * t + k] = slot; }
    }
    for (int e = F.vcu; e < 64; e += F.G) { const int c = pst[64 + e], pc = (c + 255) & ~255;
        for (int s = c + F.tid; s < pc; s += NTHR) { row_tok[pst[e] + s] = 0; row_w[pst[e] + s] = 0.f; row_rs[pst[e] + s] = 0.f; } }
    if (F.vcu == 0) { const int nblk = pst[128] >> 8;
        for (int bk = F.tid; bk < nblk; bk += NTHR) { int ee = 0; for (int j = 0; j < 64; ++j) if (pst[64 + j] > 0 && pst[j] <= bk * 256) ee = j; blk_e[bk] = ee; }
        if (F.tid == 0) blk_e[255] = nblk; }
    __syncthreads();
}

__device__ __forceinline__ void combine_norm(Frame& F, const float* g_ple) {
    unsigned char* ws = F.ws; const bf16_t* YS = (const bf16_t*)(ws + WS_YS); const int* dest = (const int*)(ws + RT_DEST); bf16_t* XN = (bf16_t*)(ws + WS_XN);
    const int gw = F.vcu * NWAVES + F.wave, NGW = F.G * NWAVES;
    f32x4 gp[4];
#pragma unroll
    for (int j = 0; j < 4; ++j) gp[j] = ((const f32x4*)g_ple)[F.lane + 64 * j];
    for (int m = gw; m < T; m += NGW) { const int d0 = dest[2 * m], d1 = dest[2 * m + 1];
        f32x4* xr = (f32x4*)(F.X + (size_t)m * 1024) + F.lane; const u32x2* y0 = (const u32x2*)(YS + (size_t)d0 * 1024) + F.lane; const u32x2* y1 = (const u32x2*)(YS + (size_t)d1 * 1024) + F.lane;
        f32x4 v[4]; float s = 0.f;
#pragma unroll
        for (int j = 0; j < 4; ++j) { v[j] = xr[64 * j]; const u32x2 a = y0[64 * j], b = y1[64 * j];
#ifndef EXP_NO_MOE
            v[j][0] += bf_lo(a.x) + bf_lo(b.x); v[j][1] += bf_hi(a.x) + bf_hi(b.x); v[j][2] += bf_lo(a.y) + bf_lo(b.y); v[j][3] += bf_hi(a.y) + bf_hi(b.y);
#endif
            s += (v[j][0] * v[j][0] + v[j][1] * v[j][1]) + (v[j][2] * v[j][2] + v[j][3] * v[j][3]); }
        const float rs = rsqrtf(wave_sum(s) * (1.0f / 1024.0f) + EPS);
#pragma unroll
        for (int j = 0; j < 4; ++j) { xr[64 * j] = v[j]; const f32x4 n = v[j] * rs * gp[j];
            ((u32x2*)(XN + (size_t)m * 1024))[F.lane + 64 * j] = (u32x2){cvt_pk_bf16(n[0], n[1]), cvt_pk_bf16(n[2], n[3])}; } }
}
__device__ __forceinline__ void final_norm(Frame& F, const float* g_final) {
    const float* ssq = (const float*)(F.ws + WS_SSQ1) + (size_t)4 * T * 16;
    const int gw = F.vcu * NWAVES + F.wave, NGW = F.G * NWAVES;
    f32x4 gp[4];
#pragma unroll
    for (int j = 0; j < 4; ++j) gp[j] = ((const f32x4*)g_final)[F.lane + 64 * j];
    for (int m = gw; m < T; m += NGW) { const float rs = rsqrtf(part_sum<16>(ssq + (size_t)m * 16) * (1.0f / 1024.0f) + EPS); f32x4* xr = (f32x4*)(F.X + (size_t)m * 1024) + F.lane;
#pragma unroll
        for (int j = 0; j < 4; ++j) xr[64 * j] = xr[64 * j] * rs * gp[j]; }
}

constexpr int PH_PER_LAYER = 13, N_PHASES = 2 + DEPTH * PH_PER_LAYER;
__global__ void __launch_bounds__(NTHR, 2) fwd_kernel(Args args) {
    extern __shared__ __attribute__((aligned(16))) unsigned char lds_raw[];
    Frame F;
    F.lds = (LAS unsigned char*)lds_raw;
    F.tid = threadIdx.x; F.lane = F.tid & 63; F.wave = __builtin_amdgcn_readfirstlane(F.tid >> 6);
    F.G = gridDim.x; { const int bx = blockIdx.x; F.vcu = (F.G % 8 == 0) ? (bx % 8) * (F.G / 8) + bx / 8 : bx; }
    F.ws = nullptr; F.X = nullptr;
    for (int u = F.tid; u < (LDS_BYTES - LDSCTL_OFF) / 4; u += NTHR) ((LAS unsigned*)(F.lds + LDSCTL_OFF))[u] = 0u;
    __syncthreads();
    const int lo = args.ph_lo, hi = args.ph_hi;
    const bool use_bar = (hi - lo) > 1;
    XcdBarrier bar; bar.bar = (unsigned*)(args.ws + WS_CTL) + CW_BAR; bar.x = 0; bar.st = nullptr;
    if (use_bar) bar = xcd_barrier_post((unsigned*)(args.ws + WS_CTL) + CW_BAR, (volatile LAS unsigned*)(F.lds + MISC_OFF + 32));
#ifndef PH_EN
#define PH_EN(j) 1
#endif
#define IN(k) (lo <= (k) && (k) < hi)
#define INL(j) (PH_EN(j) && IN(p0 + (j)))
#define SEAM(k) do { if (IN(k) && IN((k) + 1)) xcd_barrier(bar); } while (0)
#define KARGS() ({ const AS4 Args* _p = (const AS4 Args*)__builtin_amdgcn_kernarg_segment_ptr(); asm volatile("" : "+s"(_p)); _p; })
#define PHASE_ENV const AS4 Args* ap = KARGS(); unsigned char* ws = ap->ws; Frame P = F; P.ws = ws; P.X = ap->out; int cidl = cid; \
    asm volatile("" : "+v"(P.tid), "+v"(P.lane)); asm volatile("" : "+s"(P.vcu), "+s"(P.G), "+s"(P.wave), "+s"(cidl)); (void)ws; (void)cidl
    const int cid = (int)blockIdx.x;

    if (IN(0)) { PHASE_ENV; prologue(P, ap); }
    SEAM(0);

#pragma unroll 1
    for (int l = 0; l < DEPTH; ++l) {
        const int p0 = 1 + PH_PER_LAYER * l;
        if (INL(0)) {
            PHASE_ENV; unsigned char* wd = ws + WS_WD + (size_t)l * WD_STRIDE;
            pg8::Gemm g{(const bf16_t*)(ws + WS_XB), (const bf16_t*)(wd + WD_IN), 1024, 1024, 1024, nullptr}; pg8::DenseOrder S; S.init(64, 21, 1024, 1024, P.G, cidl);
            EpiInProj E{(const float*)(ws + WS_SSQ1) + (size_t)l * T * 16, (bf16_t*)(ws + WS_CQ), (bf16_t*)(ws + WS_CKV), (bf16_t*)(ws + WS_KPE), (bf16_t*)(ws + WS_DIL), (bf16_t*)(ws + WS_SG),
                        (float*)(ws + WS_SSQQ) + (size_t)l * T * 8, (float*)(ws + WS_SSQKV) + (size_t)l * T * 4, (const f32x2*)(ws + WS_ROPE_DIL), (const f32x2*)(ws + WS_ROPE_MLA)};
#ifdef EXP_SIMPLE_EPI
            EpiScaleStore E2{nullptr, 0.f, (bf16_t*)(ws + WS_YS), NIN}; pg8::gemm_phase<EpiScaleStore, pg8::DenseOrder, false, true>(P.lds, g, S, E2); (void)E;
#else
            pg8::gemm_phase<EpiInProj, pg8::DenseOrder, false, true>(P.lds, g, S, E);
#endif
        }
        SEAM(p0 + 0);
        if (INL(1)) {
            { PHASE_ENV; unsigned char* wd = ws + WS_WD + (size_t)l * WD_STRIDE;
              pg8::Gemm g{(const bf16_t*)(ws + WS_CQ), (const bf16_t*)(wd + WD_Q), 512, 512, 512, nullptr}; pg8::DenseOrder S; S.init(64, 6, 512, 512, P.G, cidl);
              EpiQup E{(const float*)(ws + WS_SSQQ) + (size_t)l * T * 8, (bf16_t*)(ws + WS_Q), (const f32x2*)(ws + WS_ROPE_MLA)}; pg8::gemm_phase<EpiQup, pg8::DenseOrder, false, true>(P.lds, g, S, E); }
            { PHASE_ENV; unsigned char* wd = ws + WS_WD + (size_t)l * WD_STRIDE;
              pg8::Gemm g{(const bf16_t*)(ws + WS_CKV), (const bf16_t*)(wd + WD_K), 256, 256, 256, nullptr}; pg8::DenseOrder S; S.init(64, 4, 256, 256, P.G, cidl);
              EpiScaleStore E{(const float*)(ws + WS_SSQKV) + (size_t)l * T * 4, 1.0f / 256.0f, (bf16_t*)(ws + WS_KN), 1024}; pg8::gemm_phase<EpiScaleStore, pg8::DenseOrder, false, true>(P.lds, g, S, E); }
            { PHASE_ENV; unsigned char* wd = ws + WS_WD + (size_t)l * WD_STRIDE;
              pg8::Gemm g{(const bf16_t*)(ws + WS_CKV), (const bf16_t*)(wd + WD_V), 256, 256, 256, nullptr}; pg8::DenseOrder S; S.init(64, 4, 256, 256, P.G, cidl);
              EpiScaleStore E{(const float*)(ws + WS_SSQKV) + (size_t)l * T * 4, 1.0f / 256.0f, (bf16_t*)(ws + WS_V), 1024}; pg8::gemm_phase<EpiScaleStore, pg8::DenseOrder, false, true>(P.lds, g, S, E); }
        }
        SEAM(p0 + 1);
        if (INL(2)) { { PHASE_ENV; mla_attn_scalar(P); } { PHASE_ENV; dil_attn_scalar(P); } }
        SEAM(p0 + 2);
        if (INL(3)) {
            PHASE_ENV; unsigned char* wd = ws + WS_WD + (size_t)l * WD_STRIDE;
            pg8::Gemm g{(const bf16_t*)(ws + WS_OB), (const bf16_t*)(wd + WD_B), 256, 256, 256, nullptr}; pg8::DenseOrder S; S.init(64, 4, 256, 256, P.G, cidl);
            EpiGate<0> E{(const bf16_t*)(ws + WS_SG), 1024, nullptr, (bf16_t*)(ws + WS_TMPB)}; pg8::gemm_phase<EpiGate<0>, pg8::DenseOrder, false, false>(P.lds, g, S, E);
        }
        SEAM(p0 + 3);
        if (INL(4)) {
            PHASE_ENV; unsigned char* wd = ws + WS_WD + (size_t)l * WD_STRIDE;
            pg8::Gemm g{(const bf16_t*)(ws + WS_OA), (const bf16_t*)(wd + WD_A), 1024, 1024, 1024, nullptr}; pg8::DenseOrder S; S.init(64, 4, 1024, 1024, P.G, cidl);
            EpiGate<1> E{(const bf16_t*)(ws + WS_SG), 0, (const bf16_t*)(ws + WS_TMPB), (bf16_t*)(ws + WS_MERGED)}; pg8::gemm_phase<EpiGate<1>, pg8::DenseOrder, false, false>(P.lds, g, S, E);
        }
        SEAM(p0 + 4);
        if (INL(5)) {
            PHASE_ENV; unsigned char* wd = ws + WS_WD + (size_t)l * WD_STRIDE;
            pg8::Gemm g{(const bf16_t*)(ws + WS_MERGED), (const bf16_t*)(wd + WD_O), 1024, 1024, 1024, nullptr}; pg8::DenseOrder S; S.init(64, 4, 1024, 1024, P.G, cidl);
            EpiResid<0> E{P.X, (bf16_t*)(ws + WS_XB), (float*)(ws + WS_SSQ2) + (size_t)l * T * 16, nullptr}; pg8::gemm_phase<EpiResid<0>, pg8::DenseOrder, false, false>(P.lds, g, S, E);
        }
        SEAM(p0 + 5);
        if (INL(6)) {
            { PHASE_ENV; unsigned char* wd = ws + WS_WD + (size_t)l * WD_STRIDE;
              pg8::Gemm g{(const bf16_t*)(ws + WS_XB), (const bf16_t*)(wd + WD_R), 1024, 1024, 256, nullptr}; RouterOrder S{P.G, cidl};
              EpiRouter E{(float*)(ws + WS_RL)}; pg8::gemm_phase<EpiRouter, RouterOrder, false, false>(P.lds, g, S, E); }
            { PHASE_ENV; unsigned char* wd = ws + WS_WD + (size_t)l * WD_STRIDE;
              pg8::Gemm g{(const bf16_t*)(ws + WS_PB) + (size_t)l * T * 256, (const bf16_t*)(wd + WD_P), 256, 256, 256, nullptr}; pg8::DenseOrder S; S.init(64, 4, 256, 256, P.G, cidl);
              EpiScaleStore E{nullptr, 0.f, (bf16_t*)(ws + WS_E), 1024}; pg8::gemm_phase<EpiScaleStore, pg8::DenseOrder, false, false>(P.lds, g, S, E); }
        }
        SEAM(p0 + 6);
        if (INL(7)) { PHASE_ENV; dispatch1(P, (const float*)ap->in[14] + l * 8, (const float*)ap->in[16] + l * 64, l); }
        SEAM(p0 + 7);
        if (INL(8)) { PHASE_ENV; dispatch2(P, l); }
        SEAM(p0 + 8);
        if (INL(9)) {
            PHASE_ENV;
            pg8::Gemm g{(const bf16_t*)(ws + WS_XB), (const bf16_t*)(ws + WS_W13 + (size_t)l * W13_STRIDE), 1024, 1024, 1024, (const int*)(ws + RT_ROW_TOK)}; ExpertOrder<2> S{(const int*)(ws + RT_BLK_E), P.G, cidl};
            EpiExp1 E{(const float*)(ws + RT_ROW_RS), (bf16_t*)(ws + WS_H)}; pg8::gemm_phase<EpiExp1, ExpertOrder<2>, true, true>(P.lds, g, S, E);
        }
        SEAM(p0 + 9);
        if (INL(10)) {
            PHASE_ENV;
            pg8::Gemm g{(const bf16_t*)(ws + WS_H), (const bf16_t*)(ws + WS_W2 + (size_t)l * W2_STRIDE), 256, 256, 256, nullptr}; ExpertOrder<4> S{(const int*)(ws + RT_BLK_E), P.G, cidl};
            EpiExp2 E{(const float*)(ws + RT_ROW_W), (bf16_t*)(ws + WS_YS)}; pg8::gemm_phase<EpiExp2, ExpertOrder<4>, false, true>(P.lds, g, S, E);
        }
        SEAM(p0 + 10);
        if (INL(11)) { PHASE_ENV; combine_norm(P, (const float*)ap->in[20] + l * 1024); }
        SEAM(p0 + 11);
        if (INL(12)) {
            PHASE_ENV; unsigned char* wd = ws + WS_WD + (size_t)l * WD_STRIDE;
            pg8::Gemm g{(const bf16_t*)(ws + WS_XN), (const bf16_t*)(wd + WD_G), 1024, 1024, 1024, nullptr}; pg8::DenseOrder S; S.init(64, 4, 1024, 1024, P.G, cidl);
            EpiResid<1> E{P.X, (bf16_t*)(ws + WS_XB), (float*)(ws + WS_SSQ1) + (size_t)(l + 1) * T * 16, (const bf16_t*)(ws + WS_E)}; pg8::gemm_phase<EpiResid<1>, pg8::DenseOrder, false, false>(P.lds, g, S, E);
        }
        SEAM(p0 + 12);
    }
    if (IN(N_PHASES - 1)) { PHASE_ENV; final_norm(P, (const float*)ap->in[23]); }
#undef IN
#undef INL
#undef SEAM
}


#ifdef DUMP_MODE
__global__ void dump_kernel(unsigned char* ws, float* out) {
    const size_t N = (size_t)T * 1024;
    for (size_t i = blockIdx.x * (size_t)blockDim.x + threadIdx.x; i < N; i += (size_t)gridDim.x * blockDim.x) {
        float v = 0.f;
#if DUMP_MODE == 1
        const bf16_t* CQ = (const bf16_t*)(ws + WS_CQ); const bf16_t* CKV = (const bf16_t*)(ws + WS_CKV); const bf16_t* KPE = (const bf16_t*)(ws + WS_KPE);
        const bf16_t* DIL = (const bf16_t*)(ws + WS_DIL); const bf16_t* SG = (const bf16_t*)(ws + WS_SG);
        v = bf_lo(CQ[i % ((size_t)T * 512)]) + bf_lo(CKV[i % ((size_t)T * 256)]) + bf_lo(KPE[i % ((size_t)T * 32)]) + bf_lo(DIL[i]) + bf_lo(DIL[i + N]) + bf_lo(DIL[(i % ((size_t)T * 256)) + 2 * N]) + bf_lo(SG[i]) + bf_lo(SG[i + N]);
#elif DUMP_MODE == 2
        const bf16_t* Q = (const bf16_t*)(ws + WS_Q); const bf16_t* KN = (const bf16_t*)(ws + WS_KN); const bf16_t* V = (const bf16_t*)(ws + WS_V);
        v = bf_lo(Q[i]) + bf_lo(Q[(i % ((size_t)T * 512)) + N]) + bf_lo(KN[i]) + bf_lo(V[i]);
#elif DUMP_MODE == 4
        const bf16_t* W = (const bf16_t*)(ws + WS_WD); const bf16_t* XB = (const bf16_t*)(ws + WS_XB); const float* R1 = (const float*)(ws + WS_ROPE_MLA); const float* R2 = (const float*)(ws + WS_ROPE_DIL);
        const bf16_t* W13 = (const bf16_t*)(ws + WS_W13); const bf16_t* W2 = (const bf16_t*)(ws + WS_W2); const bf16_t* PB = (const bf16_t*)(ws + WS_PB); const float* S1 = (const float*)(ws + WS_SSQ1);
        v = bf_lo(XB[i]) + R1[i % ((size_t)T * 32)] + R2[i % ((size_t)T * 16)] + bf_lo(PB[i]) + S1[i % T] * 1e-3f;
        for (int l = 0; l < 4; ++l) { const bf16_t* wl = (const bf16_t*)(ws + WS_WD + (size_t)l * WD_STRIDE); v += bf_lo(wl[i % ((size_t)5152 * 1024)]) + bf_lo(wl[(WD_Q / 2) + (i % ((size_t)5242880))]);
            for (int k = 0; k < 2; ++k) v += bf_lo(W13[(size_t)l * (W13_STRIDE / 2) + k * N + i]) + bf_lo(W2[(size_t)l * (W2_STRIDE / 2) + (k * N + i) % ((size_t)16 * 1024 * 1024)]); }
        (void)W;
#elif DUMP_MODE == 5
        const bf16_t* Y = (const bf16_t*)(ws + WS_YS);
        { const size_t row = i / 1024, c = i % 1024; v = 0.f; for (int k = 0; k < 5; ++k) v += bf_lo(Y[row * 5376 + k * 1024 + c]); }
#elif DUMP_MODE == 6
        const bf16_t* SG = (const bf16_t*)(ws + WS_SG);
        v = bf_lo(SG[i]) + bf_lo(SG[i + N]);
#elif DUMP_MODE == 7
        const bf16_t* CQ = (const bf16_t*)(ws + WS_CQ); const bf16_t* CKV = (const bf16_t*)(ws + WS_CKV);
        v = bf_lo(CQ[i % ((size_t)T * 512)]) + bf_lo(CKV[i % ((size_t)T * 256)]);
#elif DUMP_MODE == 8
        const bf16_t* DIL = (const bf16_t*)(ws + WS_DIL);
        v = bf_lo(DIL[i]) + bf_lo(DIL[i + N]) + bf_lo(DIL[(i % ((size_t)T * 256)) + 2 * N]);
#elif DUMP_MODE == 3
        const bf16_t* OA = (const bf16_t*)(ws + WS_OA); const bf16_t* OB = (const bf16_t*)(ws + WS_OB);
        v = bf_lo(OA[i]) + bf_lo(OB[i % ((size_t)T * 256)]);
#endif
        out[i] = v;
    }
}
#endif
extern "C" void kernel_launch(void* const* d_in, const int* in_sizes, int n_in, void* d_out, int out_size, void* d_ws, size_t ws_size, hipStream_t stream) {
    static int grid = 0;
    if (grid == 0) {
        if (n_in != 24 || out_size != T * DM || ws_size < WS_END) { fprintf(stderr, "kernel_launch: unexpected shapes n_in %d out %d ws %zu\n", n_in, out_size, ws_size); grid = -1; return; }
        int dev = 0, cus = 0, per_cu = 0;
        if (hipGetDevice(&dev) != hipSuccess || hipDeviceGetAttribute(&cus, hipDeviceAttributeMultiprocessorCount, dev) != hipSuccess) { grid = -1; return; }
        if (hipFuncSetAttribute((const void*)fwd_kernel, hipFuncAttributeMaxDynamicSharedMemorySize, LDS_BYTES) != hipSuccess) { fprintf(stderr, "kernel_launch: hipFuncSetAttribute failed\n"); grid = -1; return; }
        if (hipOccupancyMaxActiveBlocksPerMultiprocessor(&per_cu, (const void*)fwd_kernel, NTHR, LDS_BYTES) != hipSuccess || per_cu < 1) fprintf(stderr, "kernel_launch: occupancy query says %d\n", per_cu);
        (void)hipGetLastError();
        grid = cus;
    }
    if (grid < 0) return;
    (void)hipMemsetAsync((char*)d_ws + WS_CTL, 0, CTL_ZERO_BYTES, stream);
    Args a{};
    for (int i = 0; i < 24; ++i) a.in[i] = d_in[i];
    a.out = (float*)d_out; a.ws = (unsigned char*)d_ws;
#if MK_PER_PHASE
#ifndef RUN_PHASES
#define RUN_PHASES N_PHASES
#endif
    for (int ph = 0; ph < RUN_PHASES; ++ph) { a.ph_lo = ph; a.ph_hi = ph + 1; hipLaunchKernelGGL(fwd_kernel, dim3(grid), dim3(NTHR), LDS_BYTES, stream, a); }
#ifdef DUMP_MODE
    hipLaunchKernelGGL(dump_kernel, dim3(1024), dim3(256), 0, stream, (unsigned char*)d_ws, (float*)d_out);
#endif
#else
    a.ph_lo = 0; a.ph_hi = N_PHASES; hipLaunchKernelGGL(fwd_kernel, dim3(grid), dim3(NTHR), LDS_BYTES, stream, a);
#endif
}
```

```cpp
#include <hip/hip_runtime.h>
#include <cstdio>
#include <cstdint>

#define LAS __attribute__((address_space(3)))
#define GAS __attribute__((address_space(1)))
#define AS4 __attribute__((address_space(4)))
typedef unsigned short bf16_t;
typedef short bf16x8 __attribute__((ext_vector_type(8)));
typedef float f32x4 __attribute__((ext_vector_type(4)));
typedef float f32x2 __attribute__((ext_vector_type(2)));
typedef unsigned u32x4 __attribute__((ext_vector_type(4)));
typedef unsigned u32x2 __attribute__((ext_vector_type(2)));

#ifndef MK_PER_PHASE
#define MK_PER_PHASE 0
#endif

constexpr int T = 16384, DM = 1024, SEQ = 2048, NBATCH = 8, DEPTH = 4;
constexpr int NIN_SRC = 5152, NIN = 5376;
constexpr int NE = 64;
constexpr int MAXBLK = 192;
constexpr float EPS = 1e-6f;
constexpr int NWAVES = 8, NTHR = 512;

constexpr size_t MiB = 1u << 20, KiB = 1u << 10;
constexpr size_t WS_CTL = 0, CTL_ZERO_BYTES = 2 * MiB;
constexpr int CW_TMO = 0, CW_BAR = 4096;
constexpr size_t CTL_CNT = 128 * KiB;
static_assert(CTL_CNT + 4096 <= CTL_ZERO_BYTES, "ctl");
constexpr size_t WS_ROPE_MLA = 2 * MiB;
constexpr size_t WS_ROPE_DIL = 4 * MiB;
constexpr size_t WS_ROUTE = 5 * MiB;
constexpr size_t RT_TOK_E = WS_ROUTE;
constexpr size_t RT_TOK_W = RT_TOK_E + 128 * KiB;
constexpr size_t RT_TOK_RS = RT_TOK_W + 128 * KiB;
constexpr size_t RT_DEST = RT_TOK_RS + 64 * KiB;
constexpr size_t RT_ROW_TOK = RT_DEST + 128 * KiB;
constexpr size_t RT_ROW_W = RT_ROW_TOK + 192 * KiB;
constexpr size_t RT_ROW_RS = RT_ROW_W + 192 * KiB;
constexpr size_t RT_BLK_E = RT_ROW_RS + 192 * KiB;
static_assert(RT_BLK_E + 1024 <= 8 * MiB, "route");
constexpr size_t WS_WD = 8 * MiB, WD_STRIDE = 21 * MiB;
constexpr size_t WD_IN = 0, WD_Q = 10 * MiB + 512 * KiB, WD_K = 12 * MiB, WD_V = 12 * MiB + 512 * KiB, WD_A = 13 * MiB, WD_B = 15 * MiB,
                 WD_O = 15 * MiB + 512 * KiB, WD_R = 17 * MiB + 512 * KiB, WD_G = 18 * MiB, WD_P = 20 * MiB;
constexpr size_t WS_W13 = 92 * MiB, W13_STRIDE = 64 * MiB;
constexpr size_t WS_W2 = 348 * MiB, W2_STRIDE = 32 * MiB;
constexpr size_t WS_PB = 476 * MiB;
constexpr size_t WS_XB = 508 * MiB, WS_XN = 540 * MiB, WS_CQ = 572 * MiB, WS_CKV = 588 * MiB, WS_KPE = 596 * MiB, WS_Q = 598 * MiB,
                 WS_KN = 646 * MiB, WS_V = 678 * MiB, WS_OA = 710 * MiB, WS_OB = 742 * MiB, WS_TMPB = 750 * MiB, WS_MERGED = 782 * MiB,
                 WS_E = 814 * MiB, WS_RL = 846 * MiB, WS_DIL = 866 * MiB, WS_SG = 938 * MiB, WS_YS = 866 * MiB, WS_H = 962 * MiB,
                 WS_SSQ1 = 1002 * MiB  , WS_SSQ2 = 1007 * MiB  , WS_SSQQ = 1011 * MiB  , WS_SSQKV = 1013 * MiB  , WS_END = 1014 * MiB;

constexpr int RING_BYTES = 131072, LDSCTL_OFF = RING_BYTES, MISC_OFF = LDSCTL_OFF + 320, LDS_BYTES = 147456;

typedef __bf16 bf16x2_t __attribute__((ext_vector_type(2)));
__device__ __forceinline__ unsigned cvt_pk_bf16(float lo, float hi) { f32x2 v = {lo, hi}; bf16x2_t b = __builtin_convertvector(v, bf16x2_t); return __builtin_bit_cast(unsigned, b); }
__device__ __forceinline__ float bf_lo(unsigned w) { return __uint_as_float(w << 16); }
__device__ __forceinline__ float bf_hi(unsigned w) { return __uint_as_float(w & 0xffff0000u); }
__device__ __forceinline__ float sigmoidf_(float x) { return __builtin_amdgcn_rcpf(1.0f + __expf(-x)); }
__device__ __forceinline__ u32x4 pack8(f32x4 a, f32x4 b) { u32x4 w; w.x = cvt_pk_bf16(a[0], a[1]); w.y = cvt_pk_bf16(a[2], a[3]); w.z = cvt_pk_bf16(b[0], b[1]); w.w = cvt_pk_bf16(b[2], b[3]); return w; }
__device__ __forceinline__ void unpack8(u32x4 w, f32x4& a, f32x4& b) { a = (f32x4){bf_lo(w.x), bf_hi(w.x), bf_lo(w.y), bf_hi(w.y)}; b = (f32x4){bf_lo(w.z), bf_hi(w.z), bf_lo(w.w), bf_hi(w.w)}; }
__device__ __forceinline__ float wave_sum(float v) {
#pragma unroll
    for (int o = 1; o < 64; o <<= 1) v += __shfl_xor(v, o);
    return v;
}
template <int NP> __device__ __forceinline__ float part_sum(const float* p) { float t = 0.f;
#pragma unroll
    for (int i = 0; i < NP / 4; ++i) { const f32x4 a = *(const f32x4*)(p + 4 * i); t += (a[0] + a[1]) + (a[2] + a[3]); }
    return t; }
#define LDS_WAIT() asm volatile("s_waitcnt lgkmcnt(0)" ::: "memory")
#define VM_WAIT() asm volatile("s_waitcnt vmcnt(0)" ::: "memory")

namespace pg8 {
constexpr int BM = 256, BK = 64, HALF = 128, HTB = HALF * BK * 2, NXCD = 8, WGM = 8;
__host__ __device__ __forceinline__ int lds_byte(int r, int c) { const int st = (r >> 4) * 2 + (c >> 5), rr = r & 15, cc = c & 31, ob = rr * 64 + cc * 2; return st * 1024 + (ob ^ (((ob >> 9) & 1) << 5)); }
__host__ __device__ __forceinline__ void stage_rc(int b, int& R, int& C) { const int st = b / 1024, sb = b % 1024, swz = sb ^ (((sb >> 9) & 1) << 5); R = (st >> 1) * 16 + swz / 64; C = (st & 1) * 32 + (swz % 64) / 2; }
__host__ __device__ __forceinline__ int perm32(int rho) { const int n = rho >> 4, i = rho & 15; return 8 * (i >> 2) + 4 * n + (i & 3); }

struct Unit { int pm, pn; unsigned a_off, b_off; };
struct Gemm { const bf16_t* A; const bf16_t* Bt; int lda, ldb, K; const int* gather; };

struct DenseOrder {
    int nM, nN, nwg, G, c, lda, ldb;
    __device__ void init(int nM_, int nN_, int lda_, int ldb_, int G_, int c_) { nM = nM_; nN = nN_; nwg = nM * nN; G = G_; c = c_; lda = lda_; ldb = ldb_; }
    __device__ __forceinline__ bool next(int i, Unit& u) const {
        const long L = (long)i * G + c; if (L >= nwg) return false;
        int wgid = (int)L; { const int q = nwg / NXCD, r = nwg % NXCD, xcd = wgid % NXCD, off = wgid / NXCD; wgid = (xcd < r ? xcd * (q + 1) : r * (q + 1) + (xcd - r) * q) + off; }
        const int nig = WGM * nN, gid = wgid / nig, fm = gid * WGM, gsz = (nM - fm) < WGM ? (nM - fm) : WGM;
        u.pm = fm + ((wgid % nig) % gsz); u.pn = (wgid % nig) / gsz;
        u.a_off = (unsigned)u.pm * 256u * (unsigned)lda; u.b_off = (unsigned)u.pn * 256u * (unsigned)ldb; return true;
    }
};

template <class Epi, class Sched, bool GATHER, bool ALIGN_EPI>
__device__ __forceinline__ void gemm_phase(LAS unsigned char* lds, const Gemm g, const Sched& S, const Epi& E) {
    int tid_ = threadIdx.x; asm volatile("; gemm_phase entry" : "+v"(tid_));
    const int tid = tid_, wid = __builtin_amdgcn_readfirstlane(tid >> 6), lane = tid & 63, wr = wid >> 2, wc = wid & 3, fr = lane & 15, fq = lane >> 4;
    const int K = g.K, nt = K / BK, lda = g.lda, ldb = g.ldb;
    unsigned voffB[2], vAc[2][2], vAn[2][2]; int Rst[2], Cst[2];
#pragma unroll
    for (int i = 0; i < 2; ++i) { int R, C; stage_rc(tid * 16 + i * 8192, R, C); const int Rb = (R & ~31) + perm32(R & 31);
        Rst[i] = R; Cst[i] = C; voffB[i] = (unsigned)(Rb * ldb + C) * 2u;
        vAc[0][i] = (unsigned)(R * lda + C) * 2u; vAc[1][i] = (unsigned)((R + HALF) * lda + C) * 2u; vAn[0][i] = vAc[0][i]; vAn[1][i] = vAc[1][i]; }
    const size_t kstep = (size_t)(BK * 2);
    const size_t hstepB = (size_t)HALF * ldb * 2;
    const unsigned ldsw = (unsigned)wid * 1024u;
    const int aoff = lds_byte(wr * 64 + fr, fq * 8), boff = lds_byte(wc * 32 + fr, fq * 8);
#define PG8_SA(b, h) (((b) * 2 + (h)) * HTB)
#define PG8_SB(b, h) ((4 + (b) * 2 + (h)) * HTB)
#define PG8_STAGE(bufoff, gbase, voff) do { _Pragma("unroll") for (int _i = 0; _i < 2; ++_i) \
        __builtin_amdgcn_global_load_lds((const unsigned*)((const char*)(gbase) + (voff)[_i]), (LAS unsigned*)(lds + (bufoff) + ldsw + _i * 8192), 16, 0, 0); } while (0)
#define PG8_STAGE_A(bufoff, gbase, h, nx) do { _Pragma("unroll") for (int _i = 0; _i < 2; ++_i) \
        __builtin_amdgcn_global_load_lds((const unsigned*)((const char*)(gbase) + ((GATHER && (nx)) ? vAn[h][_i] : vAc[h][_i])), (LAS unsigned*)(lds + (bufoff) + ldsw + _i * 8192), 16, 0, 0); } while (0)
#define PG8_LDA(dst, b, h) do { _Pragma("unroll") for (int m = 0; m < 4; ++m) _Pragma("unroll") for (int k = 0; k < 2; ++k) dst[m][k] = *(const LAS bf16x8*)(lds + PG8_SA(b, h) + aoff + m * 2048 + k * 1024); } while (0)
#define PG8_LDB(dst, b, h) do { _Pragma("unroll") for (int n = 0; n < 2; ++n) _Pragma("unroll") for (int k = 0; k < 2; ++k) dst[n][k] = *(const LAS bf16x8*)(lds + PG8_SB(b, h) + boff + n * 2048 + k * 1024); } while (0)
#define PG8_MMA(ai, bj, At, Bt) do { __builtin_amdgcn_s_setprio(1); _Pragma("unroll") for (int m = 0; m < 4; ++m) _Pragma("unroll") for (int n = 0; n < 2; ++n) _Pragma("unroll") for (int k = 0; k < 2; ++k) \
        acc[ai][bj][m][n] = __builtin_amdgcn_mfma_f32_16x16x32_bf16(Bt[n][k], At[m][k], acc[ai][bj][m][n], 0, 0, 0); __builtin_amdgcn_s_setprio(0); } while (0)
#define PG8_WAIT_V(n) asm volatile("s_waitcnt vmcnt(" #n ")" ::: "memory")
#define PG8_WAIT_L(n) asm volatile("s_waitcnt lgkmcnt(" #n ")" ::: "memory")
#define PG8_BAR __builtin_amdgcn_s_barrier()
#define PG8_SCHED __builtin_amdgcn_sched_barrier(0)
    Unit cur, nxt; int ui = 0;
    if (!S.next(0, cur)) return;
    if constexpr (GATHER) {
#pragma unroll
        for (int h = 0; h < 2; ++h)
#pragma unroll
            for (int i = 0; i < 2; ++i) vAc[h][i] = (unsigned)(g.gather[cur.pm * 256 + h * HALF + Rst[i]] * lda + Cst[i]) * 2u;
    }
    f32x4 acc[2][2][4][2];
#pragma unroll
    for (int a = 0; a < 2; ++a)
#pragma unroll
        for (int b = 0; b < 2; ++b)
#pragma unroll
            for (int m = 0; m < 4; ++m)
#pragma unroll
                for (int n = 0; n < 2; ++n) acc[a][b][m][n] = (f32x4){0.f, 0.f, 0.f, 0.f};
    bf16x8 At[4][2], B0[2][2], B1[2][2];
    const char* cA = (const char*)g.A + (size_t)cur.a_off * 2; const char* cB = (const char*)g.Bt + (size_t)cur.b_off * 2;
    PG8_STAGE(PG8_SB(0, 0), cB, voffB); PG8_STAGE(PG8_SB(0, 1), cB + hstepB, voffB); PG8_STAGE_A(PG8_SA(0, 0), cA, 0, false); PG8_STAGE_A(PG8_SA(0, 1), cA, 1, false);
    if (wr == 1) PG8_BAR;
    PG8_WAIT_V(2); PG8_BAR;
    PG8_STAGE(PG8_SB(1, 0), cB + kstep, voffB); PG8_STAGE_A(PG8_SA(1, 0), cA + kstep, 0, false); PG8_STAGE(PG8_SB(1, 1), cB + hstepB + kstep, voffB);
    PG8_WAIT_V(6); PG8_BAR;
    for (;;) {
        const bool has_next = S.next(ui + 1, nxt);
        const char* nA = has_next ? (const char*)g.A + (size_t)nxt.a_off * 2 : cA; const char* nB = has_next ? (const char*)g.Bt + (size_t)nxt.b_off * 2 : cB;
        if constexpr (GATHER) {
#pragma unroll
            for (int h = 0; h < 2; ++h)
#pragma unroll
                for (int i = 0; i < 2; ++i) vAn[h][i] = has_next ? (unsigned)(g.gather[nxt.pm * 256 + h * HALF + Rst[i]] * lda + Cst[i]) * 2u : vAc[h][i];
        }
#pragma unroll 1
        for (int t = 0; t < nt; t += 2) {
            const bool last = (t == nt - 2);
            const char* a1 = cA + (size_t)(t + 1) * kstep;
            const char* a2 = last ? nA : cA + (size_t)(t + 2) * kstep; const char* b2 = last ? nB : cB + (size_t)(t + 2) * kstep;
            const char* a3 = a2 + kstep; const char* b3 = b2 + kstep;
            PG8_LDB(B0, 0, 0); PG8_LDB(B1, 0, 1); PG8_SCHED; PG8_LDA(At, 0, 0); PG8_STAGE_A(PG8_SA(1, 1), a1, 1, false);
            PG8_WAIT_V(8); PG8_WAIT_L(0); PG8_BAR; PG8_MMA(0, 0, At, B0); PG8_MMA(0, 1, At, B1); PG8_BAR; PG8_SCHED;
            PG8_LDA(At, 0, 1); PG8_STAGE(PG8_SB(0, 0), b2, voffB); PG8_STAGE(PG8_SB(0, 1), b2 + hstepB, voffB); PG8_STAGE_A(PG8_SA(0, 0), a2, 0, last);
            PG8_WAIT_V(8); PG8_WAIT_L(0); PG8_BAR; PG8_MMA(1, 0, At, B0); PG8_MMA(1, 1, At, B1); PG8_BAR; PG8_SCHED;
            PG8_LDB(B0, 1, 0); PG8_LDB(B1, 1, 1); PG8_SCHED; PG8_LDA(At, 1, 0); PG8_STAGE_A(PG8_SA(0, 1), a2, 1, last);
            PG8_WAIT_V(8); PG8_WAIT_L(0); PG8_BAR; PG8_MMA(0, 0, At, B0); PG8_MMA(0, 1, At, B1); PG8_BAR; PG8_SCHED;
            PG8_LDA(At, 1, 1); PG8_STAGE(PG8_SB(1, 0), b3, voffB); PG8_STAGE(PG8_SB(1, 1), b3 + hstepB, voffB); PG8_STAGE_A(PG8_SA(1, 0), a3, 0, last);
            PG8_WAIT_V(8); PG8_WAIT_L(0); PG8_BAR; PG8_MMA(1, 0, At, B0); PG8_MMA(1, 1, At, B1); PG8_BAR; PG8_SCHED;
        }
        if constexpr (ALIGN_EPI) { if (wr == 0) PG8_BAR; }
        { int fr_ = fr, fq_ = fq, wr_ = wr, wc_ = wc; asm volatile("; epilogue entry" : "+v"(fr_), "+v"(fq_)); asm volatile("" : "+s"(wr_), "+s"(wc_));
          E(acc, cur, wr_, wc_, fr_, fq_); }
        if (!has_next) break;
#pragma unroll
        for (int a = 0; a < 2; ++a)
#pragma unroll
            for (int b = 0; b < 2; ++b)
#pragma unroll
                for (int m = 0; m < 4; ++m)
#pragma unroll
                    for (int n = 0; n < 2; ++n) acc[a][b][m][n] = (f32x4){0.f, 0.f, 0.f, 0.f};
        cur = nxt; cA = nA; cB = nB; ++ui;
        if constexpr (GATHER) {
#pragma unroll
            for (int h = 0; h < 2; ++h)
#pragma unroll
                for (int i = 0; i < 2; ++i) vAc[h][i] = vAn[h][i];
        }
        if constexpr (ALIGN_EPI) { if (wr == 1) PG8_BAR; }
    }
    PG8_WAIT_V(0);
    if constexpr (!ALIGN_EPI) { if (wr == 0) PG8_BAR; }
    PG8_BAR;
#undef PG8_SA
#undef PG8_SB
#undef PG8_STAGE
#undef PG8_STAGE_A
#undef PG8_LDA
#undef PG8_LDB
#undef PG8_MMA
#undef PG8_WAIT_V
#undef PG8_WAIT_L
#undef PG8_BAR
#undef PG8_SCHED
}
}
using pg8::Unit;

#define XB_TMO      128
#define XB_XCNT(j)  (256  + 64 * (j))
#define XB_XSUB(j)  (1280 + 64 * (j))
#define XB_XGEN(j)  (2304 + 64 * (j))
#define XB_TOP      3328
#define XB_TOPGEN   3392
#define XCD_BAR_WORDS 3456
#define XB_SPIN_CAP (1u << 18)
__device__ __forceinline__ unsigned xb_ld(unsigned* p)              { return __hip_atomic_load(p, __ATOMIC_RELAXED, __HIP_MEMORY_SCOPE_AGENT); }
__device__ __forceinline__ unsigned xb_add(unsigned* p, unsigned v) { return __hip_atomic_fetch_add(p, v, __ATOMIC_RELAXED, __HIP_MEMORY_SCOPE_AGENT); }
__device__ __forceinline__ unsigned xb_xcc_id() { return (unsigned)__builtin_amdgcn_s_getreg((3 << 11) | 20) & 0xFu; }
#define XB_SPIN(cond, bar) do { unsigned _sp = 0; while (cond) { __builtin_amdgcn_s_sleep(1); \
    if ((++_sp & 255u) == 0u) { if (xb_ld(&(bar)[XB_TMO])) break; if (_sp > XB_SPIN_CAP) { atomicAdd(&(bar)[XB_TMO], 1u); break; } } } } while (0)
struct XcdBarrier { unsigned* bar; unsigned x; volatile LAS unsigned* st; };
__device__ __forceinline__ XcdBarrier xcd_barrier_post(unsigned* bar, volatile LAS unsigned* st) {
    XcdBarrier b; b.bar = bar; b.x = xb_xcc_id(); b.st = st;
    if (threadIdx.x == 0) (void)xb_add(&bar[XB_XCNT(b.x)], 1u);
    return b;
}
__device__ __forceinline__ void xcd_barrier_complete(unsigned* bar, unsigned x, unsigned& nloc, unsigned& nx) {
    const unsigned G = gridDim.x * gridDim.y * gridDim.z;
    unsigned sum, cnt, mine, sp = 0u;
    for (;;) {
        sum = 0u; cnt = 0u; mine = 0u;
#pragma unroll
        for (unsigned j = 0; j < 16; ++j) { const unsigned c = xb_ld(&bar[XB_XCNT(j)]); sum += c; cnt += (c > 0u) ? 1u : 0u; mine = (j == x) ? c : mine; }
        if (sum == G) break;
        __builtin_amdgcn_s_sleep(1);
        if ((++sp & 255u) == 0u) { if (xb_ld(&bar[XB_TMO])) break; if (sp > XB_SPIN_CAP) { atomicAdd(&bar[XB_TMO], 1u); break; } }
    }
    nloc = mine > 0u ? mine : 1u; nx = cnt > 0u ? cnt : 1u;
}
__device__ __forceinline__ void xcd_barrier(const XcdBarrier& b) {
    asm volatile("s_waitcnt vmcnt(0)" ::: "memory");
    __syncthreads();
    if (threadIdx.x == 0) {
        unsigned* bar = b.bar;
        __builtin_amdgcn_s_waitcnt(0);
        unsigned nloc = b.st[0], nx = b.st[1];
        if (nloc == 0u) { xcd_barrier_complete(bar, b.x, nloc, nx); b.st[0] = nloc; b.st[1] = nx; }
        const unsigned old = xb_add(&bar[XB_XSUB(b.x)], 1u);
        const unsigned gen = old / nloc;
        if (old + 1u == (gen + 1u) * nloc) {
            __builtin_amdgcn_fence(__ATOMIC_RELEASE, "agent");
            asm volatile("s_waitcnt vmcnt(0)" ::: "memory");
            const unsigned og = xb_add(&bar[XB_TOP], 1u);
            const unsigned tg = og / nx;
            if (og + 1u == (tg + 1u) * nx) xb_add(&bar[XB_TOPGEN], 1u);
            else XB_SPIN(xb_ld(&bar[XB_TOPGEN]) == tg, bar);
            __builtin_amdgcn_fence(__ATOMIC_ACQUIRE, "agent");
            xb_add(&bar[XB_XGEN(b.x)], 1u);
            asm volatile("s_waitcnt vmcnt(0)" ::: "memory");
        } else {
            XB_SPIN(xb_ld(&bar[XB_XGEN(b.x)]) == gen, bar);
            __builtin_amdgcn_fence(__ATOMIC_ACQUIRE, "agent");
            asm volatile("s_waitcnt vmcnt(0)" ::: "memory");
        }
    }
    __syncthreads();
}

struct Args { const void* in[24]; float* out; unsigned char* ws; int ph_lo, ph_hi; };

struct Frame {
    LAS unsigned char* lds;
    int tid, lane, wave, vcu, G;
    unsigned char* ws;
    float* X;
};

#define EPI_ROW(ai, m) (u.pm * 256 + (ai) * 128 + wr * 64 + (m) * 16 + fr)
#define EPI_FOR_ROWS _Pragma("unroll") for (int ai = 0; ai < 2; ++ai) _Pragma("unroll") for (int m = 0; m < 4; ++m)

struct EpiInProj {
    const float* ssq_x; bf16_t *CQ, *CKV, *KPE, *DIL, *SG; float *ssq_q, *ssq_kv; const f32x2* rope_dil; const f32x2* rope_mla;
    __device__ __forceinline__ void operator()(const f32x4 (&acc)[2][2][4][2], const Unit& u, int wr, int wc, int fr, int fq) const {
        const int pn = u.pn;
        if (pn < 3) {
            bf16_t* dst = pn < 2 ? CQ : CKV; const int ld = pn < 2 ? 512 : 256; const int cb = (pn == 1 ? 256 : 0) + wc * 32 + 8 * fq; float* sq = pn < 2 ? ssq_q : ssq_kv;
            EPI_FOR_ROWS { const int row = EPI_ROW(ai, m); const float rs = rsqrtf(part_sum<16>(ssq_x + (size_t)row * 16) * (1.0f / 1024.0f) + EPS); float s = 0.f;
#pragma unroll
                for (int bj = 0; bj < 2; ++bj) { const f32x4 v0 = acc[ai][bj][m][0] * rs, v1 = acc[ai][bj][m][1] * rs;
                    s += (v0[0] * v0[0] + v0[1] * v0[1]) + (v0[2] * v0[2] + v0[3] * v0[3]) + (v1[0] * v1[0] + v1[1] * v1[1]) + (v1[2] * v1[2] + v1[3] * v1[3]);
                    *(u32x4*)(dst + (size_t)row * ld + cb + bj * 128) = pack8(v0, v1); }
                s += __shfl_xor(s, 16); s += __shfl_xor(s, 32);
                if (fq == 0) { if (pn < 2) sq[(size_t)row * 8 + pn * 4 + wc] = s; else sq[(size_t)row * 4 + wc] = s; } }
        } else if (pn < 12) {
            const int t = pn - 3, kind = t % 3; const bool rope = (kind < 2) && ((wc & 1) == 0); const float sgn = fq == 0 ? -1.f : 1.f;
            const int cb = t * 256 + wc * 32 + 8 * fq;
            EPI_FOR_ROWS { const int row = EPI_ROW(ai, m); const float rs = rsqrtf(part_sum<16>(ssq_x + (size_t)row * 16) * (1.0f / 1024.0f) + EPS);
                f32x4 cs[4];
                if (rope) {
#pragma unroll
                    for (int j = 0; j < 4; ++j) cs[j] = *(const f32x4*)(rope_dil + (size_t)row * 8 + 2 * j);
                }
#pragma unroll
                for (int bj = 0; bj < 2; ++bj) { f32x4 v[2] = {acc[ai][bj][m][0] * rs, acc[ai][bj][m][1] * rs};
                    if (rope) {
#pragma unroll
                        for (int n = 0; n < 2; ++n)
#pragma unroll
                            for (int e = 0; e < 4; ++e) { const int j = 4 * n + e; const float c = cs[j >> 1][(j & 1) * 2], sn = cs[j >> 1][(j & 1) * 2 + 1];
                                const float mine = v[n][e], oth = __shfl_xor(mine, 16) * sgn;
                                const float r = mine * c + oth * sn; v[n][e] = fq < 2 ? r : mine; }
                    }
                    *(u32x4*)(DIL + (size_t)row * 2304 + cb + bj * 128) = pack8(v[0], v[1]); } }
        } else if (pn < 20) {
            const int cb = (pn - 12) * 256 + wc * 32 + 8 * fq;
            EPI_FOR_ROWS { const int row = EPI_ROW(ai, m); const float rs = rsqrtf(part_sum<16>(ssq_x + (size_t)row * 16) * (1.0f / 1024.0f) + EPS);
#pragma unroll
                for (int bj = 0; bj < 2; ++bj) { f32x4 v0 = acc[ai][bj][m][0] * rs, v1 = acc[ai][bj][m][1] * rs;
#ifdef EXP_D
                    v0 = acc[ai][bj][m][0] * 0.f + rs; v1 = acc[ai][bj][m][1] * 0.f + rs;
#else
#pragma unroll
                    for (int e = 0; e < 4; ++e) { v0[e] = sigmoidf_(v0[e]); v1[e] = sigmoidf_(v1[e]); }
#endif
                    *(u32x4*)(SG + (size_t)row * 2048 + cb + bj * 128) = pack8(v0, v1); } }
        } else {
            if (wc == 0) {
                EPI_FOR_ROWS { const int row = EPI_ROW(ai, m); const float rs = rsqrtf(part_sum<16>(ssq_x + (size_t)row * 16) * (1.0f / 1024.0f) + EPS);
                    f32x4 v[2] = {acc[ai][0][m][0] * rs, acc[ai][0][m][1] * rs};
                    const int jb = 8 * (fq & 1);
#pragma unroll
                    for (int n = 0; n < 2; ++n) { const f32x4 c01 = *(const f32x4*)(rope_mla + (size_t)row * 16 + jb + 4 * n), c23 = *(const f32x4*)(rope_mla + (size_t)row * 16 + jb + 4 * n + 2);
#pragma unroll
                        for (int e = 0; e < 4; ++e) { const float c = e < 2 ? c01[e * 2] : c23[(e - 2) * 2], sn = e < 2 ? c01[e * 2 + 1] : c23[(e - 2) * 2 + 1];
                            const float mine = v[n][e], oth = __shfl_xor(mine, 32);
                            v[n][e] = fq < 2 ? mine * c - oth * sn : oth * sn + mine * c; } }
                    *(u32x4*)(KPE + (size_t)row * 32 + 8 * fq) = pack8(v[0], v[1]); }
            }
        }
    }
};

struct EpiQup {
    const float* ssq_q; bf16_t* Q; const f32x2* rope_mla;
    __device__ __forceinline__ void operator()(const f32x4 (&acc)[2][2][4][2], const Unit& u, int wr, int wc, int fr, int fq) const {
        EPI_FOR_ROWS { const int row = EPI_ROW(ai, m); const float rs = rsqrtf(part_sum<8>(ssq_q + (size_t)row * 8) * (1.0f / 512.0f) + EPS);
#pragma unroll
            for (int bj = 0; bj < 2; ++bj) { const int cg = u.pn * 8 + bj * 4 + wc; const bool rope = (cg % 3) == 2;
                f32x4 v[2] = {acc[ai][bj][m][0] * rs, acc[ai][bj][m][1] * rs};
                if (rope) { const int jb = 8 * (fq & 1);
#pragma unroll
                    for (int n = 0; n < 2; ++n) { const f32x4 c01 = *(const f32x4*)(rope_mla + (size_t)row * 16 + jb + 4 * n), c23 = *(const f32x4*)(rope_mla + (size_t)row * 16 + jb + 4 * n + 2);
#pragma unroll
                        for (int e = 0; e < 4; ++e) { const float c = e < 2 ? c01[e * 2] : c23[(e - 2) * 2], sn = e < 2 ? c01[e * 2 + 1] : c23[(e - 2) * 2 + 1];
                            const float mine = v[n][e], oth = __shfl_xor(mine, 32);
                            v[n][e] = fq < 2 ? mine * c - oth * sn : oth * sn + mine * c; } } }
                *(u32x4*)(Q + (size_t)row * 1536 + u.pn * 256 + bj * 128 + wc * 32 + 8 * fq) = pack8(v[0], v[1]); } }
    }
};

struct EpiScaleStore {
    const float* ssq; float inv_n; bf16_t* O; int ld;
    __device__ __forceinline__ void operator()(const f32x4 (&acc)[2][2][4][2], const Unit& u, int wr, int wc, int fr, int fq) const {
        EPI_FOR_ROWS { const int row = EPI_ROW(ai, m); const float rs = ssq ? rsqrtf(part_sum<4>(ssq + (size_t)row * 4) * inv_n + EPS) : 1.0f;
#pragma unroll
            for (int bj = 0; bj < 2; ++bj) *(u32x4*)(O + (size_t)row * ld + u.pn * 256 + bj * 128 + wc * 32 + 8 * fq) = pack8(acc[ai][bj][m][0] * rs, acc[ai][bj][m][1] * rs); }
    }
};

template <int MODE> struct EpiGate {
    const bf16_t* G; int goff; const bf16_t* ADD; bf16_t* O;
    __device__ __forceinline__ void operator()(const f32x4 (&acc)[2][2][4][2], const Unit& u, int wr, int wc, int fr, int fq) const {
        EPI_FOR_ROWS { const int row = EPI_ROW(ai, m);
#pragma unroll
            for (int bj = 0; bj < 2; ++bj) { const int col = u.pn * 256 + bj * 128 + wc * 32 + 8 * fq;
                f32x4 g0, g1; unpack8(*(const u32x4*)(G + (size_t)row * 2048 + goff + col), g0, g1);
                f32x4 v0 = acc[ai][bj][m][0] * g0, v1 = acc[ai][bj][m][1] * g1;
                if (MODE == 1) { f32x4 a0, a1; unpack8(*(const u32x4*)(ADD + (size_t)row * 1024 + col), a0, a1); v0 += a0; v1 += a1; }
                *(u32x4*)(O + (size_t)row * 1024 + col) = pack8(v0, v1); } }
    }
};

template <int MODE> struct EpiResid {
    float* X; bf16_t* XB; float* ssq; const bf16_t* Eb;
    __device__ __forceinline__ void operator()(const f32x4 (&acc)[2][2][4][2], const Unit& u, int wr, int wc, int fr, int fq) const {
        EPI_FOR_ROWS { const int row = EPI_ROW(ai, m); float s = 0.f;
#pragma unroll
            for (int bj = 0; bj < 2; ++bj) { const int col = u.pn * 256 + bj * 128 + wc * 32 + 8 * fq;
                float* xp = X + (size_t)row * 1024 + col;
                f32x4 x0 = *(const f32x4*)xp, x1 = *(const f32x4*)(xp + 4);
                f32x4 d0 = acc[ai][bj][m][0], d1 = acc[ai][bj][m][1];
                if (MODE == 1) { f32x4 e0, e1; unpack8(*(const u32x4*)(Eb + (size_t)row * 1024 + col), e0, e1);
#pragma unroll
                    for (int e = 0; e < 4; ++e) { d0[e] = sigmoidf_(d0[e]) * e0[e]; d1[e] = sigmoidf_(d1[e]) * e1[e]; } }
                x0 += d0; x1 += d1;
                *(f32x4*)xp = x0; *(f32x4*)(xp + 4) = x1;
                if (XB) *(u32x4*)(XB + (size_t)row * 1024 + col) = pack8(x0, x1);
                s += (x0[0] * x0[0] + x0[1] * x0[1]) + (x0[2] * x0[2] + x0[3] * x0[3]) + (x1[0] * x1[0] + x1[1] * x1[1]) + (x1[2] * x1[2] + x1[3] * x1[3]); }
            s += __shfl_xor(s, 16); s += __shfl_xor(s, 32);
            if (fq == 0) ssq[(size_t)row * 16 + u.pn * 4 + wc] = s; }
    }
};

struct EpiRouter {
    float* RL;
    __device__ __forceinline__ void operator()(const f32x4 (&acc)[2][2][4][2], const Unit& u, int wr, int wc, int fr, int fq) const {
        const int c0 = wc * 32 + 8 * fq;
        if (c0 < 72) {
            EPI_FOR_ROWS { const int row = EPI_ROW(ai, m); float* p = RL + ((size_t)u.pn * T + row) * 72 + c0;
                *(f32x4*)p = acc[ai][0][m][0]; *(f32x4*)(p + 4) = acc[ai][0][m][1]; }
        }
    }
};

struct EpiExp1 {
    const float* row_rs; bf16_t* H;
    __device__ __forceinline__ void operator()(const f32x4 (&acc)[2][2][4][2], const Unit& u, int wr, int wc, int fr, int fq) const {
        EPI_FOR_ROWS { const int row = EPI_ROW(ai, m); const float rs = row_rs[row];
            f32x4 h[2];
#pragma unroll
            for (int n = 0; n < 2; ++n)
#pragma unroll
                for (int e = 0; e < 4; ++e) { const float gt = acc[ai][0][m][n][e] * rs, up = acc[ai][1][m][n][e] * rs; h[n][e] = gt * sigmoidf_(gt) * up; }
            *(u32x4*)(H + (size_t)row * 256 + u.pn * 128 + wc * 32 + 8 * fq) = pack8(h[0], h[1]); }
    }
};
struct EpiExp2 {
    const float* row_w; bf16_t* YS;
    __device__ __forceinline__ void operator()(const f32x4 (&acc)[2][2][4][2], const Unit& u, int wr, int wc, int fr, int fq) const {
        EPI_FOR_ROWS { const int row = EPI_ROW(ai, m); const float w = row_w[row];
#pragma unroll
            for (int bj = 0; bj < 2; ++bj) *(u32x4*)(YS + (size_t)row * 1024 + u.pn * 256 + bj * 128 + wc * 32 + 8 * fq) = pack8(acc[ai][bj][m][0] * w, acc[ai][bj][m][1] * w); }
    }
};

struct RouterOrder {
    int G, c;
    __device__ __forceinline__ bool next(int i, Unit& u) const { const int L = i * G + c; if (L >= 256) return false;
        u.pm = L >> 2; u.pn = L & 3; u.a_off = (unsigned)u.pm * 256u * 1024u + (unsigned)u.pn * 256u; u.b_off = (unsigned)u.pn * 256u; return true; }
};
template <int NJ> struct ExpertOrder {
    const int* blk_e; int G, c;
    __device__ __forceinline__ bool next(int i, Unit& u) const { const int nblk = blk_e[255]; const int L = i * G + c; if (L >= nblk * NJ) return false;
        const int blk = L / NJ, j = L % NJ, e = blk_e[blk]; u.pm = blk; u.pn = j;
        if (NJ == 2) { u.a_off = 0u; u.b_off = (unsigned)(e * 512 + j * 256) * 1024u; } else { u.a_off = (unsigned)blk * 256u * 256u; u.b_off = (unsigned)(e * 1024 + j * 256) * 256u; }
        return true; }
};

__device__ __forceinline__ void tr_item(const float* W, int ldw, int n_src0, const float* g, bf16_t* WT, int K, int n_dst0, int k0, LAS float* scr, int lane) {
#pragma unroll 8
    for (int i = 0; i < 32; ++i) { const int kk = 2 * i + (lane >> 5); float v = W[(size_t)(k0 + kk) * ldw + n_src0 + (lane & 31)]; if (g) v *= g[k0 + kk]; scr[kk * 33 + (lane & 31)] = v; }
    LDS_WAIT(); asm volatile("" ::: "memory");
    const int c = lane & 7;
#pragma unroll
    for (int j = 0; j < 4; ++j) { const int n = (lane >> 3) + 8 * j; const LAS float* s = scr + (8 * c) * 33 + n;
        u32x4 o; o.x = cvt_pk_bf16(s[0 * 33], s[1 * 33]); o.y = cvt_pk_bf16(s[2 * 33], s[3 * 33]); o.z = cvt_pk_bf16(s[4 * 33], s[5 * 33]); o.w = cvt_pk_bf16(s[6 * 33], s[7 * 33]);
        *(u32x4*)(WT + (size_t)(n_dst0 + n) * K + k0 + 8 * c) = o; }
    LDS_WAIT(); asm volatile("" ::: "memory");
}

__device__ __forceinline__ void prologue(Frame& F, const AS4 Args* a) {
    LAS float* scr = (LAS float*)(F.lds + F.wave * 16384);
    const int gw = F.vcu * NWAVES + F.wave, NGW = F.G * NWAVES;
    const float* x = (const float*)a->in[0]; const float* p = (const float*)a->in[1]; const int* pos = (const int*)a->in[2];
    const float* g_mix = (const float*)a->in[3]; const float* w_in = (const float*)a->in[4]; const float* g_q = (const float*)a->in[5]; const float* w_q = (const float*)a->in[6];
    const float* g_kv = (const float*)a->in[7]; const float* w_kv = (const float*)a->in[8]; const float* w_a = (const float*)a->in[9]; const float* w_b = (const float*)a->in[10];
    const float* w_o = (const float*)a->in[11]; const float* g_ffn = (const float*)a->in[12]; const float* w_rg = (const float*)a->in[13]; const float* w_re = (const float*)a->in[15];
    const float* w_eg = (const float*)a->in[17]; const float* w_eu = (const float*)a->in[18]; const float* w_ed = (const float*)a->in[19];
    const float* w_pg = (const float*)a->in[21]; const float* w_pp = (const float*)a->in[22];
    unsigned char* ws = F.ws;
    constexpr int I_IN = 16 * 161, I_Q = 8 * 48, I_KV = 4 * 64, I_A = 16 * 32, I_B = 4 * 32, I_E13 = 64 * 256, I_E2 = 64 * 128;
    constexpr int I_LAYER = I_IN + I_Q + I_KV + I_A + I_B + I_A + I_A + I_B + I_E13 + I_E2;
    for (int it = gw; it < DEPTH * I_LAYER; it += NGW) {
        const int l = it / I_LAYER; int r = it % I_LAYER;
        unsigned char* wd = ws + WS_WD + (size_t)l * WD_STRIDE;
        if (r < I_IN) { const int kb = r / 161, nb = r % 161, ns = nb * 32; const int nd = ns < 768 ? ns : (ns < 800 ? 5120 : ns - 32);
            tr_item(w_in + (size_t)l * 1024 * NIN_SRC, NIN_SRC, ns, g_mix + l * 1024, (bf16_t*)(wd + WD_IN), 1024, nd, kb * 64, scr, F.lane); continue; } r -= I_IN;
        if (r < I_Q) { const int kb = r / 48, nb = r % 48;
            tr_item(w_q + (size_t)l * 512 * 1536, 1536, nb * 32, g_q + l * 512, (bf16_t*)(wd + WD_Q), 512, nb * 32, kb * 64, scr, F.lane); continue; } r -= I_Q;
        if (r < I_KV) { const int kb = r / 64, nb = r % 64, h = nb >> 2, part = nb & 3;
            tr_item(w_kv + (size_t)l * 256 * 2048, 2048, nb * 32, g_kv + l * 256, (bf16_t*)(wd + (part < 2 ? WD_K : WD_V)), 256, h * 64 + (part & 1) * 32, kb * 64, scr, F.lane); continue; } r -= I_KV;
        if (r < I_A) { const int kb = r / 32, nb = r % 32; tr_item(w_a + (size_t)l * 1024 * 1024, 1024, nb * 32, nullptr, (bf16_t*)(wd + WD_A), 1024, nb * 32, kb * 64, scr, F.lane); continue; } r -= I_A;
        if (r < I_B) { const int kb = r / 32, nb = r % 32; tr_item(w_b + (size_t)l * 256 * 1024, 1024, nb * 32, nullptr, (bf16_t*)(wd + WD_B), 256, nb * 32, kb * 64, scr, F.lane); continue; } r -= I_B;
        if (r < I_A) { const int kb = r / 32, nb = r % 32; tr_item(w_o + (size_t)l * 1024 * 1024, 1024, nb * 32, nullptr, (bf16_t*)(wd + WD_O), 1024, nb * 32, kb * 64, scr, F.lane); continue; } r -= I_A;
        if (r < I_A) { const int kb = r / 32, nb = r % 32; tr_item(w_pg + (size_t)l * 1024 * 1024, 1024, nb * 32, nullptr, (bf16_t*)(wd + WD_G), 1024, nb * 32, kb * 64, scr, F.lane); continue; } r -= I_A;
        if (r < I_B) { const int kb = r / 32, nb = r % 32; tr_item(w_pp + (size_t)l * 256 * 1024, 1024, nb * 32, nullptr, (bf16_t*)(wd + WD_P), 256, nb * 32, kb * 64, scr, F.lane); continue; } r -= I_B;
        if (r < I_E13) { const int e = r >> 8, q = r & 255, up = q >> 7, kb = (q & 127) >> 3, nb = q & 7; const int f0 = nb * 32, nd = (f0 >> 7) * 256 + up * 128 + (f0 & 127);
            tr_item((up ? w_eu : w_eg) + ((size_t)l * 64 + e) * 1024 * 256, 256, f0, g_ffn + l * 1024, (bf16_t*)(ws + WS_W13 + (size_t)l * W13_STRIDE) + (size_t)e * 512 * 1024, 1024, nd, kb * 64, scr, F.lane); continue; } r -= I_E13;
        { const int e = r >> 7, q = r & 127, kb = q >> 5, nb = q & 31;
            tr_item(w_ed + ((size_t)l * 64 + e) * 256 * 1024, 1024, nb * 32, nullptr, (bf16_t*)(ws + WS_W2 + (size_t)l * W2_STRIDE) + (size_t)e * 1024 * 256, 256, nb * 32, kb * 64, scr, F.lane); }
    }
    const int gt = F.vcu * NTHR + F.tid, NGT = F.G * NTHR;
    for (int i = gt; i < DEPTH * 256 * 1024; i += NGT) { const int l = i >> 18, n = (i >> 10) & 255, k = i & 1023;
        float v = 0.f; if (n < 8) v = w_rg[((size_t)l * 1024 + k) * 8 + n] * g_ffn[l * 1024 + k]; else if (n < 72) v = w_re[((size_t)l * 1024 + k) * 64 + (n - 8)] * g_ffn[l * 1024 + k];
        ((bf16_t*)(ws + WS_WD + (size_t)l * WD_STRIDE + WD_R))[n * 1024 + k] = (bf16_t)(cvt_pk_bf16(v, 0.f) & 0xffffu); }
    for (int i = gt; i < T * 16; i += NGT) { const int row = i >> 4, j = i & 15; const float inv = exp2f(-(float)j * (1.0f / 16.0f) * 13.287712379549449f);
        const float ang = (float)pos[row] * inv; ((f32x2*)(ws + WS_ROPE_MLA))[i] = (f32x2){cosf(ang), sinf(ang)}; }
    for (int i = gt; i < T * 8; i += NGT) { const int row = i >> 3, j = i & 7; const float inv = exp2f(-(float)j * (1.0f / 8.0f) * 18.931568569324174f);
        const float ang = (float)pos[row] * inv; ((f32x2*)(ws + WS_ROPE_DIL))[i] = (f32x2){cosf(ang), sinf(ang)}; }
    for (size_t i = gt; i < (size_t)DEPTH * T * 256 / 8; i += NGT) { const f32x4 a0 = ((const f32x4*)p)[2 * i], a1 = ((const f32x4*)p)[2 * i + 1]; ((u32x4*)(ws + WS_PB))[i] = pack8(a0, a1); }
    float* ssq1 = (float*)(ws + WS_SSQ1); bf16_t* XB = (bf16_t*)(ws + WS_XB);
    for (int m = gw; m < T; m += NGW) { const f32x4* xr = (const f32x4*)(x + (size_t)m * 1024) + F.lane; f32x4 v[4]; float s = 0.f;
#pragma unroll
        for (int j = 0; j < 4; ++j) { v[j] = xr[64 * j]; s += (v[j][0] * v[j][0] + v[j][1] * v[j][1]) + (v[j][2] * v[j][2] + v[j][3] * v[j][3]); }
        s = wave_sum(s); if (F.lane < 16) ssq1[(size_t)m * 16 + F.lane] = F.lane == 0 ? s : 0.f;
#pragma unroll
        for (int j = 0; j < 4; ++j) { ((f32x4*)(F.X + (size_t)m * 1024))[F.lane + 64 * j] = v[j];
            ((u32x2*)(XB + (size_t)m * 1024))[F.lane + 64 * j] = (u32x2){cvt_pk_bf16(v[j][0], v[j][1]), cvt_pk_bf16(v[j][2], v[j][3])}; } }
}

__device__ __forceinline__ void mla_attn_scalar(Frame& F) {
    unsigned char* ws = F.ws;
    const bf16_t* Q = (const bf16_t*)(ws + WS_Q); const bf16_t* KN = (const bf16_t*)(ws + WS_KN); const bf16_t* KPE = (const bf16_t*)(ws + WS_KPE); const bf16_t* V = (const bf16_t*)(ws + WS_V);
    bf16_t* OA = (bf16_t*)(ws + WS_OA);
    LAS float* Ks = (LAS float*)F.lds; LAS float* Vs = Ks + 32 * 96;
    const float scale = 0.10206207261596575f;
    for (int u = F.vcu; u < 512; u += F.G) {
        const int qc = 3 - (u >> 7), bh = u & 127, b = bh >> 4, h = bh & 15;
        const int tq = qc * 512 + F.tid; const size_t rowq = (size_t)b * SEQ + tq;
        float q[96], o[64];
#pragma unroll
        for (int c = 0; c < 12; ++c) { f32x4 a0, a1; unpack8(*(const u32x4*)(Q + rowq * 1536 + h * 96 + c * 8), a0, a1);
#pragma unroll
            for (int e = 0; e < 4; ++e) { q[c * 8 + e] = a0[e] * scale; q[c * 8 + 4 + e] = a1[e] * scale; } }
#pragma unroll
        for (int d = 0; d < 64; ++d) o[d] = 0.f;
        float mx = -1e30f, l = 0.f;
        const int nkt = (qc * 512 + 512) / 32; const int tq_wmax = qc * 512 + (F.tid | 63);
        for (int kt = 0; kt < nkt; ++kt) {
            __syncthreads();
            for (int c = F.tid; c < 640; c += NTHR) { const int key = c / 20, part = c % 20; const size_t row = (size_t)b * SEQ + kt * 32 + key;
                const bf16_t* src = part < 8 ? KN + row * 1024 + h * 64 + part * 8 : (part < 12 ? KPE + row * 32 + (part - 8) * 8 : V + row * 1024 + h * 64 + (part - 12) * 8);
                LAS float* dst = part < 12 ? Ks + key * 96 + part * 8 : Vs + key * 64 + (part - 12) * 8;
                f32x4 a0, a1; unpack8(*(const u32x4*)src, a0, a1); *(LAS f32x4*)dst = a0; *(LAS f32x4*)(dst + 4) = a1; }
            __syncthreads();
            if (kt * 32 <= tq_wmax) {
                for (int key = 0; key < 32; ++key) { const int kpos = kt * 32 + key; float s = 0.f;
#pragma unroll
                    for (int d = 0; d < 96; d += 4) { const f32x4 kk = *(const LAS f32x4*)(Ks + key * 96 + d); s += q[d] * kk[0] + q[d + 1] * kk[1] + q[d + 2] * kk[2] + q[d + 3] * kk[3]; }
                    if (kpos <= tq) { const float mn = fmaxf(mx, s), al = __expf(mx - mn), pp = __expf(s - mn); l = l * al + pp; mx = mn;
#pragma unroll
                        for (int d = 0; d < 64; d += 4) { const f32x4 vv = *(const LAS f32x4*)(Vs + key * 64 + d); o[d] = o[d] * al + pp * vv[0]; o[d + 1] = o[d + 1] * al + pp * vv[1]; o[d + 2] = o[d + 2] * al + pp * vv[2]; o[d + 3] = o[d + 3] * al + pp * vv[3]; } } }
            }
        }
        const float il = 1.0f / l;
#pragma unroll
        for (int c = 0; c < 8; ++c) { u32x4 w; w.x = cvt_pk_bf16(o[c * 8] * il, o[c * 8 + 1] * il); w.y = cvt_pk_bf16(o[c * 8 + 2] * il, o[c * 8 + 3] * il); w.z = cvt_pk_bf16(o[c * 8 + 4] * il, o[c * 8 + 5] * il); w.w = cvt_pk_bf16(o[c * 8 + 6] * il, o[c * 8 + 7] * il);
            *(u32x4*)(OA + rowq * 1024 + h * 64 + c * 8) = w; }
    }
    __syncthreads();
}

__device__ __forceinline__ void dil_attn_scalar(Frame& F) {
    unsigned char* ws = F.ws; const bf16_t* DIL = (const bf16_t*)(ws + WS_DIL); bf16_t* OB = (bf16_t*)(ws + WS_OB);
    for (int u = F.vcu; u < 128; u += F.G) {
        const int id = u * NTHR + F.tid, t = id & 2047, h = (id >> 11) & 3, b = id >> 13; const size_t row = (size_t)b * SEQ + t;
        float o[64]; float mx = -1e30f, l = 0.f;
#pragma unroll
        for (int d = 0; d < 64; ++d) o[d] = 0.f;
#pragma unroll 1
        for (int g = 0; g < 3; ++g) { const int dil = g == 0 ? 1 : (g == 1 ? 4 : 16);
            float q[64];
#pragma unroll
            for (int c = 0; c < 8; ++c) { f32x4 a0, a1; unpack8(*(const u32x4*)(DIL + row * 2304 + g * 768 + h * 64 + c * 8), a0, a1);
#pragma unroll
                for (int e = 0; e < 4; ++e) { q[c * 8 + e] = a0[e] * 0.125f; q[c * 8 + 4 + e] = a1[e] * 0.125f; } }
#pragma unroll 1
            for (int j = 0; j <= 128; ++j) { const int tk = t - j * dil; const bool valid = tk >= 0; if (!__any(valid)) break;
                if (valid) { const bf16_t* kp = DIL + ((size_t)b * SEQ + tk) * 2304 + g * 768 + 256 + h * 64; float s = 0.f;
#pragma unroll
                    for (int c = 0; c < 8; ++c) { f32x4 a0, a1; unpack8(*(const u32x4*)(kp + c * 8), a0, a1);
#pragma unroll
                        for (int e = 0; e < 4; ++e) s += q[c * 8 + e] * a0[e] + q[c * 8 + 4 + e] * a1[e]; }
                    const float mn = fmaxf(mx, s), al = __expf(mx - mn), pp = __expf(s - mn); l = l * al + pp; mx = mn;
#pragma unroll
                    for (int c = 0; c < 8; ++c) { f32x4 a0, a1; unpack8(*(const u32x4*)(kp + 256 + c * 8), a0, a1);
#pragma unroll
                        for (int e = 0; e < 4; ++e) { o[c * 8 + e] = o[c * 8 + e] * al + pp * a0[e]; o[c * 8 + 4 + e] = o[c * 8 + 4 + e] * al + pp * a1[e]; } } } }
        }
        const float il = 1.0f / l;
#pragma unroll
        for (int c = 0; c < 8; ++c) { u32x4 w; w.x = cvt_pk_bf16(o[c * 8] * il, o[c * 8 + 1] * il); w.y = cvt_pk_bf16(o[c * 8 + 2] * il, o[c * 8 + 3] * il); w.z = cvt_pk_bf16(o[c * 8 + 4] * il, o[c * 8 + 5] * il); w.w = cvt_pk_bf16(o[c * 8 + 6] * il, o[c * 8 + 7] * il);
            *(u32x4*)(OB + row * 256 + h * 64 + c * 8) = w; }
    }
}

__device__ __forceinline__ void dispatch1(Frame& F, const float* b_g, const float* b_e, int l) {
    unsigned char* ws = F.ws; const float* RL = (const float*)(ws + WS_RL); const float* ssq2 = (const float*)(ws + WS_SSQ2) + (size_t)l * T * 16;
    int* tok_e = (int*)(ws + RT_TOK_E); float* tok_w = (float*)(ws + RT_TOK_W); float* tok_rs = (float*)(ws + RT_TOK_RS);
    int* cnt = (int*)(ws + CTL_CNT) + l * 64;
    LAS int* hist = (LAS int*)F.lds;
    if (F.tid < 64) hist[F.tid] = 0;
    __syncthreads();
    for (int t = F.vcu * NTHR + F.tid; t < T; t += F.G * NTHR) {
        const float rs = rsqrtf(part_sum<16>(ssq2 + (size_t)t * 16) * (1.0f / 1024.0f) + EPS);
        float gl[8];
#pragma unroll
        for (int j = 0; j < 8; ++j) { float s = 0.f;
#pragma unroll
            for (int ks = 0; ks < 4; ++ks) s += RL[((size_t)ks * T + t) * 72 + j];
            gl[j] = s * rs + b_g[j]; }
        int gs = 0; float gm = gl[0];
#pragma unroll
        for (int j = 1; j < 8; ++j) if (gl[j] > gm) { gm = gl[j]; gs = j; }
        float den = 0.f;
#pragma unroll
        for (int j = 0; j < 8; ++j) den += __expf(gl[j] - gm);
        const float pg = 1.0f / den;
        float el[8];
#pragma unroll
        for (int j = 0; j < 8; ++j) { float s = 0.f;
#pragma unroll
            for (int ks = 0; ks < 4; ++ks) s += RL[((size_t)ks * T + t) * 72 + 8 + gs * 8 + j];
            el[j] = s * rs + b_e[gs * 8 + j]; }
        int i0 = 0; float v0 = el[0];
#pragma unroll
        for (int j = 1; j < 8; ++j) if (el[j] > v0) { v0 = el[j]; i0 = j; }
        int i1 = -1; float v1 = -3.0e38f;
#pragma unroll
        for (int j = 0; j < 8; ++j) if (j != i0 && el[j] > v1) { v1 = el[j]; i1 = j; }
        const float ex = __expf(v1 - v0), w0 = pg / (1.0f + ex), w1 = pg * ex / (1.0f + ex);
        const int e0 = gs * 8 + i0, e1 = gs * 8 + i1;
        tok_e[2 * t] = e0; tok_e[2 * t + 1] = e1; tok_w[2 * t] = w0; tok_w[2 * t + 1] = w1; tok_rs[t] = rs;
        atomicAdd((int*)&hist[e0], 1); atomicAdd((int*)&hist[e1], 1);
    }
    __syncthreads();
    if (F.tid < 64 && hist[F.tid]) atomicAdd(cnt + F.tid, hist[F.tid]);
    __syncthreads();
}
__device__ __forceinline__ void dispatch2(Frame& F, int l) {
    unsigned char* ws = F.ws;
    const int* tok_e = (const int*)(ws + RT_TOK_E); const float* tok_w = (const float*)(ws + RT_TOK_W); const float* tok_rs = (const float*)(ws + RT_TOK_RS);
    int* dest = (int*)(ws + RT_DEST); int* row_tok = (int*)(ws + RT_ROW_TOK); float* row_w = (float*)(ws + RT_ROW_W); float* row_rs = (float*)(ws + RT_ROW_RS); int* blk_e = (int*)(ws + RT_BLK_E);
    const int* cnt = (const int*)(ws + CTL_CNT) + l * 64; int* fill = (int*)(ws + CTL_CNT) + 256 + l * 64;
    LAS int* pst = (LAS int*)F.lds;
    if (F.tid < 64) pst[64 + F.tid] = cnt[F.tid];
    __syncthreads();
    if (F.tid == 0) { int acc = 0; for (int e = 0; e < 64; ++e) { pst[e] = acc; acc += (pst[64 + e] + 255) & ~255; } pst[128] = acc; }
    __syncthreads();
    for (int t = F.vcu * NTHR + F.tid; t < T; t += F.G * NTHR) {
#pragma unroll
        for (int k = 0; k < 2; ++k) { const int e = tok_e[2 * t + k]; const int slot = pst[e] + atomicAdd(fill + e, 1);
            row_tok[slot] = t; row_w[slot] = tok_w[2 * t + k]; row_rs[slot] = tok_rs[t]; dest[2 * t + k] = slot; }
    }
    for (int e = F.vcu; e < 64; e += F.G) { const int c = pst[64 + e], pc = (c + 255) & ~255;
        for (int s = c + F.tid; s < pc; s += NTHR) { row_tok[pst[e] + s] = 0; row_w[pst[e] + s] = 0.f; row_rs[pst[e] + s] = 0.f; } }
    if (F.vcu == 0) { const int nblk = pst[128] >> 8;
        for (int bk = F.tid; bk < nblk; bk += NTHR) { int ee = 0; for (int j = 0; j < 64; ++j) if (pst[64 + j] > 0 && pst[j] <= bk * 256) ee = j; blk_e[bk] = ee; }
        if (F.tid == 0) blk_e[255] = nblk; }
    __syncthreads();
}

__device__ __forceinline__ void combine_norm(Frame& F, const float* g_ple) {
    unsigned char* ws = F.ws; const bf16_t* YS = (const bf16_t*)(ws + WS_YS); const int* dest = (const int*)(ws + RT_DEST); bf16_t* XN = (bf16_t*)(ws + WS_XN);
    const int gw = F.vcu * NWAVES + F.wave, NGW = F.G * NWAVES;
    f32x4 gp[4];
#pragma unroll
    for (int j = 0; j < 4; ++j) gp[j] = ((const f32x4*)g_ple)[F.lane + 64 * j];
    for (int m = gw; m < T; m += NGW) { const int d0 = dest[2 * m], d1 = dest[2 * m + 1];
        f32x4* xr = (f32x4*)(F.X + (size_t)m * 1024) + F.lane; const u32x2* y0 = (const u32x2*)(YS + (size_t)d0 * 1024) + F.lane; const u32x2* y1 = (const u32x2*)(YS + (size_t)d1 * 1024) + F.lane;
        f32x4 v[4]; float s = 0.f;
#pragma unroll
        for (int j = 0; j < 4; ++j) { v[j] = xr[64 * j]; const u32x2 a = y0[64 * j], b = y1[64 * j];
#ifndef EXP_NO_MOE
            v[j][0] += bf_lo(a.x) + bf_lo(b.x); v[j][1] += bf_hi(a.x) + bf_hi(b.x); v[j][2] += bf_lo(a.y) + bf_lo(b.y); v[j][3] += bf_hi(a.y) + bf_hi(b.y);
#endif
            s += (v[j][0] * v[j][0] + v[j][1] * v[j][1]) + (v[j][2] * v[j][2] + v[j][3] * v[j][3]); }
        const float rs = rsqrtf(wave_sum(s) * (1.0f / 1024.0f) + EPS);
#pragma unroll
        for (int j = 0; j < 4; ++j) { xr[64 * j] = v[j]; const f32x4 n = v[j] * rs * gp[j];
            ((u32x2*)(XN + (size_t)m * 1024))[F.lane + 64 * j] = (u32x2){cvt_pk_bf16(n[0], n[1]), cvt_pk_bf16(n[2], n[3])}; } }
}
__device__ __forceinline__ void final_norm(Frame& F, const float* g_final) {
    const float* ssq = (const float*)(F.ws + WS_SSQ1) + (size_t)4 * T * 16;
    const int gw = F.vcu * NWAVES + F.wave, NGW = F.G * NWAVES;
    f32x4 gp[4];
#pragma unroll
    for (int j = 0; j < 4; ++j) gp[j] = ((const f32x4*)g_final)[F.lane + 64 * j];
    for (int m = gw; m < T; m += NGW) { const float rs = rsqrtf(part_sum<16>(ssq + (size_t)m * 16) * (1.0f / 1024.0f) + EPS); f32x4* xr = (f32x4*)(F.X + (size_t)m * 1024) + F.lane;
#pragma unroll
        for (int j = 0; j < 4; ++j) xr[64 * j] = xr[64 * j] * rs * gp[j]; }
}

constexpr int PH_PER_LAYER = 13, N_PHASES = 2 + DEPTH * PH_PER_LAYER;
__global__ void __launch_bounds__(NTHR, 2) fwd_kernel(Args args) {
    extern __shared__ __attribute__((aligned(16))) unsigned char lds_raw[];
    Frame F;
    F.lds = (LAS unsigned char*)lds_raw;
    F.tid = threadIdx.x; F.lane = F.tid & 63; F.wave = __builtin_amdgcn_readfirstlane(F.tid >> 6);
    F.G = gridDim.x; { const int bx = blockIdx.x; F.vcu = (F.G % 8 == 0) ? (bx % 8) * (F.G / 8) + bx / 8 : bx; }
    F.ws = nullptr; F.X = nullptr;
    for (int u = F.tid; u < (LDS_BYTES - LDSCTL_OFF) / 4; u += NTHR) ((LAS unsigned*)(F.lds + LDSCTL_OFF))[u] = 0u;
    __syncthreads();
    const int lo = args.ph_lo, hi = args.ph_hi;
    const bool use_bar = (hi - lo) > 1;
    XcdBarrier bar; bar.bar = (unsigned*)(args.ws + WS_CTL) + CW_BAR; bar.x = 0; bar.st = nullptr;
    if (use_bar) bar = xcd_barrier_post((unsigned*)(args.ws + WS_CTL) + CW_BAR, (volatile LAS unsigned*)(F.lds + MISC_OFF + 32));
#ifndef PH_EN
#define PH_EN(j) 1
#endif
#define IN(k) (lo <= (k) && (k) < hi)
#define INL(j) (PH_EN(j) && IN(p0 + (j)))
#define SEAM(k) do { if (IN(k) && IN((k) + 1)) xcd_barrier(bar); } while (0)
#define KARGS() ({ const AS4 Args* _p = (const AS4 Args*)__builtin_amdgcn_kernarg_segment_ptr(); asm volatile("" : "+s"(_p)); _p; })
#define PHASE_ENV const AS4 Args* ap = KARGS(); unsigned char* ws = ap->ws; Frame P = F; P.ws = ws; P.X = ap->out; int cidl = cid; \
    asm volatile("" : "+v"(P.tid), "+v"(P.lane)); asm volatile("" : "+s"(P.vcu), "+s"(P.G), "+s"(P.wave), "+s"(cidl)); (void)ws; (void)cidl
    const int cid = (int)blockIdx.x;

    if (IN(0)) { PHASE_ENV; prologue(P, ap); }
    SEAM(0);

#pragma unroll 1
    for (int l = 0; l < DEPTH; ++l) {
        const int p0 = 1 + PH_PER_LAYER * l;
        if (INL(0)) {
            PHASE_ENV; unsigned char* wd = ws + WS_WD + (size_t)l * WD_STRIDE;
            pg8::Gemm g{(const bf16_t*)(ws + WS_XB), (const bf16_t*)(wd + WD_IN), 1024, 1024, 1024, nullptr}; pg8::DenseOrder S; S.init(64, 21, 1024, 1024, P.G, cidl);
            EpiInProj E{(const float*)(ws + WS_SSQ1) + (size_t)l * T * 16, (bf16_t*)(ws + WS_CQ), (bf16_t*)(ws + WS_CKV), (bf16_t*)(ws + WS_KPE), (bf16_t*)(ws + WS_DIL), (bf16_t*)(ws + WS_SG),
                        (float*)(ws + WS_SSQQ) + (size_t)l * T * 8, (float*)(ws + WS_SSQKV) + (size_t)l * T * 4, (const f32x2*)(ws + WS_ROPE_DIL), (const f32x2*)(ws + WS_ROPE_MLA)};
#ifdef EXP_SIMPLE_EPI
            EpiScaleStore E2{nullptr, 0.f, (bf16_t*)(ws + WS_YS), NIN}; pg8::gemm_phase<EpiScaleStore, pg8::DenseOrder, false, true>(P.lds, g, S, E2); (void)E;
#else
            pg8::gemm_phase<EpiInProj, pg8::DenseOrder, false, true>(P.lds, g, S, E);
#endif
        }
        SEAM(p0 + 0);
        if (INL(1)) {
            { PHASE_ENV; unsigned char* wd = ws + WS_WD + (size_t)l * WD_STRIDE;
              pg8::Gemm g{(const bf16_t*)(ws + WS_CQ), (const bf16_t*)(wd + WD_Q), 512, 512, 512, nullptr}; pg8::DenseOrder S; S.init(64, 6, 512, 512, P.G, cidl);
              EpiQup E{(const float*)(ws + WS_SSQQ) + (size_t)l * T * 8, (bf16_t*)(ws + WS_Q), (const f32x2*)(ws + WS_ROPE_MLA)}; pg8::gemm_phase<EpiQup, pg8::DenseOrder, false, true>(P.lds, g, S, E); }
            { PHASE_ENV; unsigned char* wd = ws + WS_WD + (size_t)l * WD_STRIDE;
              pg8::Gemm g{(const bf16_t*)(ws + WS_CKV), (const bf16_t*)(wd + WD_K), 256, 256, 256, nullptr}; pg8::DenseOrder S; S.init(64, 4, 256, 256, P.G, cidl);
              EpiScaleStore E{(const float*)(ws + WS_SSQKV) + (size_t)l * T * 4, 1.0f / 256.0f, (bf16_t*)(ws + WS_KN), 1024}; pg8::gemm_phase<EpiScaleStore, pg8::DenseOrder, false, true>(P.lds, g, S, E); }
            { PHASE_ENV; unsigned char* wd = ws + WS_WD + (size_t)l * WD_STRIDE;
              pg8::Gemm g{(const bf16_t*)(ws + WS_CKV), (const bf16_t*)(wd + WD_V), 256, 256, 256, nullptr}; pg8::DenseOrder S; S.init(64, 4, 256, 256, P.G, cidl);
              EpiScaleStore E{(const float*)(ws + WS_SSQKV) + (size_t)l * T * 4, 1.0f / 256.0f, (bf16_t*)(ws + WS_V), 1024}; pg8::gemm_phase<EpiScaleStore, pg8::DenseOrder, false, true>(P.lds, g, S, E); }
        }
        SEAM(p0 + 1);
        if (INL(2)) { { PHASE_ENV; mla_attn_scalar(P); } { PHASE_ENV; dil_attn_scalar(P); } }
        SEAM(p0 + 2);
        if (INL(3)) {
            PHASE_ENV; unsigned char* wd = ws + WS_WD + (size_t)l * WD_STRIDE;
            pg8::Gemm g{(const bf16_t*)(ws + WS_OB), (const bf16_t*)(wd + WD_B), 256, 256, 256, nullptr}; pg8::DenseOrder S; S.init(64, 4, 256, 256, P.G, cidl);
            EpiGate<0> E{(const bf16_t*)(ws + WS_SG), 1024, nullptr, (bf16_t*)(ws + WS_TMPB)}; pg8::gemm_phase<EpiGate<0>, pg8::DenseOrder, false, false>(P.lds, g, S, E);
        }
        SEAM(p0 + 3);
        if (INL(4)) {
            PHASE_ENV; unsigned char* wd = ws + WS_WD + (size_t)l * WD_STRIDE;
            pg8::Gemm g{(const bf16_t*)(ws + WS_OA), (const bf16_t*)(wd + WD_A), 1024, 1024, 1024, nullptr}; pg8::DenseOrder S; S.init(64, 4, 1024, 1024, P.G, cidl);
            EpiGate<1> E{(const bf16_t*)(ws + WS_SG), 0, (const bf16_t*)(ws + WS_TMPB), (bf16_t*)(ws + WS_MERGED)}; pg8::gemm_phase<EpiGate<1>, pg8::DenseOrder, false, false>(P.lds, g, S, E);
        }
        SEAM(p0 + 4);
        if (INL(5)) {
            PHASE_ENV; unsigned char* wd = ws + WS_WD + (size_t)l * WD_STRIDE;
            pg8::Gemm g{(const bf16_t*)(ws + WS_MERGED), (const bf16_t*)(wd + WD_O), 1024, 1024, 1024, nullptr}; pg8::DenseOrder S; S.init(64, 4, 1024, 1024, P.G, cidl);
            EpiResid<0> E{P.X, (bf16_t*)(ws + WS_XB), (float*)(ws + WS_SSQ2) + (size_t)l * T * 16, nullptr}; pg8::gemm_phase<EpiResid<0>, pg8::DenseOrder, false, false>(P.lds, g, S, E);
        }
        SEAM(p0 + 5);
        if (INL(6)) {
            { PHASE_ENV; unsigned char* wd = ws + WS_WD + (size_t)l * WD_STRIDE;
              pg8::Gemm g{(const bf16_t*)(ws + WS_XB), (const bf16_t*)(wd + WD_R), 1024, 1024, 256, nullptr}; RouterOrder S{P.G, cidl};
              EpiRouter E{(float*)(ws + WS_RL)}; pg8::gemm_phase<EpiRouter, RouterOrder, false, false>(P.lds, g, S, E); }
            { PHASE_ENV; unsigned char* wd = ws + WS_WD + (size_t)l * WD_STRIDE;
              pg8::Gemm g{(const bf16_t*)(ws + WS_PB) + (size_t)l * T * 256, (const bf16_t*)(wd + WD_P), 256, 256, 256, nullptr}; pg8::DenseOrder S; S.init(64, 4, 256, 256, P.G, cidl);
              EpiScaleStore E{nullptr, 0.f, (bf16_t*)(ws + WS_E), 1024}; pg8::gemm_phase<EpiScaleStore, pg8::DenseOrder, false, false>(P.lds, g, S, E); }
        }
        SEAM(p0 + 6);
        if (INL(7)) { PHASE_ENV; dispatch1(P, (const float*)ap->in[14] + l * 8, (const float*)ap->in[16] + l * 64, l); }
        SEAM(p0 + 7);
        if (INL(8)) { PHASE_ENV; dispatch2(P, l); }
        SEAM(p0 + 8);
        if (INL(9)) {
            PHASE_ENV;
            pg8::Gemm g{(const bf16_t*)(ws + WS_XB), (const bf16_t*)(ws + WS_W13 + (size_t)l * W13_STRIDE), 1024, 1024, 1024, (const int*)(ws + RT_ROW_TOK)}; ExpertOrder<2> S{(const int*)(ws + RT_BLK_E), P.G, cidl};
            EpiExp1 E{(const float*)(ws + RT_ROW_RS), (bf16_t*)(ws + WS_H)}; pg8::gemm_phase<EpiExp1, ExpertOrder<2>, true, true>(P.lds, g, S, E);
        }
        SEAM(p0 + 9);
        if (INL(10)) {
            PHASE_ENV;
            pg8::Gemm g{(const bf16_t*)(ws + WS_H), (const bf16_t*)(ws + WS_W2 + (size_t)l * W2_STRIDE), 256, 256, 256, nullptr}; ExpertOrder<4> S{(const int*)(ws + RT_BLK_E), P.G, cidl};
            EpiExp2 E{(const float*)(ws + RT_ROW_W), (bf16_t*)(ws + WS_YS)}; pg8::gemm_phase<EpiExp2, ExpertOrder<4>, false, true>(P.lds, g, S, E);
        }
        SEAM(p0 + 10);
        if (INL(11)) { PHASE_ENV; combine_norm(P, (const float*)ap->in[20] + l * 1024); }
        SEAM(p0 + 11);
        if (INL(12)) {
            PHASE_ENV; unsigned char* wd = ws + WS_WD + (size_t)l * WD_STRIDE;
            pg8::Gemm g{(const bf16_t*)(ws + WS_XN), (const bf16_t*)(wd + WD_G), 1024, 1024, 1024, nullptr}; pg8::DenseOrder S; S.init(64, 4, 1024, 1024, P.G, cidl);
            EpiResid<1> E{P.X, (bf16_t*)(ws + WS_XB), (float*)(ws + WS_SSQ1) + (size_t)(l + 1) * T * 16, (const bf16_t*)(ws + WS_E)}; pg8::gemm_phase<EpiResid<1>, pg8::DenseOrder, false, false>(P.lds, g, S, E);
        }
        SEAM(p0 + 12);
    }
    if (IN(N_PHASES - 1)) { PHASE_ENV; final_norm(P, (const float*)ap->in[23]); }
#undef IN
#undef INL
#undef SEAM
}


#ifdef DUMP_MODE
__global__ void dump_kernel(unsigned char* ws, float* out) {
    const size_t N = (size_t)T * 1024;
    for (size_t i = blockIdx.x * (size_t)blockDim.x + threadIdx.x; i < N; i += (size_t)gridDim.x * blockDim.x) {
        float v = 0.f;
#if DUMP_MODE == 1
        const bf16_t* CQ = (const bf16_t*)(ws + WS_CQ); const bf16_t* CKV = (const bf16_t*)(ws + WS_CKV); const bf16_t* KPE = (const bf16_t*)(ws + WS_KPE);
        const bf16_t* DIL = (const bf16_t*)(ws + WS_DIL); const bf16_t* SG = (const bf16_t*)(ws + WS_SG);
        v = bf_lo(CQ[i % ((size_t)T * 512)]) + bf_lo(CKV[i % ((size_t)T * 256)]) + bf_lo(KPE[i % ((size_t)T * 32)]) + bf_lo(DIL[i]) + bf_lo(DIL[i + N]) + bf_lo(DIL[(i % ((size_t)T * 256)) + 2 * N]) + bf_lo(SG[i]) + bf_lo(SG[i + N]);
#elif DUMP_MODE == 2
        const bf16_t* Q = (const bf16_t*)(ws + WS_Q); const bf16_t* KN = (const bf16_t*)(ws + WS_KN); const bf16_t* V = (const bf16_t*)(ws + WS_V);
        v = bf_lo(Q[i]) + bf_lo(Q[(i % ((size_t)T * 512)) + N]) + bf_lo(KN[i]) + bf_lo(V[i]);
#elif DUMP_MODE == 4
        const bf16_t* W = (const bf16_t*)(ws + WS_WD); const bf16_t* XB = (const bf16_t*)(ws + WS_XB); const float* R1 = (const float*)(ws + WS_ROPE_MLA); const float* R2 = (const float*)(ws + WS_ROPE_DIL);
        const bf16_t* W13 = (const bf16_t*)(ws + WS_W13); const bf16_t* W2 = (const bf16_t*)(ws + WS_W2); const bf16_t* PB = (const bf16_t*)(ws + WS_PB); const float* S1 = (const float*)(ws + WS_SSQ1);
        v = bf_lo(XB[i]) + R1[i % ((size_t)T * 32)] + R2[i % ((size_t)T * 16)] + bf_lo(PB[i]) + S1[i % T] * 1e-3f;
        for (int l = 0; l < 4; ++l) { const bf16_t* wl = (const bf16_t*)(ws + WS_WD + (size_t)l * WD_STRIDE); v += bf_lo(wl[i % ((size_t)5152 * 1024)]) + bf_lo(wl[(WD_Q / 2) + (i % ((size_t)5242880))]);
            for (int k = 0; k < 2; ++k) v += bf_lo(W13[(size_t)l * (W13_STRIDE / 2) + k * N + i]) + bf_lo(W2[(size_t)l * (W2_STRIDE / 2) + (k * N + i) % ((size_t)16 * 1024 * 1024)]); }
        (void)W;
#elif DUMP_MODE == 5
        const bf16_t* Y = (const bf16_t*)(ws + WS_YS);
        { const size_t row = i / 1024, c = i % 1024; v = 0.f; for (int k = 0; k < 5; ++k) v += bf_lo(Y[row * 5376 + k * 1024 + c]); }
#elif DUMP_MODE == 6
        const bf16_t* SG = (const bf16_t*)(ws + WS_SG);
        v = bf_lo(SG[i]) + bf_lo(SG[i + N]);
#elif DUMP_MODE == 7
        const bf16_t* CQ = (const bf16_t*)(ws + WS_CQ); const bf16_t* CKV = (const bf16_t*)(ws + WS_CKV);
        v = bf_lo(CQ[i % ((size_t)T * 512)]) + bf_lo(CKV[i % ((size_t)T * 256)]);
#elif DUMP_MODE == 8
        const bf16_t* DIL = (const bf16_t*)(ws + WS_DIL);
        v = bf_lo(DIL[i]) + bf_lo(DIL[i + N]) + bf_lo(DIL[(i % ((size_t)T * 256)) + 2 * N]);
#elif DUMP_MODE == 3
        const bf16_t* OA = (const bf16_t*)(ws + WS_OA); const bf16_t* OB = (const bf16_t*)(ws + WS_OB);
        v = bf_lo(OA[i]) + bf_lo(OB[i % ((size_t)T * 256)]);
#endif
        out[i] = v;
    }
}
#endif
extern "C" void kernel_launch(void* const* d_in, const int* in_sizes, int n_in, void* d_out, int out_size, void* d_ws, size_t ws_size, hipStream_t stream) {
    static int grid = 0;
    if (grid == 0) {
        if (n_in != 24 || out_size != T * DM || ws_size < WS_END) { fprintf(stderr, "kernel_launch: unexpected shapes n_in %d out %d ws %zu\n", n_in, out_size, ws_size); grid = -1; return; }
        int dev = 0, cus = 0, per_cu = 0;
        if (hipGetDevice(&dev) != hipSuccess || hipDeviceGetAttribute(&cus, hipDeviceAttributeMultiprocessorCount, dev) != hipSuccess) { grid = -1; return; }
        if (hipFuncSetAttribute((const void*)fwd_kernel, hipFuncAttributeMaxDynamicSharedMemorySize, LDS_BYTES) != hipSuccess) { fprintf(stderr, "kernel_launch: hipFuncSetAttribute failed\n"); grid = -1; return; }
        if (hipOccupancyMaxActiveBlocksPerMultiprocessor(&per_cu, (const void*)fwd_kernel, NTHR, LDS_BYTES) != hipSuccess || per_cu < 1) fprintf(stderr, "kernel_launch: occupancy query says %d\n", per_cu);
        (void)hipGetLastError();
        grid = cus;
    }
    if (grid < 0) return;
    (void)hipMemsetAsync((char*)d_ws + WS_CTL, 0, CTL_ZERO_BYTES, stream);
    Args a{};
    for (int i = 0; i < 24; ++i) a.in[i] = d_in[i];
    a.out = (float*)d_out; a.ws = (unsigned char*)d_ws;
#if MK_PER_PHASE
#ifndef RUN_PHASES
#define RUN_PHASES N_PHASES
#endif
    for (int ph = 0; ph < RUN_PHASES; ++ph) { a.ph_lo = ph; a.ph_hi = ph + 1; hipLaunchKernelGGL(fwd_kernel, dim3(grid), dim3(NTHR), LDS_BYTES, stream, a); }
#ifdef DUMP_MODE
    hipLaunchKernelGGL(dump_kernel, dim3(1024), dim3(256), 0, stream, (unsigned char*)d_ws, (float*)d_out);
#endif
#else
    a.ph_lo = 0; a.ph_hi = N_PHASES; hipLaunchKernelGGL(fwd_kernel, dim3(grid), dim3(NTHR), LDS_BYTES, stream, a);
#endif
}
```

```cpp
#include <hip/hip_runtime.h>
#include <cstdio>
#include <cstdint>

#define LAS __attribute__((address_space(3)))
#define GAS __attribute__((address_space(1)))
#define AS4 __attribute__((address_space(4)))
typedef unsigned short bf16_t;
typedef short bf16x8 __attribute__((ext_vector_type(8)));
typedef float f32x4 __attribute__((ext_vector_type(4)));
typedef float f32x2 __attribute__((ext_vector_type(2)));
typedef unsigned u32x4 __attribute__((ext_vector_type(4)));
typedef unsigned u32x2 __attribute__((ext_vector_type(2)));

#ifndef MK_PER_PHASE
#define MK_PER_PHASE 0
#endif

constexpr int T = 16384, DM = 1024, SEQ = 2048, NBATCH = 8, DEPTH = 4;
constexpr int NIN_SRC = 5152, NIN = 5376;
constexpr int NE = 64;
constexpr int MAXBLK = 192;
constexpr float EPS = 1e-6f;
constexpr int NWAVES = 8, NTHR = 512;

constexpr size_t MiB = 1u << 20, KiB = 1u << 10;
constexpr size_t WS_CTL = 0, CTL_ZERO_BYTES = 2 * MiB;
constexpr int CW_TMO = 0, CW_BAR = 4096;
constexpr size_t CTL_CNT = 128 * KiB;
static_assert(CTL_CNT + 4096 <= CTL_ZERO_BYTES, "ctl");
constexpr size_t WS_ROPE_MLA = 2 * MiB;
constexpr size_t WS_ROPE_DIL = 4 * MiB;
constexpr size_t WS_ROUTE = 5 * MiB;
constexpr size_t RT_TOK_E = WS_ROUTE;
constexpr size_t RT_TOK_W = RT_TOK_E + 128 * KiB;
constexpr size_t RT_TOK_RS = RT_TOK_W + 128 * KiB;
constexpr size_t RT_DEST = RT_TOK_RS + 64 * KiB;
constexpr size_t RT_ROW_TOK = RT_DEST + 128 * KiB;
constexpr size_t RT_ROW_W = RT_ROW_TOK + 192 * KiB;
constexpr size_t RT_ROW_RS = RT_ROW_W + 192 * KiB;
constexpr size_t RT_BLK_E = RT_ROW_RS + 192 * KiB;
static_assert(RT_BLK_E + 1024 <= 8 * MiB, "route");
constexpr size_t WS_WD = 8 * MiB, WD_STRIDE = 21 * MiB;
constexpr size_t WD_IN = 0, WD_Q = 10 * MiB + 512 * KiB, WD_K = 12 * MiB, WD_V = 12 * MiB + 512 * KiB, WD_A = 13 * MiB, WD_B = 15 * MiB,
                 WD_O = 15 * MiB + 512 * KiB, WD_R = 17 * MiB + 512 * KiB, WD_G = 18 * MiB, WD_P = 20 * MiB;
constexpr size_t WS_W13 = 92 * MiB, W13_STRIDE = 64 * MiB;
constexpr size_t WS_W2 = 348 * MiB, W2_STRIDE = 32 * MiB;
constexpr size_t WS_PB = 476 * MiB;
constexpr size_t WS_XB = 508 * MiB, WS_XN = 540 * MiB, WS_CQ = 572 * MiB, WS_CKV = 588 * MiB, WS_KPE = 596 * MiB, WS_Q = 598 * MiB,
                 WS_KN = 646 * MiB, WS_V = 678 * MiB, WS_OA = 710 * MiB, WS_OB = 742 * MiB, WS_TMPB = 750 * MiB, WS_MERGED = 782 * MiB,
                 WS_E = 814 * MiB, WS_RL = 846 * MiB, WS_DIL = 866 * MiB, WS_SG = 938 * MiB, WS_YS = 866 * MiB, WS_H = 962 * MiB, WS_OG = 782 * MiB  , WS_LSE = 806 * MiB  ,
                 WS_SSQ1 = 1002 * MiB  , WS_SSQ2 = 1007 * MiB  , WS_SSQQ = 1011 * MiB  , WS_SSQKV = 1013 * MiB  , WS_END = 1014 * MiB;

constexpr int RING_BYTES = 131072, LDSCTL_OFF = RING_BYTES, MISC_OFF = LDSCTL_OFF + 320, LDS_BYTES = 147456;

typedef __bf16 bf16x2_t __attribute__((ext_vector_type(2)));
__device__ __forceinline__ unsigned cvt_pk_bf16(float lo, float hi) { f32x2 v = {lo, hi}; bf16x2_t b = __builtin_convertvector(v, bf16x2_t); return __builtin_bit_cast(unsigned, b); }
__device__ __forceinline__ float bf_lo(unsigned w) { return __uint_as_float(w << 16); }
__device__ __forceinline__ float bf_hi(unsigned w) { return __uint_as_float(w & 0xffff0000u); }
__device__ __forceinline__ float sigmoidf_(float x) { return __builtin_amdgcn_rcpf(1.0f + __expf(-x)); }
__device__ __forceinline__ u32x4 pack8(f32x4 a, f32x4 b) { u32x4 w; w.x = cvt_pk_bf16(a[0], a[1]); w.y = cvt_pk_bf16(a[2], a[3]); w.z = cvt_pk_bf16(b[0], b[1]); w.w = cvt_pk_bf16(b[2], b[3]); return w; }
__device__ __forceinline__ void unpack8(u32x4 w, f32x4& a, f32x4& b) { a = (f32x4){bf_lo(w.x), bf_hi(w.x), bf_lo(w.y), bf_hi(w.y)}; b = (f32x4){bf_lo(w.z), bf_hi(w.z), bf_lo(w.w), bf_hi(w.w)}; }
__device__ __forceinline__ float wave_sum(float v) {
#pragma unroll
    for (int o = 1; o < 64; o <<= 1) v += __shfl_xor(v, o);
    return v;
}
template <int NP> __device__ __forceinline__ float part_sum(const float* p) { float t = 0.f;
#pragma unroll
    for (int i = 0; i < NP / 4; ++i) { const f32x4 a = *(const f32x4*)(p + 4 * i); t += (a[0] + a[1]) + (a[2] + a[3]); }
    return t; }
#define LDS_WAIT() asm volatile("s_waitcnt lgkmcnt(0)" ::: "memory")
#define VM_WAIT() asm volatile("s_waitcnt vmcnt(0)" ::: "memory")

namespace pg8 {
constexpr int BM = 256, BK = 64, HALF = 128, HTB = HALF * BK * 2, NXCD = 8, WGM = 8;
__host__ __device__ __forceinline__ int lds_byte(int r, int c) { const int st = (r >> 4) * 2 + (c >> 5), rr = r & 15, cc = c & 31, ob = rr * 64 + cc * 2; return st * 1024 + (ob ^ (((ob >> 9) & 1) << 5)); }
__host__ __device__ __forceinline__ void stage_rc(int b, int& R, int& C) { const int st = b / 1024, sb = b % 1024, swz = sb ^ (((sb >> 9) & 1) << 5); R = (st >> 1) * 16 + swz / 64; C = (st & 1) * 32 + (swz % 64) / 2; }
__host__ __device__ __forceinline__ int perm32(int rho) { const int n = rho >> 4, i = rho & 15; return 8 * (i >> 2) + 4 * n + (i & 3); }

struct Unit { int pm, pn; unsigned a_off, b_off; };
struct Gemm { const bf16_t* A; const bf16_t* Bt; int lda, ldb, K; const int* gather; };

struct DenseOrder {
    int nM, nN, nwg, G, c, lda, ldb;
    __device__ void init(int nM_, int nN_, int lda_, int ldb_, int G_, int c_) { nM = nM_; nN = nN_; nwg = nM * nN; G = G_; c = c_; lda = lda_; ldb = ldb_; }
    __device__ __forceinline__ bool next(int i, Unit& u) const {
        const long L = (long)i * G + c; if (L >= nwg) return false;
        int wgid = (int)L; { const int q = nwg / NXCD, r = nwg % NXCD, xcd = wgid % NXCD, off = wgid / NXCD; wgid = (xcd < r ? xcd * (q + 1) : r * (q + 1) + (xcd - r) * q) + off; }
        const int nig = WGM * nN, gid = wgid / nig, fm = gid * WGM, gsz = (nM - fm) < WGM ? (nM - fm) : WGM;
        u.pm = fm + ((wgid % nig) % gsz); u.pn = (wgid % nig) / gsz;
        u.a_off = (unsigned)u.pm * 256u * (unsigned)lda; u.b_off = (unsigned)u.pn * 256u * (unsigned)ldb; return true;
    }
};

template <class Epi, class Sched, bool GATHER, bool ALIGN_EPI>
__device__ __forceinline__ void gemm_phase(LAS unsigned char* lds, const Gemm g, const Sched& S, const Epi& E) {
    int tid_ = threadIdx.x; asm volatile("; gemm_phase entry" : "+v"(tid_));
    const int tid = tid_, wid = __builtin_amdgcn_readfirstlane(tid >> 6), lane = tid & 63, wr = wid >> 2, wc = wid & 3, fr = lane & 15, fq = lane >> 4;
    const int K = g.K, nt = K / BK, lda = g.lda, ldb = g.ldb;
    unsigned voffB[2], vAc[2][2], vAn[2][2]; int Rst[2], Cst[2];
#pragma unroll
    for (int i = 0; i < 2; ++i) { int R, C; stage_rc(tid * 16 + i * 8192, R, C); const int Rb = (R & ~31) + perm32(R & 31);
        Rst[i] = R; Cst[i] = C; voffB[i] = (unsigned)(Rb * ldb + C) * 2u;
        vAc[0][i] = (unsigned)(R * lda + C) * 2u; vAc[1][i] = (unsigned)((R + HALF) * lda + C) * 2u; vAn[0][i] = vAc[0][i]; vAn[1][i] = vAc[1][i]; }
    const size_t kstep = (size_t)(BK * 2);
    const size_t hstepB = (size_t)HALF * ldb * 2;
    const unsigned ldsw = (unsigned)wid * 1024u;
    const int aoff = lds_byte(wr * 64 + fr, fq * 8), boff = lds_byte(wc * 32 + fr, fq * 8);
#define PG8_SA(b, h) (((b) * 2 + (h)) * HTB)
#define PG8_SB(b, h) ((4 + (b) * 2 + (h)) * HTB)
#define PG8_STAGE(bufoff, gbase, voff) do { _Pragma("unroll") for (int _i = 0; _i < 2; ++_i) \
        __builtin_amdgcn_global_load_lds((const unsigned*)((const char*)(gbase) + (voff)[_i]), (LAS unsigned*)(lds + (bufoff) + ldsw + _i * 8192), 16, 0, 0); } while (0)
#define PG8_STAGE_A(bufoff, gbase, h, nx) do { _Pragma("unroll") for (int _i = 0; _i < 2; ++_i) \
        __builtin_amdgcn_global_load_lds((const unsigned*)((const char*)(gbase) + ((GATHER && (nx)) ? vAn[h][_i] : vAc[h][_i])), (LAS unsigned*)(lds + (bufoff) + ldsw + _i * 8192), 16, 0, 0); } while (0)
#define PG8_LDA(dst, b, h) do { _Pragma("unroll") for (int m = 0; m < 4; ++m) _Pragma("unroll") for (int k = 0; k < 2; ++k) dst[m][k] = *(const LAS bf16x8*)(lds + PG8_SA(b, h) + aoff + m * 2048 + k * 1024); } while (0)
#define PG8_LDB(dst, b, h) do { _Pragma("unroll") for (int n = 0; n < 2; ++n) _Pragma("unroll") for (int k = 0; k < 2; ++k) dst[n][k] = *(const LAS bf16x8*)(lds + PG8_SB(b, h) + boff + n * 2048 + k * 1024); } while (0)
#define PG8_MMA(ai, bj, At, Bt) do { __builtin_amdgcn_s_setprio(1); _Pragma("unroll") for (int m = 0; m < 4; ++m) _Pragma("unroll") for (int n = 0; n < 2; ++n) _Pragma("unroll") for (int k = 0; k < 2; ++k) \
        acc[ai][bj][m][n] = __builtin_amdgcn_mfma_f32_16x16x32_bf16(Bt[n][k], At[m][k], acc[ai][bj][m][n], 0, 0, 0); __builtin_amdgcn_s_setprio(0); } while (0)
#define PG8_WAIT_V(n) asm volatile("s_waitcnt vmcnt(" #n ")" ::: "memory")
#define PG8_WAIT_L(n) asm volatile("s_waitcnt lgkmcnt(" #n ")" ::: "memory")
#define PG8_BAR __builtin_amdgcn_s_barrier()
#define PG8_SCHED __builtin_amdgcn_sched_barrier(0)
    Unit cur, nxt; int ui = 0;
    if (!S.next(0, cur)) return;
    if constexpr (GATHER) {
#pragma unroll
        for (int h = 0; h < 2; ++h)
#pragma unroll
            for (int i = 0; i < 2; ++i) vAc[h][i] = (unsigned)(g.gather[cur.pm * 256 + h * HALF + Rst[i]] * lda + Cst[i]) * 2u;
    }
    f32x4 acc[2][2][4][2];
#pragma unroll
    for (int a = 0; a < 2; ++a)
#pragma unroll
        for (int b = 0; b < 2; ++b)
#pragma unroll
            for (int m = 0; m < 4; ++m)
#pragma unroll
                for (int n = 0; n < 2; ++n) acc[a][b][m][n] = (f32x4){0.f, 0.f, 0.f, 0.f};
    bf16x8 At[4][2], B0[2][2], B1[2][2];
    const char* cA = (const char*)g.A + (size_t)cur.a_off * 2; const char* cB = (const char*)g.Bt + (size_t)cur.b_off * 2;
    PG8_STAGE(PG8_SB(0, 0), cB, voffB); PG8_STAGE(PG8_SB(0, 1), cB + hstepB, voffB); PG8_STAGE_A(PG8_SA(0, 0), cA, 0, false); PG8_STAGE_A(PG8_SA(0, 1), cA, 1, false);
    if (wr == 1) PG8_BAR;
    PG8_WAIT_V(2); PG8_BAR;
    PG8_STAGE(PG8_SB(1, 0), cB + kstep, voffB); PG8_STAGE_A(PG8_SA(1, 0), cA + kstep, 0, false); PG8_STAGE(PG8_SB(1, 1), cB + hstepB + kstep, voffB);
    PG8_WAIT_V(6); PG8_BAR;
    for (;;) {
        const bool has_next = S.next(ui + 1, nxt);
        const char* nA = has_next ? (const char*)g.A + (size_t)nxt.a_off * 2 : cA; const char* nB = has_next ? (const char*)g.Bt + (size_t)nxt.b_off * 2 : cB;
        if constexpr (GATHER) {
#pragma unroll
            for (int h = 0; h < 2; ++h)
#pragma unroll
                for (int i = 0; i < 2; ++i) vAn[h][i] = has_next ? (unsigned)(g.gather[nxt.pm * 256 + h * HALF + Rst[i]] * lda + Cst[i]) * 2u : vAc[h][i];
        }
#pragma unroll 1
        for (int t = 0; t < nt; t += 2) {
            const bool last = (t == nt - 2);
            const char* a1 = cA + (size_t)(t + 1) * kstep;
            const char* a2 = last ? nA : cA + (size_t)(t + 2) * kstep; const char* b2 = last ? nB : cB + (size_t)(t + 2) * kstep;
            const char* a3 = a2 + kstep; const char* b3 = b2 + kstep;
            PG8_LDB(B0, 0, 0); PG8_LDB(B1, 0, 1); PG8_SCHED; PG8_LDA(At, 0, 0); PG8_STAGE_A(PG8_SA(1, 1), a1, 1, false);
            PG8_WAIT_V(8); PG8_WAIT_L(0); PG8_BAR; PG8_MMA(0, 0, At, B0); PG8_MMA(0, 1, At, B1); PG8_BAR; PG8_SCHED;
            PG8_LDA(At, 0, 1); PG8_STAGE(PG8_SB(0, 0), b2, voffB); PG8_STAGE(PG8_SB(0, 1), b2 + hstepB, voffB); PG8_STAGE_A(PG8_SA(0, 0), a2, 0, last);
            PG8_WAIT_V(8); PG8_WAIT_L(0); PG8_BAR; PG8_MMA(1, 0, At, B0); PG8_MMA(1, 1, At, B1); PG8_BAR; PG8_SCHED;
            PG8_LDB(B0, 1, 0); PG8_LDB(B1, 1, 1); PG8_SCHED; PG8_LDA(At, 1, 0); PG8_STAGE_A(PG8_SA(0, 1), a2, 1, last);
            PG8_WAIT_V(8); PG8_WAIT_L(0); PG8_BAR; PG8_MMA(0, 0, At, B0); PG8_MMA(0, 1, At, B1); PG8_BAR; PG8_SCHED;
            PG8_LDA(At, 1, 1); PG8_STAGE(PG8_SB(1, 0), b3, voffB); PG8_STAGE(PG8_SB(1, 1), b3 + hstepB, voffB); PG8_STAGE_A(PG8_SA(1, 0), a3, 0, last);
            PG8_WAIT_V(8); PG8_WAIT_L(0); PG8_BAR; PG8_MMA(1, 0, At, B0); PG8_MMA(1, 1, At, B1); PG8_BAR; PG8_SCHED;
        }
        if constexpr (ALIGN_EPI) { if (wr == 0) PG8_BAR; }
        { int fr_ = fr, fq_ = fq, wr_ = wr, wc_ = wc; asm volatile("; epilogue entry" : "+v"(fr_), "+v"(fq_)); asm volatile("" : "+s"(wr_), "+s"(wc_));
          E(acc, cur, wr_, wc_, fr_, fq_); }
        if (!has_next) break;
#pragma unroll
        for (int a = 0; a < 2; ++a)
#pragma unroll
            for (int b = 0; b < 2; ++b)
#pragma unroll
                for (int m = 0; m < 4; ++m)
#pragma unroll
                    for (int n = 0; n < 2; ++n) acc[a][b][m][n] = (f32x4){0.f, 0.f, 0.f, 0.f};
        cur = nxt; cA = nA; cB = nB; ++ui;
        if constexpr (GATHER) {
#pragma unroll
            for (int h = 0; h < 2; ++h)
#pragma unroll
                for (int i = 0; i < 2; ++i) vAc[h][i] = vAn[h][i];
        }
        if constexpr (ALIGN_EPI) { if (wr == 1) PG8_BAR; }
    }
    PG8_WAIT_V(0);
    if constexpr (!ALIGN_EPI) { if (wr == 0) PG8_BAR; }
    PG8_BAR;
#undef PG8_SA
#undef PG8_SB
#undef PG8_STAGE
#undef PG8_STAGE_A
#undef PG8_LDA
#undef PG8_LDB
#undef PG8_MMA
#undef PG8_WAIT_V
#undef PG8_WAIT_L
#undef PG8_BAR
#undef PG8_SCHED
}
}
using pg8::Unit;

#define XB_TMO      128
#define XB_XCNT(j)  (256  + 64 * (j))
#define XB_XSUB(j)  (1280 + 64 * (j))
#define XB_XGEN(j)  (2304 + 64 * (j))
#define XB_TOP      3328
#define XB_TOPGEN   3392
#define XCD_BAR_WORDS 3456
#define XB_SPIN_CAP (1u << 18)
__device__ __forceinline__ unsigned xb_ld(unsigned* p)              { return __hip_atomic_load(p, __ATOMIC_RELAXED, __HIP_MEMORY_SCOPE_AGENT); }
__device__ __forceinline__ unsigned xb_add(unsigned* p, unsigned v) { return __hip_atomic_fetch_add(p, v, __ATOMIC_RELAXED, __HIP_MEMORY_SCOPE_AGENT); }
__device__ __forceinline__ unsigned xb_xcc_id() { return (unsigned)__builtin_amdgcn_s_getreg((3 << 11) | 20) & 0xFu; }
#define XB_SPIN(cond, bar) do { unsigned _sp = 0; while (cond) { __builtin_amdgcn_s_sleep(1); \
    if ((++_sp & 255u) == 0u) { if (xb_ld(&(bar)[XB_TMO])) break; if (_sp > XB_SPIN_CAP) { atomicAdd(&(bar)[XB_TMO], 1u); break; } } } } while (0)
struct XcdBarrier { unsigned* bar; unsigned x; volatile LAS unsigned* st; };
__device__ __forceinline__ XcdBarrier xcd_barrier_post(unsigned* bar, volatile LAS unsigned* st) {
    XcdBarrier b; b.bar = bar; b.x = xb_xcc_id(); b.st = st;
    if (threadIdx.x == 0) (void)xb_add(&bar[XB_XCNT(b.x)], 1u);
    return b;
}
__device__ __forceinline__ void xcd_barrier_complete(unsigned* bar, unsigned x, unsigned& nloc, unsigned& nx) {
    const unsigned G = gridDim.x * gridDim.y * gridDim.z;
    unsigned sum, cnt, mine, sp = 0u;
    for (;;) {
        sum = 0u; cnt = 0u; mine = 0u;
#pragma unroll
        for (unsigned j = 0; j < 16; ++j) { const unsigned c = xb_ld(&bar[XB_XCNT(j)]); sum += c; cnt += (c > 0u) ? 1u : 0u; mine = (j == x) ? c : mine; }
        if (sum == G) break;
        __builtin_amdgcn_s_sleep(1);
        if ((++sp & 255u) == 0u) { if (xb_ld(&bar[XB_TMO])) break; if (sp > XB_SPIN_CAP) { atomicAdd(&bar[XB_TMO], 1u); break; } }
    }
    nloc = mine > 0u ? mine : 1u; nx = cnt > 0u ? cnt : 1u;
}
__device__ __forceinline__ void xcd_barrier(const XcdBarrier& b) {
    asm volatile("s_waitcnt vmcnt(0)" ::: "memory");
    __syncthreads();
    if (threadIdx.x == 0) {
        unsigned* bar = b.bar;
        __builtin_amdgcn_s_waitcnt(0);
        unsigned nloc = b.st[0], nx = b.st[1];
        if (nloc == 0u) { xcd_barrier_complete(bar, b.x, nloc, nx); b.st[0] = nloc; b.st[1] = nx; }
        const unsigned old = xb_add(&bar[XB_XSUB(b.x)], 1u);
        const unsigned gen = old / nloc;
        if (old + 1u == (gen + 1u) * nloc) {
            __builtin_amdgcn_fence(__ATOMIC_RELEASE, "agent");
            asm volatile("s_waitcnt vmcnt(0)" ::: "memory");
            const unsigned og = xb_add(&bar[XB_TOP], 1u);
            const unsigned tg = og / nx;
            if (og + 1u == (tg + 1u) * nx) xb_add(&bar[XB_TOPGEN], 1u);
            else XB_SPIN(xb_ld(&bar[XB_TOPGEN]) == tg, bar);
            __builtin_amdgcn_fence(__ATOMIC_ACQUIRE, "agent");
            xb_add(&bar[XB_XGEN(b.x)], 1u);
            asm volatile("s_waitcnt vmcnt(0)" ::: "memory");
        } else {
            XB_SPIN(xb_ld(&bar[XB_XGEN(b.x)]) == gen, bar);
            __builtin_amdgcn_fence(__ATOMIC_ACQUIRE, "agent");
            asm volatile("s_waitcnt vmcnt(0)" ::: "memory");
        }
    }
    __syncthreads();
}

struct Args { const void* in[24]; float* out; unsigned char* ws; int ph_lo, ph_hi; };

struct Frame {
    LAS unsigned char* lds;
    int tid, lane, wave, vcu, G;
    unsigned char* ws;
    float* X;
};

#define EPI_ROW(ai, m) (u.pm * 256 + (ai) * 128 + wr * 64 + (m) * 16 + fr)
#define EPI_FOR_ROWS _Pragma("unroll") for (int ai = 0; ai < 2; ++ai) _Pragma("unroll") for (int m = 0; m < 4; ++m)

struct EpiInProj {
    const float* ssq_x; bf16_t *CQ, *CKV, *KPE, *DIL, *SG; float *ssq_q, *ssq_kv; const f32x2* rope_dil; const f32x2* rope_mla;
    __device__ __forceinline__ void operator()(const f32x4 (&acc)[2][2][4][2], const Unit& u, int wr, int wc, int fr, int fq) const {
        const int pn = u.pn;
        if (pn < 3) {
            bf16_t* dst = pn < 2 ? CQ : CKV; const int ld = pn < 2 ? 512 : 256; const int cb = (pn == 1 ? 256 : 0) + wc * 32 + 8 * fq; float* sq = pn < 2 ? ssq_q : ssq_kv;
            EPI_FOR_ROWS { const int row = EPI_ROW(ai, m); const float rs = rsqrtf(part_sum<16>(ssq_x + (size_t)row * 16) * (1.0f / 1024.0f) + EPS); float s = 0.f;
#pragma unroll
                for (int bj = 0; bj < 2; ++bj) { const f32x4 v0 = acc[ai][bj][m][0] * rs, v1 = acc[ai][bj][m][1] * rs;
                    s += (v0[0] * v0[0] + v0[1] * v0[1]) + (v0[2] * v0[2] + v0[3] * v0[3]) + (v1[0] * v1[0] + v1[1] * v1[1]) + (v1[2] * v1[2] + v1[3] * v1[3]);
                    *(u32x4*)(dst + (size_t)row * ld + cb + bj * 128) = pack8(v0, v1); }
                s += __shfl_xor(s, 16); s += __shfl_xor(s, 32);
                if (fq == 0) { if (pn < 2) sq[(size_t)row * 8 + pn * 4 + wc] = s; else sq[(size_t)row * 4 + wc] = s; } }
        } else if (pn < 12) {
            const int t = pn - 3, kind = t % 3; const bool rope = (kind < 2) && ((wc & 1) == 0); const float sgn = fq == 0 ? -1.f : 1.f;
            const int cb = t * 256 + wc * 32 + 8 * fq;
            EPI_FOR_ROWS { const int row = EPI_ROW(ai, m); const float rs = rsqrtf(part_sum<16>(ssq_x + (size_t)row * 16) * (1.0f / 1024.0f) + EPS);
                f32x4 cs[4];
                if (rope) {
#pragma unroll
                    for (int j = 0; j < 4; ++j) cs[j] = *(const f32x4*)(rope_dil + (size_t)row * 8 + 2 * j);
                }
#pragma unroll
                for (int bj = 0; bj < 2; ++bj) { f32x4 v[2] = {acc[ai][bj][m][0] * rs, acc[ai][bj][m][1] * rs};
                    if (rope) {
#pragma unroll
                        for (int n = 0; n < 2; ++n)
#pragma unroll
                            for (int e = 0; e < 4; ++e) { const int j = 4 * n + e; const float c = cs[j >> 1][(j & 1) * 2], sn = cs[j >> 1][(j & 1) * 2 + 1];
                                const float mine = v[n][e], oth = __shfl_xor(mine, 16) * sgn;
                                const float r = mine * c + oth * sn; v[n][e] = fq < 2 ? r : mine; }
                    }
                    *(u32x4*)(DIL + (size_t)row * 2304 + cb + bj * 128) = pack8(v[0], v[1]); } }
        } else if (pn < 20) {
            const int cb = (pn - 12) * 256 + wc * 32 + 8 * fq;
            EPI_FOR_ROWS { const int row = EPI_ROW(ai, m); const float rs = rsqrtf(part_sum<16>(ssq_x + (size_t)row * 16) * (1.0f / 1024.0f) + EPS);
#pragma unroll
                for (int bj = 0; bj < 2; ++bj) { f32x4 v0 = acc[ai][bj][m][0] * rs, v1 = acc[ai][bj][m][1] * rs;
#ifdef EXP_D
                    v0 = acc[ai][bj][m][0] * 0.f + rs; v1 = acc[ai][bj][m][1] * 0.f + rs;
#else
#pragma unroll
                    for (int e = 0; e < 4; ++e) { v0[e] = sigmoidf_(v0[e]); v1[e] = sigmoidf_(v1[e]); }
#endif
                    *(u32x4*)(SG + (size_t)row * 2048 + cb + bj * 128) = pack8(v0, v1); } }
        } else {
            if (wc == 0) {
                EPI_FOR_ROWS { const int row = EPI_ROW(ai, m); const float rs = rsqrtf(part_sum<16>(ssq_x + (size_t)row * 16) * (1.0f / 1024.0f) + EPS);
                    f32x4 v[2] = {acc[ai][0][m][0] * rs, acc[ai][0][m][1] * rs};
                    const int jb = 8 * (fq & 1);
#pragma unroll
                    for (int n = 0; n < 2; ++n) { const f32x4 c01 = *(const f32x4*)(rope_mla + (size_t)row * 16 + jb + 4 * n), c23 = *(const f32x4*)(rope_mla + (size_t)row * 16 + jb + 4 * n + 2);
#pragma unroll
                        for (int e = 0; e < 4; ++e) { const float c = e < 2 ? c01[e * 2] : c23[(e - 2) * 2], sn = e < 2 ? c01[e * 2 + 1] : c23[(e - 2) * 2 + 1];
                            const float mine = v[n][e], oth = __shfl_xor(mine, 32);
                            v[n][e] = fq < 2 ? mine * c - oth * sn : oth * sn + mine * c; } }
                    *(u32x4*)(KPE + (size_t)row * 32 + 8 * fq) = pack8(v[0], v[1]); }
            }
        }
    }
};

struct EpiQup {
    const float* ssq_q; bf16_t* Q; const f32x2* rope_mla;
    __device__ __forceinline__ void operator()(const f32x4 (&acc)[2][2][4][2], const Unit& u, int wr, int wc, int fr, int fq) const {
        EPI_FOR_ROWS { const int row = EPI_ROW(ai, m); const float rs = rsqrtf(part_sum<8>(ssq_q + (size_t)row * 8) * (1.0f / 512.0f) + EPS);
#pragma unroll
            for (int bj = 0; bj < 2; ++bj) { const int cg = u.pn * 8 + bj * 4 + wc; const bool rope = (cg % 3) == 2;
                f32x4 v[2] = {acc[ai][bj][m][0] * rs, acc[ai][bj][m][1] * rs};
                if (rope) { const int jb = 8 * (fq & 1);
#pragma unroll
                    for (int n = 0; n < 2; ++n) { const f32x4 c01 = *(const f32x4*)(rope_mla + (size_t)row * 16 + jb + 4 * n), c23 = *(const f32x4*)(rope_mla + (size_t)row * 16 + jb + 4 * n + 2);
#pragma unroll
                        for (int e = 0; e < 4; ++e) { const float c = e < 2 ? c01[e * 2] : c23[(e - 2) * 2], sn = e < 2 ? c01[e * 2 + 1] : c23[(e - 2) * 2 + 1];
                            const float mine = v[n][e], oth = __shfl_xor(mine, 32);
                            v[n][e] = fq < 2 ? mine * c - oth * sn : oth * sn + mine * c; } } }
                *(u32x4*)(Q + (size_t)row * 1536 + u.pn * 256 + bj * 128 + wc * 32 + 8 * fq) = pack8(v[0], v[1]); } }
    }
};

struct EpiScaleStore {
    const float* ssq; float inv_n; bf16_t* O; int ld;
    __device__ __forceinline__ void operator()(const f32x4 (&acc)[2][2][4][2], const Unit& u, int wr, int wc, int fr, int fq) const {
        EPI_FOR_ROWS { const int row = EPI_ROW(ai, m); const float rs = ssq ? rsqrtf(part_sum<4>(ssq + (size_t)row * 4) * inv_n + EPS) : 1.0f;
#pragma unroll
            for (int bj = 0; bj < 2; ++bj) *(u32x4*)(O + (size_t)row * ld + u.pn * 256 + bj * 128 + wc * 32 + 8 * fq) = pack8(acc[ai][bj][m][0] * rs, acc[ai][bj][m][1] * rs); }
    }
};

template <int MODE> struct EpiGate {
    const bf16_t* G; int goff; const bf16_t* ADD; bf16_t* O;
    __device__ __forceinline__ void operator()(const f32x4 (&acc)[2][2][4][2], const Unit& u, int wr, int wc, int fr, int fq) const {
        EPI_FOR_ROWS { const int row = EPI_ROW(ai, m);
#pragma unroll
            for (int bj = 0; bj < 2; ++bj) { const int col = u.pn * 256 + bj * 128 + wc * 32 + 8 * fq;
                f32x4 g0, g1; unpack8(*(const u32x4*)(G + (size_t)row * 2048 + goff + col), g0, g1);
                f32x4 v0 = acc[ai][bj][m][0] * g0, v1 = acc[ai][bj][m][1] * g1;
                if (MODE == 1) { f32x4 a0, a1; unpack8(*(const u32x4*)(ADD + (size_t)row * 1024 + col), a0, a1); v0 += a0; v1 += a1; }
                *(u32x4*)(O + (size_t)row * 1024 + col) = pack8(v0, v1); } }
    }
};

template <int MODE> struct EpiResid {
    float* X; bf16_t* XB; float* ssq; const bf16_t* Eb;
    __device__ __forceinline__ void operator()(const f32x4 (&acc)[2][2][4][2], const Unit& u, int wr, int wc, int fr, int fq) const {
        EPI_FOR_ROWS { const int row = EPI_ROW(ai, m); float s = 0.f;
#pragma unroll
            for (int bj = 0; bj < 2; ++bj) { const int col = u.pn * 256 + bj * 128 + wc * 32 + 8 * fq;
                float* xp = X + (size_t)row * 1024 + col;
                f32x4 x0 = *(const f32x4*)xp, x1 = *(const f32x4*)(xp + 4);
                f32x4 d0 = acc[ai][bj][m][0], d1 = acc[ai][bj][m][1];
                if (MODE == 1) { f32x4 e0, e1; unpack8(*(const u32x4*)(Eb + (size_t)row * 1024 + col), e0, e1);
#pragma unroll
                    for (int e = 0; e < 4; ++e) { d0[e] = sigmoidf_(d0[e]) * e0[e]; d1[e] = sigmoidf_(d1[e]) * e1[e]; } }
                x0 += d0; x1 += d1;
                *(f32x4*)xp = x0; *(f32x4*)(xp + 4) = x1;
                if (XB) *(u32x4*)(XB + (size_t)row * 1024 + col) = pack8(x0, x1);
                s += (x0[0] * x0[0] + x0[1] * x0[1]) + (x0[2] * x0[2] + x0[3] * x0[3]) + (x1[0] * x1[0] + x1[1] * x1[1]) + (x1[2] * x1[2] + x1[3] * x1[3]); }
            s += __shfl_xor(s, 16); s += __shfl_xor(s, 32);
            if (fq == 0) ssq[(size_t)row * 16 + u.pn * 4 + wc] = s; }
    }
};

struct EpiRouter {
    float* RL;
    __device__ __forceinline__ void operator()(const f32x4 (&acc)[2][2][4][2], const Unit& u, int wr, int wc, int fr, int fq) const {
        const int c0 = wc * 32 + 8 * fq;
        if (c0 < 72) {
            EPI_FOR_ROWS { const int row = EPI_ROW(ai, m); float* p = RL + ((size_t)u.pn * T + row) * 72 + c0;
                *(f32x4*)p = acc[ai][0][m][0]; *(f32x4*)(p + 4) = acc[ai][0][m][1]; }
        }
    }
};

struct EpiExp1 {
    const float* row_rs; bf16_t* H;
    __device__ __forceinline__ void operator()(const f32x4 (&acc)[2][2][4][2], const Unit& u, int wr, int wc, int fr, int fq) const {
        EPI_FOR_ROWS { const int row = EPI_ROW(ai, m); const float rs = row_rs[row];
            f32x4 h[2];
#pragma unroll
            for (int n = 0; n < 2; ++n)
#pragma unroll
                for (int e = 0; e < 4; ++e) { const float gt = acc[ai][0][m][n][e] * rs, up = acc[ai][1][m][n][e] * rs; h[n][e] = gt * sigmoidf_(gt) * up; }
            *(u32x4*)(H + (size_t)row * 256 + u.pn * 128 + wc * 32 + 8 * fq) = pack8(h[0], h[1]); }
    }
};
struct EpiExp2 {
    const float* row_w; bf16_t* YS;
    __device__ __forceinline__ void operator()(const f32x4 (&acc)[2][2][4][2], const Unit& u, int wr, int wc, int fr, int fq) const {
        EPI_FOR_ROWS { const int row = EPI_ROW(ai, m); const float w = row_w[row];
#pragma unroll
            for (int bj = 0; bj < 2; ++bj) *(u32x4*)(YS + (size_t)row * 1024 + u.pn * 256 + bj * 128 + wc * 32 + 8 * fq) = pack8(acc[ai][bj][m][0] * w, acc[ai][bj][m][1] * w); }
    }
};

struct RouterOrder {
    int G, c;
    __device__ __forceinline__ bool next(int i, Unit& u) const { const int L = i * G + c; if (L >= 256) return false;
        u.pm = L >> 2; u.pn = L & 3; u.a_off = (unsigned)u.pm * 256u * 1024u + (unsigned)u.pn * 256u; u.b_off = (unsigned)u.pn * 256u; return true; }
};
template <int NJ> struct ExpertOrder {
    const int* blk_e; int G, c;
    __device__ __forceinline__ bool next(int i, Unit& u) const { const int nblk = blk_e[255]; const int L = i * G + c; if (L >= nblk * NJ) return false;
        const int blk = L / NJ, j = L % NJ, e = blk_e[blk]; u.pm = blk; u.pn = j;
        if (NJ == 2) { u.a_off = 0u; u.b_off = (unsigned)(e * 512 + j * 256) * 1024u; } else { u.a_off = (unsigned)blk * 256u * 256u; u.b_off = (unsigned)(e * 1024 + j * 256) * 256u; }
        return true; }
};

__device__ __forceinline__ void tr_item(const float* W, int ldw, int n_src0, const float* g, bf16_t* WT, int K, int n_dst0, int k0, LAS float* scr, int lane) {
#pragma unroll 8
    for (int i = 0; i < 32; ++i) { const int kk = 2 * i + (lane >> 5); float v = W[(size_t)(k0 + kk) * ldw + n_src0 + (lane & 31)]; if (g) v *= g[k0 + kk]; scr[kk * 33 + (lane & 31)] = v; }
    LDS_WAIT(); asm volatile("" ::: "memory");
    const int c = lane & 7;
#pragma unroll
    for (int j = 0; j < 4; ++j) { const int n = (lane >> 3) + 8 * j; const LAS float* s = scr + (8 * c) * 33 + n;
        u32x4 o; o.x = cvt_pk_bf16(s[0 * 33], s[1 * 33]); o.y = cvt_pk_bf16(s[2 * 33], s[3 * 33]); o.z = cvt_pk_bf16(s[4 * 33], s[5 * 33]); o.w = cvt_pk_bf16(s[6 * 33], s[7 * 33]);
        *(u32x4*)(WT + (size_t)(n_dst0 + n) * K + k0 + 8 * c) = o; }
    LDS_WAIT(); asm volatile("" ::: "memory");
}

__device__ __forceinline__ void prologue(Frame& F, const AS4 Args* a) {
    LAS float* scr = (LAS float*)(F.lds + F.wave * 16384);
    const int gw = F.vcu * NWAVES + F.wave, NGW = F.G * NWAVES;
    const float* x = (const float*)a->in[0]; const float* p = (const float*)a->in[1]; const int* pos = (const int*)a->in[2];
    const float* g_mix = (const float*)a->in[3]; const float* w_in = (const float*)a->in[4]; const float* g_q = (const float*)a->in[5]; const float* w_q = (const float*)a->in[6];
    const float* g_kv = (const float*)a->in[7]; const float* w_kv = (const float*)a->in[8]; const float* w_a = (const float*)a->in[9]; const float* w_b = (const float*)a->in[10];
    const float* w_o = (const float*)a->in[11]; const float* g_ffn = (const float*)a->in[12]; const float* w_rg = (const float*)a->in[13]; const float* w_re = (const float*)a->in[15];
    const float* w_eg = (const float*)a->in[17]; const float* w_eu = (const float*)a->in[18]; const float* w_ed = (const float*)a->in[19];
    const float* w_pg = (const float*)a->in[21]; const float* w_pp = (const float*)a->in[22];
    unsigned char* ws = F.ws;
    constexpr int I_IN = 16 * 161, I_Q = 8 * 48, I_KV = 4 * 64, I_A = 16 * 32, I_B = 4 * 32, I_E13 = 64 * 256, I_E2 = 64 * 128;
    constexpr int I_LAYER = I_IN + I_Q + I_KV + I_A + I_B + I_A + I_A + I_B + I_E13 + I_E2;
    for (int it = gw; it < DEPTH * I_LAYER; it += NGW) {
        const int l = it / I_LAYER; int r = it % I_LAYER;
        unsigned char* wd = ws + WS_WD + (size_t)l * WD_STRIDE;
        if (r < I_IN) { const int kb = r / 161, nb = r % 161, ns = nb * 32; const int nd = ns < 768 ? ns : (ns < 800 ? 5120 : ns - 32);
            tr_item(w_in + (size_t)l * 1024 * NIN_SRC, NIN_SRC, ns, g_mix + l * 1024, (bf16_t*)(wd + WD_IN), 1024, nd, kb * 64, scr, F.lane); continue; } r -= I_IN;
        if (r < I_Q) { const int kb = r / 48, nb = r % 48;
            tr_item(w_q + (size_t)l * 512 * 1536, 1536, nb * 32, g_q + l * 512, (bf16_t*)(wd + WD_Q), 512, nb * 32, kb * 64, scr, F.lane); continue; } r -= I_Q;
        if (r < I_KV) { const int kb = r / 64, nb = r % 64, h = nb >> 2, part = nb & 3;
            tr_item(w_kv + (size_t)l * 256 * 2048, 2048, nb * 32, g_kv + l * 256, (bf16_t*)(wd + (part < 2 ? WD_K : WD_V)), 256, h * 64 + (part & 1) * 32, kb * 64, scr, F.lane); continue; } r -= I_KV;
        if (r < I_A) { const int kb = r / 32, nb = r % 32; tr_item(w_a + (size_t)l * 1024 * 1024, 1024, nb * 32, nullptr, (bf16_t*)(wd + WD_A), 1024, nb * 32, kb * 64, scr, F.lane); continue; } r -= I_A;
        if (r < I_B) { const int kb = r / 32, nb = r % 32; tr_item(w_b + (size_t)l * 256 * 1024, 1024, nb * 32, nullptr, (bf16_t*)(wd + WD_B), 256, nb * 32, kb * 64, scr, F.lane); continue; } r -= I_B;
        if (r < I_A) { const int kb = r / 32, nb = r % 32; tr_item(w_o + (size_t)l * 1024 * 1024, 1024, nb * 32, nullptr, (bf16_t*)(wd + WD_O), 1024, nb * 32, kb * 64, scr, F.lane); continue; } r -= I_A;
        if (r < I_A) { const int kb = r / 32, nb = r % 32; tr_item(w_pg + (size_t)l * 1024 * 1024, 1024, nb * 32, nullptr, (bf16_t*)(wd + WD_G), 1024, nb * 32, kb * 64, scr, F.lane); continue; } r -= I_A;
        if (r < I_B) { const int kb = r / 32, nb = r % 32; tr_item(w_pp + (size_t)l * 256 * 1024, 1024, nb * 32, nullptr, (bf16_t*)(wd + WD_P), 256, nb * 32, kb * 64, scr, F.lane); continue; } r -= I_B;
        if (r < I_E13) { const int e = r >> 8, q = r & 255, up = q >> 7, kb = (q & 127) >> 3, nb = q & 7; const int f0 = nb * 32, nd = (f0 >> 7) * 256 + up * 128 + (f0 & 127);
            tr_item((up ? w_eu : w_eg) + ((size_t)l * 64 + e) * 1024 * 256, 256, f0, g_ffn + l * 1024, (bf16_t*)(ws + WS_W13 + (size_t)l * W13_STRIDE) + (size_t)e * 512 * 1024, 1024, nd, kb * 64, scr, F.lane); continue; } r -= I_E13;
        { const int e = r >> 7, q = r & 127, kb = q >> 5, nb = q & 31;
            tr_item(w_ed + ((size_t)l * 64 + e) * 256 * 1024, 1024, nb * 32, nullptr, (bf16_t*)(ws + WS_W2 + (size_t)l * W2_STRIDE) + (size_t)e * 1024 * 256, 256, nb * 32, kb * 64, scr, F.lane); }
    }
    const int gt = F.vcu * NTHR + F.tid, NGT = F.G * NTHR;
    for (int i = gt; i < DEPTH * 256 * 1024; i += NGT) { const int l = i >> 18, n = (i >> 10) & 255, k = i & 1023;
        float v = 0.f; if (n < 8) v = w_rg[((size_t)l * 1024 + k) * 8 + n] * g_ffn[l * 1024 + k]; else if (n < 72) v = w_re[((size_t)l * 1024 + k) * 64 + (n - 8)] * g_ffn[l * 1024 + k];
        ((bf16_t*)(ws + WS_WD + (size_t)l * WD_STRIDE + WD_R))[n * 1024 + k] = (bf16_t)(cvt_pk_bf16(v, 0.f) & 0xffffu); }
    for (int i = gt; i < T * 16; i += NGT) { const int row = i >> 4, j = i & 15; const float inv = exp2f(-(float)j * (1.0f / 16.0f) * 13.287712379549449f);
        const float ang = (float)pos[row] * inv; ((f32x2*)(ws + WS_ROPE_MLA))[i] = (f32x2){cosf(ang), sinf(ang)}; }
    for (int i = gt; i < T * 8; i += NGT) { const int row = i >> 3, j = i & 7; const float inv = exp2f(-(float)j * (1.0f / 8.0f) * 18.931568569324174f);
        const float ang = (float)pos[row] * inv; ((f32x2*)(ws + WS_ROPE_DIL))[i] = (f32x2){cosf(ang), sinf(ang)}; }
    for (size_t i = gt; i < (size_t)DEPTH * T * 256 / 8; i += NGT) { const f32x4 a0 = ((const f32x4*)p)[2 * i], a1 = ((const f32x4*)p)[2 * i + 1]; ((u32x4*)(ws + WS_PB))[i] = pack8(a0, a1); }
    float* ssq1 = (float*)(ws + WS_SSQ1); bf16_t* XB = (bf16_t*)(ws + WS_XB);
    for (int m = gw; m < T; m += NGW) { const f32x4* xr = (const f32x4*)(x + (size_t)m * 1024) + F.lane; f32x4 v[4]; float s = 0.f;
#pragma unroll
        for (int j = 0; j < 4; ++j) { v[j] = xr[64 * j]; s += (v[j][0] * v[j][0] + v[j][1] * v[j][1]) + (v[j][2] * v[j][2] + v[j][3] * v[j][3]); }
        s = wave_sum(s); if (F.lane < 16) ssq1[(size_t)m * 16 + F.lane] = F.lane == 0 ? s : 0.f;
#pragma unroll
        for (int j = 0; j < 4; ++j) { ((f32x4*)(F.X + (size_t)m * 1024))[F.lane + 64 * j] = v[j];
            ((u32x2*)(XB + (size_t)m * 1024))[F.lane + 64 * j] = (u32x2){cvt_pk_bf16(v[j][0], v[j][1]), cvt_pk_bf16(v[j][2], v[j][3])}; } }
}

typedef float f32x16 __attribute__((ext_vector_type(16)));
typedef short v4i16_t __attribute__((ext_vector_type(4)));
constexpr int AT_KP0 = 208, AT_KP1 = 144, AT_VP = 192;
constexpr int AT_KBYTES = 64 * 208, AT_VBYTES = 64 * 192, AT_STAGE = AT_KBYTES + AT_VBYTES;
struct AttnDesc {
    const bf16_t* q; const bf16_t* k; const bf16_t* k2; const bf16_t* v; bf16_t* o; float* lse;
    int qs, ks, k2s, vs, os, lses;
    int m0, nq;
    int kt0, kt1;
};
template <int MODE>
__device__ __forceinline__ void attn_unit(Frame& F, const AttnDesc& D) {
    constexpr int NKS = MODE == 0 ? 6 : 4, KP = MODE == 0 ? AT_KP0 : AT_KP1, CPR = MODE == 0 ? 20 : 16, NCH = 64 * CPR;
    constexpr float CS = MODE == 0 ? 0.14724353f : 0.18033688f;
    const int lane = F.lane, w = F.wave, r = lane & 31, hh = lane >> 5, tid = F.tid;
    LAS unsigned char* lds = F.lds;
    const bool active = w * 32 < D.nq;
    const int mq = D.m0 + 32 * w + r;
    const int kt_hi = (D.m0 + 32 * w + 31) >> 6;
    const int kt_lo = MODE == 0 ? 0 : max(0, (D.m0 + 32 * w - 128) >> 6);
    bf16x8 qf[NKS];
    if (active) {
#pragma unroll
        for (int ks = 0; ks < NKS; ++ks) qf[ks] = *(const bf16x8*)(D.q + (size_t)mq * D.qs + 16 * ks + 8 * hh);
    } else {
#pragma unroll
        for (int ks = 0; ks < NKS; ++ks) qf[ks] = (bf16x8){0, 0, 0, 0, 0, 0, 0, 0};
    }
    f32x16 o0, o1;
#pragma unroll
    for (int i = 0; i < 16; ++i) { o0[i] = 0.f; o1[i] = 0.f; }
    float mrun = -3.0e38f, lrun = 0.f;
    u32x4 st[3];
    auto stage_load = [&](int kt) {
#pragma unroll
        for (int i = 0; i < 3; ++i) { const int c = tid + 512 * i;
            if (c < NCH) { const int key = c / CPR, part = c % CPR; const size_t mk = (size_t)(64 * kt + key);
                const bf16_t* src;
                if (MODE == 0) src = part < 8 ? D.k + mk * D.ks + part * 8 : (part < 12 ? D.k2 + mk * D.k2s + (part - 8) * 8 : D.v + mk * D.vs + (part - 12) * 8);
                else src = part < 8 ? D.k + mk * D.ks + part * 8 : D.v + mk * D.vs + (part - 8) * 8;
                st[i] = *(const u32x4*)src; } }
    };
    auto stage_store = [&](int buf) {
#pragma unroll
        for (int i = 0; i < 3; ++i) { const int c = tid + 512 * i;
            if (c < NCH) { const int key = c / CPR, part = c % CPR; constexpr int KPARTS = MODE == 0 ? 12 : 8;
                LAS unsigned char* dst = lds + buf * AT_STAGE + (part < KPARTS ? key * KP + part * 16 : AT_KBYTES + key * AT_VP + (part - KPARTS) * 16);
                *(LAS u32x4*)dst = st[i]; } }
    };
    __syncthreads();
    stage_load(D.kt0); stage_store(0);
    __syncthreads();
    const int vlane = (hh * 4 + ((lane & 15) >> 2)) * AT_VP + (16 * ((lane >> 4) & 1) + 4 * (lane & 3)) * 2;
    for (int kt = D.kt0; kt <= D.kt1; ++kt) {
        const int buf = (kt - D.kt0) & 1;
        if (kt < D.kt1) stage_load(kt + 1);
        if (active && kt >= kt_lo && kt <= kt_hi) {
            const LAS unsigned char* Kl = lds + buf * AT_STAGE; const LAS unsigned char* Vl = Kl + AT_KBYTES;
            f32x16 s0, s1;
#pragma unroll
            for (int i = 0; i < 16; ++i) { s0[i] = 0.f; s1[i] = 0.f; }
#pragma unroll
            for (int ks = 0; ks < NKS; ++ks) {
                const bf16x8 k0 = *(const LAS bf16x8*)(Kl + r * KP + (16 * ks + 8 * hh) * 2);
                const bf16x8 k1 = *(const LAS bf16x8*)(Kl + (32 + r) * KP + (16 * ks + 8 * hh) * 2);
                s0 = __builtin_amdgcn_mfma_f32_32x32x16_bf16(k0, qf[ks], s0, 0, 0, 0);
                s1 = __builtin_amdgcn_mfma_f32_32x32x16_bf16(k1, qf[ks], s1, 0, 0, 0);
            }
            const bool edge = (kt == kt_hi) || (MODE == 1 && kt <= kt_lo + 1);
            if (edge) {
#pragma unroll
                for (int i = 0; i < 16; ++i) { const int key0 = 64 * kt + (i & 3) + 8 * (i >> 2) + 4 * hh, key1 = key0 + 32;
                    const bool v0 = key0 <= mq && (MODE == 0 || key0 >= mq - 128), v1 = key1 <= mq && (MODE == 0 || key1 >= mq - 128);
                    s0[i] = v0 ? s0[i] : -3.0e38f; s1[i] = v1 ? s1[i] : -3.0e38f; }
            }
            float mx = fmaxf(s0[0], s1[0]);
#pragma unroll
            for (int i = 1; i < 16; ++i) mx = fmaxf(mx, fmaxf(s0[i], s1[i]));
            mx = fmaxf(mx, __shfl_xor(mx, 32));
            const float mnew = fmaxf(mrun, mx * CS);
            const float alpha = __builtin_amdgcn_exp2f(mrun - mnew);
            mrun = mnew;
            float ps = 0.f;
#pragma unroll
            for (int i = 0; i < 16; ++i) { s0[i] = __builtin_amdgcn_exp2f(s0[i] * CS - mnew); s1[i] = __builtin_amdgcn_exp2f(s1[i] * CS - mnew); ps += s0[i] + s1[i]; }
            lrun = lrun * alpha + ps;
#pragma unroll
            for (int i = 0; i < 16; ++i) { o0[i] *= alpha; o1[i] *= alpha; }
#pragma unroll
            for (int sb = 0; sb < 2; ++sb)
#pragma unroll
                for (int s2 = 0; s2 < 2; ++s2) {
                    const f32x16& pp = sb == 0 ? s0 : s1;
                    u32x4 pw; pw.x = cvt_pk_bf16(pp[8 * s2 + 0], pp[8 * s2 + 1]); pw.y = cvt_pk_bf16(pp[8 * s2 + 2], pp[8 * s2 + 3]); pw.z = cvt_pk_bf16(pp[8 * s2 + 4], pp[8 * s2 + 5]); pw.w = cvt_pk_bf16(pp[8 * s2 + 6], pp[8 * s2 + 7]);
                    const bf16x8 pf = __builtin_bit_cast(bf16x8, pw);
                    const LAS unsigned char* vb = Vl + (32 * sb + 16 * s2) * AT_VP + vlane;
#pragma unroll
                    for (int blk = 0; blk < 2; ++blk) {
                        const v4i16_t t0 = __builtin_amdgcn_ds_read_tr16_b64_v4i16((LAS v4i16_t*)(vb + blk * 64));
                        const v4i16_t t1 = __builtin_amdgcn_ds_read_tr16_b64_v4i16((LAS v4i16_t*)(vb + blk * 64 + 8 * AT_VP));
                        const bf16x8 vf = (bf16x8){t0[0], t0[1], t0[2], t0[3], t1[0], t1[1], t1[2], t1[3]};
                        if (blk == 0) o0 = __builtin_amdgcn_mfma_f32_32x32x16_bf16(vf, pf, o0, 0, 0, 0); else o1 = __builtin_amdgcn_mfma_f32_32x32x16_bf16(vf, pf, o1, 0, 0, 0);
                    }
                }
        }
        if (kt < D.kt1) stage_store(buf ^ 1);
        __syncthreads();
    }
    if (active) {
        const float lt = lrun + __shfl_xor(lrun, 32), il = 1.0f / lt;
        bf16_t* op = D.o + (size_t)mq * D.os;
#pragma unroll
        for (int blk = 0; blk < 2; ++blk)
#pragma unroll
            for (int g4 = 0; g4 < 4; ++g4) { const f32x16& oo = blk == 0 ? o0 : o1;
                *(u32x2*)(op + 32 * blk + 8 * g4 + 4 * hh) = (u32x2){cvt_pk_bf16(oo[4 * g4] * il, oo[4 * g4 + 1] * il), cvt_pk_bf16(oo[4 * g4 + 2] * il, oo[4 * g4 + 3] * il)}; }
        if (MODE == 1 && hh == 0) D.lse[(size_t)mq * D.lses] = mrun + __builtin_amdgcn_logf(lt);
    }
}

__device__ __forceinline__ void mla_attn_phase(Frame& F) {
    unsigned char* ws = F.ws;
    for (int p = F.vcu; p < 512; p += F.G) {
        const int bh = p >> 2, j = p & 3, b = bh >> 4, h = bh & 15;
#pragma unroll 1
        for (int half = 0; half < 2; ++half) { const int qb = half == 0 ? 7 - j : j;
            AttnDesc D;
            D.q = (const bf16_t*)(ws + WS_Q) + (size_t)b * SEQ * 1536 + h * 96; D.qs = 1536;
            D.k = (const bf16_t*)(ws + WS_KN) + (size_t)b * SEQ * 1024 + h * 64; D.ks = 1024;
            D.k2 = (const bf16_t*)(ws + WS_KPE) + (size_t)b * SEQ * 32; D.k2s = 32;
            D.v = (const bf16_t*)(ws + WS_V) + (size_t)b * SEQ * 1024 + h * 64; D.vs = 1024;
            D.o = (bf16_t*)(ws + WS_OA) + (size_t)b * SEQ * 1024 + h * 64; D.os = 1024; D.lse = nullptr; D.lses = 0;
            D.m0 = qb * 256; D.nq = 256; D.kt0 = 0; D.kt1 = 4 * qb + 3;
            attn_unit<0>(F, D); }
    }
}
__device__ __forceinline__ void dil_attn_phase(Frame& F) {
    unsigned char* ws = F.ws; const bf16_t* DIL = (const bf16_t*)(ws + WS_DIL); bf16_t* OG = (bf16_t*)(ws + WS_OG); float* LSE = (float*)(ws + WS_LSE);
    for (int u = F.vcu; u < 1024; u += F.G) {
        int g, b, h, rr, c, d, nq;
        if (u < 256) { g = 0; b = u >> 5; h = (u >> 3) & 3; c = u & 7; rr = 0; d = 1; nq = 256; }
        else if (u < 512) { const int v = u - 256; g = 1; b = v >> 5; h = (v >> 3) & 3; rr = (v >> 1) & 3; c = v & 1; d = 4; nq = 256; }
        else { const int v = u - 512; g = 2; b = v >> 6; h = (v >> 4) & 3; rr = v & 15; c = 0; d = 16; nq = 128; }
        AttnDesc D; const size_t row0 = (size_t)b * SEQ + rr;
        D.q = DIL + row0 * 2304 + g * 768 + h * 64; D.qs = d * 2304; D.k = D.q + 256; D.ks = d * 2304; D.k2 = nullptr; D.k2s = 0; D.v = D.q + 512; D.vs = d * 2304;
        D.o = OG + ((size_t)g * T + row0) * 256 + h * 64; D.os = d * 256; D.lse = LSE + ((size_t)g * T + row0) * 4 + h; D.lses = d * 4;
        D.m0 = c * 256; D.nq = nq; D.kt0 = max(0, 4 * c - 2); D.kt1 = nq == 256 ? 4 * c + 3 : 1;
        attn_unit<1>(F, D);
    }
}
__device__ __forceinline__ void dil_merge(Frame& F) {
    unsigned char* ws = F.ws; const bf16_t* OG = (const bf16_t*)(ws + WS_OG); const float* LSE = (const float*)(ws + WS_LSE); bf16_t* OB = (bf16_t*)(ws + WS_OB);
    for (int i = F.vcu * NTHR + F.tid; i < T * 32; i += F.G * NTHR) { const int row = i >> 5, ch = i & 31, h = ch >> 3;
        const float l0 = LSE[(size_t)row * 4 + h], l1 = LSE[((size_t)T + row) * 4 + h], l2 = LSE[((size_t)2 * T + row) * 4 + h];
        const float mx = fmaxf(l0, fmaxf(l1, l2)); const float w0 = __builtin_amdgcn_exp2f(l0 - mx), w1 = __builtin_amdgcn_exp2f(l1 - mx), w2 = __builtin_amdgcn_exp2f(l2 - mx); const float inv = 1.0f / (w0 + w1 + w2);
        f32x4 a0, a1, b0, b1, c0, c1;
        unpack8(*(const u32x4*)(OG + (size_t)row * 256 + ch * 8), a0, a1); unpack8(*(const u32x4*)(OG + ((size_t)T + row) * 256 + ch * 8), b0, b1); unpack8(*(const u32x4*)(OG + ((size_t)2 * T + row) * 256 + ch * 8), c0, c1);
        const f32x4 r0 = (a0 * w0 + b0 * w1 + c0 * w2) * inv, r1 = (a1 * w0 + b1 * w1 + c1 * w2) * inv;
        *(u32x4*)(OB + (size_t)row * 256 + ch * 8) = pack8(r0, r1); }
}

__device__ __forceinline__ void dispatch1(Frame& F, const float* b_g, const float* b_e, int l) {
    unsigned char* ws = F.ws; const float* RL = (const float*)(ws + WS_RL); const float* ssq2 = (const float*)(ws + WS_SSQ2) + (size_t)l * T * 16;
    int* tok_e = (int*)(ws + RT_TOK_E); float* tok_w = (float*)(ws + RT_TOK_W); float* tok_rs = (float*)(ws + RT_TOK_RS);
    int* cnt = (int*)(ws + CTL_CNT) + l * 64;
    LAS int* hist = (LAS int*)F.lds;
    if (F.tid < 64) hist[F.tid] = 0;
    __syncthreads();
    for (int t = F.vcu * NTHR + F.tid; t < T; t += F.G * NTHR) {
        const float rs = rsqrtf(part_sum<16>(ssq2 + (size_t)t * 16) * (1.0f / 1024.0f) + EPS);
        float gl[8];
#pragma unroll
        for (int j = 0; j < 8; ++j) { float s = 0.f;
#pragma unroll
            for (int ks = 0; ks < 4; ++ks) s += RL[((size_t)ks * T + t) * 72 + j];
            gl[j] = s * rs + b_g[j]; }
        int gs = 0; float gm = gl[0];
#pragma unroll
        for (int j = 1; j < 8; ++j) if (gl[j] > gm) { gm = gl[j]; gs = j; }
        float den = 0.f;
#pragma unroll
        for (int j = 0; j < 8; ++j) den += __expf(gl[j] - gm);
        const float pg = 1.0f / den;
        float el[8];
#pragma unroll
        for (int j = 0; j < 8; ++j) { float s = 0.f;
#pragma unroll
            for (int ks = 0; ks < 4; ++ks) s += RL[((size_t)ks * T + t) * 72 + 8 + gs * 8 + j];
            el[j] = s * rs + b_e[gs * 8 + j]; }
        int i0 = 0; float v0 = el[0];
#pragma unroll
        for (int j = 1; j < 8; ++j) if (el[j] > v0) { v0 = el[j]; i0 = j; }
        int i1 = -1; float v1 = -3.0e38f;
#pragma unroll
        for (int j = 0; j < 8; ++j) if (j != i0 && el[j] > v1) { v1 = el[j]; i1 = j; }
        const float ex = __expf(v1 - v0), w0 = pg / (1.0f + ex), w1 = pg * ex / (1.0f + ex);
        const int e0 = gs * 8 + i0, e1 = gs * 8 + i1;
        tok_e[2 * t] = e0; tok_e[2 * t + 1] = e1; tok_w[2 * t] = w0; tok_w[2 * t + 1] = w1; tok_rs[t] = rs;
        atomicAdd((int*)&hist[e0], 1); atomicAdd((int*)&hist[e1], 1);
    }
    __syncthreads();
    if (F.tid < 64 && hist[F.tid]) atomicAdd(cnt + F.tid, hist[F.tid]);
    __syncthreads();
}
__device__ __forceinline__ void dispatch2(Frame& F, int l) {
    unsigned char* ws = F.ws;
    const int* tok_e = (const int*)(ws + RT_TOK_E); const float* tok_w = (const float*)(ws + RT_TOK_W); const float* tok_rs = (const float*)(ws + RT_TOK_RS);
    int* dest = (int*)(ws + RT_DEST); int* row_tok = (int*)(ws + RT_ROW_TOK); float* row_w = (float*)(ws + RT_ROW_W); float* row_rs = (float*)(ws + RT_ROW_RS); int* blk_e = (int*)(ws + RT_BLK_E);
    const int* cnt = (const int*)(ws + CTL_CNT) + l * 64; int* fill = (int*)(ws + CTL_CNT) + 256 + l * 64;
    LAS int* pst = (LAS int*)F.lds;
    if (F.tid < 64) pst[64 + F.tid] = cnt[F.tid];
    __syncthreads();
    if (F.tid == 0) { int acc = 0; for (int e = 0; e < 64; ++e) { pst[e] = acc; acc += (pst[64 + e] + 255) & ~255; } pst[128] = acc; }
    __syncthreads();
    for (int t = F.vcu * NTHR + F.tid; t < T; t += F.G * NTHR) {
#pragma unroll
        for (int k = 0; k < 2; ++k) { const int e = tok_e[2 * t + k]; const int slot = pst[e] + atomicAdd(fill + e, 1);
            row_tok[slot] = t; row_w[slot] = tok_w[2 * t + k]; row_rs[slot] = tok_rs[t]; dest[2 * t + k] = slot; }
    }
    for (int e = F.vcu; e < 64; e += F.G) { const int c = pst[64 + e], pc = (c + 255) & ~255;
        for (int s = c + F.tid; s < pc; s += NTHR) { row_tok[pst[e] + s] = 0; row_w[pst[e] + s] = 0.f; row_rs[pst[e] + s] = 0.f; } }
    if (F.vcu == 0) { const int nblk = pst[128] >> 8;
        for (int bk = F.tid; bk < nblk; bk += NTHR) { int ee = 0; for (int j = 0; j < 64; ++j) if (pst[64 + j] > 0 && pst[j] <= bk * 256) ee = j; blk_e[bk] = ee; }
        if (F.tid == 0) blk_e[255] = nblk; }
    __syncthreads();
}

__device__ __forceinline__ void combine_norm(Frame& F, const float* g_ple) {
    unsigned char* ws = F.ws; const bf16_t* YS = (const bf16_t*)(ws + WS_YS); const int* dest = (const int*)(ws + RT_DEST); bf16_t* XN = (bf16_t*)(ws + WS_XN);
    const int gw = F.vcu * NWAVES + F.wave, NGW = F.G * NWAVES;
    f32x4 gp[4];
#pragma unroll
    for (int j = 0; j < 4; ++j) gp[j] = ((const f32x4*)g_ple)[F.lane + 64 * j];
    for (int m = gw; m < T; m += NGW) { const int d0 = dest[2 * m], d1 = dest[2 * m + 1];
        f32x4* xr = (f32x4*)(F.X + (size_t)m * 1024) + F.lane; const u32x2* y0 = (const u32x2*)(YS + (size_t)d0 * 1024) + F.lane; const u32x2* y1 = (const u32x2*)(YS + (size_t)d1 * 1024) + F.lane;
        f32x4 v[4]; float s = 0.f;
#pragma unroll
        for (int j = 0; j < 4; ++j) { v[j] = xr[64 * j]; const u32x2 a = y0[64 * j], b = y1[64 * j];
#ifndef EXP_NO_MOE
            v[j][0] += bf_lo(a.x) + bf_lo(b.x); v[j][1] += bf_hi(a.x) + bf_hi(b.x); v[j][2] += bf_lo(a.y) + bf_lo(b.y); v[j][3] += bf_hi(a.y) + bf_hi(b.y);
#endif
            s += (v[j][0] * v[j][0] + v[j][1] * v[j][1]) + (v[j][2] * v[j][2] + v[j][3] * v[j][3]); }
        const float rs = rsqrtf(wave_sum(s) * (1.0f / 1024.0f) + EPS);
#pragma unroll
        for (int j = 0; j < 4; ++j) { xr[64 * j] = v[j]; const f32x4 n = v[j] * rs * gp[j];
            ((u32x2*)(XN + (size_t)m * 1024))[F.lane + 64 * j] = (u32x2){cvt_pk_bf16(n[0], n[1]), cvt_pk_bf16(n[2], n[3])}; } }
}
__device__ __forceinline__ void final_norm(Frame& F, const float* g_final) {
    const float* ssq = (const float*)(F.ws + WS_SSQ1) + (size_t)4 * T * 16;
    const int gw = F.vcu * NWAVES + F.wave, NGW = F.G * NWAVES;
    f32x4 gp[4];
#pragma unroll
    for (int j = 0; j < 4; ++j) gp[j] = ((const f32x4*)g_final)[F.lane + 64 * j];
    for (int m = gw; m < T; m += NGW) { const float rs = rsqrtf(part_sum<16>(ssq + (size_t)m * 16) * (1.0f / 1024.0f) + EPS); f32x4* xr = (f32x4*)(F.X + (size_t)m * 1024) + F.lane;
#pragma unroll
        for (int j = 0; j < 4; ++j) xr[64 * j] = xr[64 * j] * rs * gp[j]; }
}

constexpr int PH_PER_LAYER = 13, N_PHASES = 2 + DEPTH * PH_PER_LAYER;
__global__ void __launch_bounds__(NTHR, 2) fwd_kernel(Args args) {
    extern __shared__ __attribute__((aligned(16))) unsigned char lds_raw[];
    Frame F;
    F.lds = (LAS unsigned char*)lds_raw;
    F.tid = threadIdx.x; F.lane = F.tid & 63; F.wave = __builtin_amdgcn_readfirstlane(F.tid >> 6);
    F.G = gridDim.x; { const int bx = blockIdx.x; F.vcu = (F.G % 8 == 0) ? (bx % 8) * (F.G / 8) + bx / 8 : bx; }
    F.ws = nullptr; F.X = nullptr;
    for (int u = F.tid; u < (LDS_BYTES - LDSCTL_OFF) / 4; u += NTHR) ((LAS unsigned*)(F.lds + LDSCTL_OFF))[u] = 0u;
    __syncthreads();
    const int lo = args.ph_lo, hi = args.ph_hi;
    const bool use_bar = (hi - lo) > 1;
    XcdBarrier bar; bar.bar = (unsigned*)(args.ws + WS_CTL) + CW_BAR; bar.x = 0; bar.st = nullptr;
    if (use_bar) bar = xcd_barrier_post((unsigned*)(args.ws + WS_CTL) + CW_BAR, (volatile LAS unsigned*)(F.lds + MISC_OFF + 32));
#ifndef PH_EN
#define PH_EN(j) 1
#endif
#define IN(k) (lo <= (k) && (k) < hi)
#define INL(j) (PH_EN(j) && IN(p0 + (j)))
#define SEAM(k) do { if (IN(k) && IN((k) + 1)) xcd_barrier(bar); } while (0)
#define KARGS() ({ const AS4 Args* _p = (const AS4 Args*)__builtin_amdgcn_kernarg_segment_ptr(); asm volatile("" : "+s"(_p)); _p; })
#define PHASE_ENV const AS4 Args* ap = KARGS(); unsigned char* ws = ap->ws; Frame P = F; P.ws = ws; P.X = ap->out; int cidl = cid; \
    asm volatile("" : "+v"(P.tid), "+v"(P.lane)); asm volatile("" : "+s"(P.vcu), "+s"(P.G), "+s"(P.wave), "+s"(cidl)); (void)ws; (void)cidl
    const int cid = (int)blockIdx.x;

    if (IN(0)) { PHASE_ENV; prologue(P, ap); }
    SEAM(0);

#pragma unroll 1
    for (int l = 0; l < DEPTH; ++l) {
        const int p0 = 1 + PH_PER_LAYER * l;
        if (INL(0)) {
            PHASE_ENV; unsigned char* wd = ws + WS_WD + (size_t)l * WD_STRIDE;
            pg8::Gemm g{(const bf16_t*)(ws + WS_XB), (const bf16_t*)(wd + WD_IN), 1024, 1024, 1024, nullptr}; pg8::DenseOrder S; S.init(64, 21, 1024, 1024, P.G, cidl);
            EpiInProj E{(const float*)(ws + WS_SSQ1) + (size_t)l * T * 16, (bf16_t*)(ws + WS_CQ), (bf16_t*)(ws + WS_CKV), (bf16_t*)(ws + WS_KPE), (bf16_t*)(ws + WS_DIL), (bf16_t*)(ws + WS_SG),
                        (float*)(ws + WS_SSQQ) + (size_t)l * T * 8, (float*)(ws + WS_SSQKV) + (size_t)l * T * 4, (const f32x2*)(ws + WS_ROPE_DIL), (const f32x2*)(ws + WS_ROPE_MLA)};
#ifdef EXP_SIMPLE_EPI
            EpiScaleStore E2{nullptr, 0.f, (bf16_t*)(ws + WS_YS), NIN}; pg8::gemm_phase<EpiScaleStore, pg8::DenseOrder, false, true>(P.lds, g, S, E2); (void)E;
#else
            pg8::gemm_phase<EpiInProj, pg8::DenseOrder, false, true>(P.lds, g, S, E);
#endif
        }
        SEAM(p0 + 0);
        if (INL(1)) {
            { PHASE_ENV; unsigned char* wd = ws + WS_WD + (size_t)l * WD_STRIDE;
              pg8::Gemm g{(const bf16_t*)(ws + WS_CQ), (const bf16_t*)(wd + WD_Q), 512, 512, 512, nullptr}; pg8::DenseOrder S; S.init(64, 6, 512, 512, P.G, cidl);
              EpiQup E{(const float*)(ws + WS_SSQQ) + (size_t)l * T * 8, (bf16_t*)(ws + WS_Q), (const f32x2*)(ws + WS_ROPE_MLA)}; pg8::gemm_phase<EpiQup, pg8::DenseOrder, false, true>(P.lds, g, S, E); }
            { PHASE_ENV; unsigned char* wd = ws + WS_WD + (size_t)l * WD_STRIDE;
              pg8::Gemm g{(const bf16_t*)(ws + WS_CKV), (const bf16_t*)(wd + WD_K), 256, 256, 256, nullptr}; pg8::DenseOrder S; S.init(64, 4, 256, 256, P.G, cidl);
              EpiScaleStore E{(const float*)(ws + WS_SSQKV) + (size_t)l * T * 4, 1.0f / 256.0f, (bf16_t*)(ws + WS_KN), 1024}; pg8::gemm_phase<EpiScaleStore, pg8::DenseOrder, false, true>(P.lds, g, S, E); }
            { PHASE_ENV; unsigned char* wd = ws + WS_WD + (size_t)l * WD_STRIDE;
              pg8::Gemm g{(const bf16_t*)(ws + WS_CKV), (const bf16_t*)(wd + WD_V), 256, 256, 256, nullptr}; pg8::DenseOrder S; S.init(64, 4, 256, 256, P.G, cidl);
              EpiScaleStore E{(const float*)(ws + WS_SSQKV) + (size_t)l * T * 4, 1.0f / 256.0f, (bf16_t*)(ws + WS_V), 1024}; pg8::gemm_phase<EpiScaleStore, pg8::DenseOrder, false, true>(P.lds, g, S, E); }
            { PHASE_ENV; dil_attn_phase(P); }
        }
        SEAM(p0 + 1);
        if (INL(2)) { { PHASE_ENV; mla_attn_phase(P); } { PHASE_ENV; dil_merge(P); } }
        SEAM(p0 + 2);
        if (INL(3)) {
            PHASE_ENV; unsigned char* wd = ws + WS_WD + (size_t)l * WD_STRIDE;
            pg8::Gemm g{(const bf16_t*)(ws + WS_OB), (const bf16_t*)(wd + WD_B), 256, 256, 256, nullptr}; pg8::DenseOrder S; S.init(64, 4, 256, 256, P.G, cidl);
            EpiGate<0> E{(const bf16_t*)(ws + WS_SG), 1024, nullptr, (bf16_t*)(ws + WS_TMPB)}; pg8::gemm_phase<EpiGate<0>, pg8::DenseOrder, false, false>(P.lds, g, S, E);
        }
        SEAM(p0 + 3);
        if (INL(4)) {
            PHASE_ENV; unsigned char* wd = ws + WS_WD + (size_t)l * WD_STRIDE;
            pg8::Gemm g{(const bf16_t*)(ws + WS_OA), (const bf16_t*)(wd + WD_A), 1024, 1024, 1024, nullptr}; pg8::DenseOrder S; S.init(64, 4, 1024, 1024, P.G, cidl);
            EpiGate<1> E{(const bf16_t*)(ws + WS_SG), 0, (const bf16_t*)(ws + WS_TMPB), (bf16_t*)(ws + WS_MERGED)}; pg8::gemm_phase<EpiGate<1>, pg8::DenseOrder, false, false>(P.lds, g, S, E);
        }
        SEAM(p0 + 4);
        if (INL(5)) {
            PHASE_ENV; unsigned char* wd = ws + WS_WD + (size_t)l * WD_STRIDE;
            pg8::Gemm g{(const bf16_t*)(ws + WS_MERGED), (const bf16_t*)(wd + WD_O), 1024, 1024, 1024, nullptr}; pg8::DenseOrder S; S.init(64, 4, 1024, 1024, P.G, cidl);
            EpiResid<0> E{P.X, (bf16_t*)(ws + WS_XB), (float*)(ws + WS_SSQ2) + (size_t)l * T * 16, nullptr}; pg8::gemm_phase<EpiResid<0>, pg8::DenseOrder, false, false>(P.lds, g, S, E);
        }
        SEAM(p0 + 5);
        if (INL(6)) {
            { PHASE_ENV; unsigned char* wd = ws + WS_WD + (size_t)l * WD_STRIDE;
              pg8::Gemm g{(const bf16_t*)(ws + WS_XB), (const bf16_t*)(wd + WD_R), 1024, 1024, 256, nullptr}; RouterOrder S{P.G, cidl};
              EpiRouter E{(float*)(ws + WS_RL)}; pg8::gemm_phase<EpiRouter, RouterOrder, false, false>(P.lds, g, S, E); }
            { PHASE_ENV; unsigned char* wd = ws + WS_WD + (size_t)l * WD_STRIDE;
              pg8::Gemm g{(const bf16_t*)(ws + WS_PB) + (size_t)l * T * 256, (const bf16_t*)(wd + WD_P), 256, 256, 256, nullptr}; pg8::DenseOrder S; S.init(64, 4, 256, 256, P.G, cidl);
              EpiScaleStore E{nullptr, 0.f, (bf16_t*)(ws + WS_E), 1024}; pg8::gemm_phase<EpiScaleStore, pg8::DenseOrder, false, false>(P.lds, g, S, E); }
        }
        SEAM(p0 + 6);
        if (INL(7)) { PHASE_ENV; dispatch1(P, (const float*)ap->in[14] + l * 8, (const float*)ap->in[16] + l * 64, l); }
        SEAM(p0 + 7);
        if (INL(8)) { PHASE_ENV; dispatch2(P, l); }
        SEAM(p0 + 8);
        if (INL(9)) {
            PHASE_ENV;
            pg8::Gemm g{(const bf16_t*)(ws + WS_XB), (const bf16_t*)(ws + WS_W13 + (size_t)l * W13_STRIDE), 1024, 1024, 1024, (const int*)(ws + RT_ROW_TOK)}; ExpertOrder<2> S{(const int*)(ws + RT_BLK_E), P.G, cidl};
            EpiExp1 E{(const float*)(ws + RT_ROW_RS), (bf16_t*)(ws + WS_H)}; pg8::gemm_phase<EpiExp1, ExpertOrder<2>, true, true>(P.lds, g, S, E);
        }
        SEAM(p0 + 9);
        if (INL(10)) {
            PHASE_ENV;
            pg8::Gemm g{(const bf16_t*)(ws + WS_H), (const bf16_t*)(ws + WS_W2 + (size_t)l * W2_STRIDE), 256, 256, 256, nullptr}; ExpertOrder<4> S{(const int*)(ws + RT_BLK_E), P.G, cidl};
            EpiExp2 E{(const float*)(ws + RT_ROW_W), (bf16_t*)(ws + WS_YS)}; pg8::gemm_phase<EpiExp2, ExpertOrder<4>, false, true>(P.lds, g, S, E);
        }
        SEAM(p0 + 10);
        if (INL(11)) { PHASE_ENV; combine_norm(P, (const float*)ap->in[20] + l * 1024); }
        SEAM(p0 + 11);
        if (INL(12)) {
            PHASE_ENV; unsigned char* wd = ws + WS_WD + (size_t)l * WD_STRIDE;
            pg8::Gemm g{(const bf16_t*)(ws + WS_XN), (const bf16_t*)(wd + WD_G), 1024, 1024, 1024, nullptr}; pg8::DenseOrder S; S.init(64, 4, 1024, 1024, P.G, cidl);
            EpiResid<1> E{P.X, (bf16_t*)(ws + WS_XB), (float*)(ws + WS_SSQ1) + (size_t)(l + 1) * T * 16, (const bf16_t*)(ws + WS_E)}; pg8::gemm_phase<EpiResid<1>, pg8::DenseOrder, false, false>(P.lds, g, S, E);
        }
        SEAM(p0 + 12);
    }
    if (IN(N_PHASES - 1)) { PHASE_ENV; final_norm(P, (const float*)ap->in[23]); }
#undef IN
#undef INL
#undef SEAM
}


#ifdef DUMP_MODE
__global__ void dump_kernel(unsigned char* ws, float* out) {
    const size_t N = (size_t)T * 1024;
    for (size_t i = blockIdx.x * (size_t)blockDim.x + threadIdx.x; i < N; i += (size_t)gridDim.x * blockDim.x) {
        float v = 0.f;
#if DUMP_MODE == 1
        const bf16_t* CQ = (const bf16_t*)(ws + WS_CQ); const bf16_t* CKV = (const bf16_t*)(ws + WS_CKV); const bf16_t* KPE = (const bf16_t*)(ws + WS_KPE);
        const bf16_t* DIL = (const bf16_t*)(ws + WS_DIL); const bf16_t* SG = (const bf16_t*)(ws + WS_SG);
        v = bf_lo(CQ[i % ((size_t)T * 512)]) + bf_lo(CKV[i % ((size_t)T * 256)]) + bf_lo(KPE[i % ((size_t)T * 32)]) + bf_lo(DIL[i]) + bf_lo(DIL[i + N]) + bf_lo(DIL[(i % ((size_t)T * 256)) + 2 * N]) + bf_lo(SG[i]) + bf_lo(SG[i + N]);
#elif DUMP_MODE == 2
        const bf16_t* Q = (const bf16_t*)(ws + WS_Q); const bf16_t* KN = (const bf16_t*)(ws + WS_KN); const bf16_t* V = (const bf16_t*)(ws + WS_V);
        v = bf_lo(Q[i]) + bf_lo(Q[(i % ((size_t)T * 512)) + N]) + bf_lo(KN[i]) + bf_lo(V[i]);
#elif DUMP_MODE == 4
        const bf16_t* W = (const bf16_t*)(ws + WS_WD); const bf16_t* XB = (const bf16_t*)(ws + WS_XB); const float* R1 = (const float*)(ws + WS_ROPE_MLA); const float* R2 = (const float*)(ws + WS_ROPE_DIL);
        const bf16_t* W13 = (const bf16_t*)(ws + WS_W13); const bf16_t* W2 = (const bf16_t*)(ws + WS_W2); const bf16_t* PB = (const bf16_t*)(ws + WS_PB); const float* S1 = (const float*)(ws + WS_SSQ1);
        v = bf_lo(XB[i]) + R1[i % ((size_t)T * 32)] + R2[i % ((size_t)T * 16)] + bf_lo(PB[i]) + S1[i % T] * 1e-3f;
        for (int l = 0; l < 4; ++l) { const bf16_t* wl = (const bf16_t*)(ws + WS_WD + (size_t)l * WD_STRIDE); v += bf_lo(wl[i % ((size_t)5152 * 1024)]) + bf_lo(wl[(WD_Q / 2) + (i % ((size_t)5242880))]);
            for (int k = 0; k < 2; ++k) v += bf_lo(W13[(size_t)l * (W13_STRIDE / 2) + k * N + i]) + bf_lo(W2[(size_t)l * (W2_STRIDE / 2) + (k * N + i) % ((size_t)16 * 1024 * 1024)]); }
        (void)W;
#elif DUMP_MODE == 5
        const bf16_t* Y = (const bf16_t*)(ws + WS_YS);
        { const size_t row = i / 1024, c = i % 1024; v = 0.f; for (int k = 0; k < 5; ++k) v += bf_lo(Y[row * 5376 + k * 1024 + c]); }
#elif DUMP_MODE == 6
        const bf16_t* SG = (const bf16_t*)(ws + WS_SG);
        v = bf_lo(SG[i]) + bf_lo(SG[i + N]);
#elif DUMP_MODE == 7
        const bf16_t* CQ = (const bf16_t*)(ws + WS_CQ); const bf16_t* CKV = (const bf16_t*)(ws + WS_CKV);
        v = bf_lo(CQ[i % ((size_t)T * 512)]) + bf_lo(CKV[i % ((size_t)T * 256)]);
#elif DUMP_MODE == 8
        const bf16_t* DIL = (const bf16_t*)(ws + WS_DIL);
        v = bf_lo(DIL[i]) + bf_lo(DIL[i + N]) + bf_lo(DIL[(i % ((size_t)T * 256)) + 2 * N]);
#elif DUMP_MODE == 3
        const bf16_t* OA = (const bf16_t*)(ws + WS_OA); const bf16_t* OB = (const bf16_t*)(ws + WS_OB);
        v = bf_lo(OA[i]) + bf_lo(OB[i % ((size_t)T * 256)]);
#endif
        out[i] = v;
    }
}
#endif
extern "C" void kernel_launch(void* const* d_in, const int* in_sizes, int n_in, void* d_out, int out_size, void* d_ws, size_t ws_size, hipStream_t stream) {
    static int grid = 0;
    if (grid == 0) {
        if (n_in != 24 || out_size != T * DM || ws_size < WS_END) { fprintf(stderr, "kernel_launch: unexpected shapes n_in %d out %d ws %zu\n", n_in, out_size, ws_size); grid = -1; return; }
        int dev = 0, cus = 0, per_cu = 0;
        if (hipGetDevice(&dev) != hipSuccess || hipDeviceGetAttribute(&cus, hipDeviceAttributeMultiprocessorCount, dev) != hipSuccess) { grid = -1; return; }
        if (hipFuncSetAttribute((const void*)fwd_kernel, hipFuncAttributeMaxDynamicSharedMemorySize, LDS_BYTES) != hipSuccess) { fprintf(stderr, "kernel_launch: hipFuncSetAttribute failed\n"); grid = -1; return; }
        if (hipOccupancyMaxActiveBlocksPerMultiprocessor(&per_cu, (const void*)fwd_kernel, NTHR, LDS_BYTES) != hipSuccess || per_cu < 1) fprintf(stderr, "kernel_launch: occupancy query says %d\n", per_cu);
        (void)hipGetLastError();
        grid = cus;
    }
    if (grid < 0) return;
    (void)hipMemsetAsync((char*)d_ws + WS_CTL, 0, CTL_ZERO_BYTES, stream);
    Args a{};
    for (int i = 0; i < 24; ++i) a.in[i] = d_in[i];
    a.out = (float*)d_out; a.ws = (unsigned char*)d_ws;
#if MK_PER_PHASE
#ifndef RUN_PHASES
#define RUN_PHASES N_PHASES
#endif
    for (int ph = 0; ph < RUN_PHASES; ++ph) { a.ph_lo = ph; a.ph_hi = ph + 1; hipLaunchKernelGGL(fwd_kernel, dim3(grid), dim3(NTHR), LDS_BYTES, stream, a); }
#ifdef DUMP_MODE
    hipLaunchKernelGGL(dump_kernel, dim3(1024), dim3(256), 0, stream, (unsigned char*)d_ws, (float*)d_out);
#endif
#else
    a.ph_lo = 0; a.ph_hi = N_PHASES; hipLaunchKernelGGL(fwd_kernel, dim3(grid), dim3(NTHR), LDS_BYTES, stream, a);
#endif
}
```

```cpp
#include <hip/hip_runtime.h>
#include <cstdio>
#include <cstdint>

#define LAS __attribute__((address_space(3)))
#define GAS __attribute__((address_space(1)))
#define AS4 __attribute__((address_space(4)))
typedef unsigned short bf16_t;
typedef short bf16x8 __attribute__((ext_vector_type(8)));
typedef float f32x4 __attribute__((ext_vector_type(4)));
typedef float f32x2 __attribute__((ext_vector_type(2)));
typedef unsigned u32x4 __attribute__((ext_vector_type(4)));
typedef unsigned u32x2 __attribute__((ext_vector_type(2)));

#ifndef MK_PER_PHASE
#define MK_PER_PHASE 0
#endif

constexpr int T = 16384, DM = 1024, SEQ = 2048, NBATCH = 8, DEPTH = 4;
constexpr int NIN_SRC = 5152, NIN = 5376;
constexpr int NE = 64;
constexpr int MAXBLK = 192;
constexpr float EPS = 1e-6f;
constexpr int NWAVES = 8, NTHR = 512;

constexpr size_t MiB = 1u << 20, KiB = 1u << 10;
constexpr size_t WS_CTL = 0, CTL_ZERO_BYTES = 2 * MiB;
constexpr int CW_TMO = 0, CW_BAR = 4096, CW_XCT = 20480, CW_XFLAG = 20480 + 256;
constexpr size_t CTL_CNT = 128 * KiB;
static_assert(CTL_CNT + 4096 <= CTL_ZERO_BYTES, "ctl");
constexpr size_t WS_ROPE_MLA = 2 * MiB;
constexpr size_t WS_ROPE_DIL = 4 * MiB;
constexpr size_t WS_ROUTE = 5 * MiB;
constexpr size_t RT_TOK_E = WS_ROUTE;
constexpr size_t RT_TOK_W = RT_TOK_E + 128 * KiB;
constexpr size_t RT_TOK_RS = RT_TOK_W + 128 * KiB;
constexpr size_t RT_DEST = RT_TOK_RS + 64 * KiB;
constexpr size_t RT_ROW_TOK = RT_DEST + 128 * KiB;
constexpr size_t RT_ROW_W = RT_ROW_TOK + 192 * KiB;
constexpr size_t RT_ROW_RS = RT_ROW_W + 192 * KiB;
constexpr size_t RT_BLK_E = RT_ROW_RS + 192 * KiB;
constexpr size_t RT_HIST = RT_BLK_E + 4096;
constexpr size_t RT_TS = RT_HIST + 4 * 64 * 64 * 4;
constexpr size_t RT_PLE_RS = RT_TS + 1024;
static_assert(RT_PLE_RS + 64 * KiB <= 8 * MiB, "route");
constexpr size_t WS_WD = 8 * MiB, WD_STRIDE = 21 * MiB;
constexpr size_t WD_IN = 0, WD_Q = 10 * MiB + 512 * KiB, WD_K = 12 * MiB, WD_V = 12 * MiB + 512 * KiB, WD_A = 13 * MiB, WD_B = 15 * MiB,
                 WD_O = 15 * MiB + 512 * KiB, WD_R = 17 * MiB + 512 * KiB, WD_G = 18 * MiB, WD_P = 20 * MiB;
constexpr size_t WS_W13 = 92 * MiB, W13_STRIDE = 64 * MiB;
constexpr size_t WS_W2 = 348 * MiB, W2_STRIDE = 32 * MiB;
constexpr size_t WS_PB = 476 * MiB;
constexpr size_t WS_XB = 508 * MiB, WS_XN = 540 * MiB, WS_CQ = 572 * MiB, WS_CKV = 588 * MiB, WS_KPE = 596 * MiB, WS_Q = 598 * MiB,
                 WS_KN = 646 * MiB, WS_V = 678 * MiB, WS_OA = 710 * MiB, WS_OB = 742 * MiB, WS_TMPB = 750 * MiB, WS_MERGED = 750 * MiB  ,
                 WS_E = 814 * MiB, WS_RL = 846 * MiB, WS_DIL = 866 * MiB, WS_SG = 938 * MiB, WS_YS = 220 * MiB  , WS_H = 316 * MiB  , WS_OG = 782 * MiB  , WS_LSE = 806 * MiB  ,
                 WS_SSQ1 = 1002 * MiB  , WS_SSQ2 = 1007 * MiB  , WS_SSQQ = 1011 * MiB  , WS_SSQKV = 1013 * MiB  , WS_END = 1014 * MiB;

constexpr int RING_BYTES = 131072, LDSCTL_OFF = RING_BYTES, MISC_OFF = LDSCTL_OFF + 320, LDS_BYTES = 147456;
constexpr int TAB_OFF = RING_BYTES + 1024, TAB_UNITS = 8;
static_assert(TAB_OFF + TAB_UNITS * 1024 <= LDS_BYTES, "lds");

typedef __bf16 bf16x2_t __attribute__((ext_vector_type(2)));
__device__ __forceinline__ unsigned cvt_pk_bf16(float lo, float hi) { f32x2 v = {lo, hi}; bf16x2_t b = __builtin_convertvector(v, bf16x2_t); return __builtin_bit_cast(unsigned, b); }
__device__ __forceinline__ float bf_lo(unsigned w) { return __uint_as_float(w << 16); }
__device__ __forceinline__ float bf_hi(unsigned w) { return __uint_as_float(w & 0xffff0000u); }
__device__ __forceinline__ float sigmoidf_(float x) { return __builtin_amdgcn_rcpf(1.0f + __expf(-x)); }
__device__ __forceinline__ u32x4 pack8(f32x4 a, f32x4 b) { u32x4 w; w.x = cvt_pk_bf16(a[0], a[1]); w.y = cvt_pk_bf16(a[2], a[3]); w.z = cvt_pk_bf16(b[0], b[1]); w.w = cvt_pk_bf16(b[2], b[3]); return w; }
__device__ __forceinline__ void unpack8(u32x4 w, f32x4& a, f32x4& b) { a = (f32x4){bf_lo(w.x), bf_hi(w.x), bf_lo(w.y), bf_hi(w.y)}; b = (f32x4){bf_lo(w.z), bf_hi(w.z), bf_lo(w.w), bf_hi(w.w)}; }
__device__ __forceinline__ float wave_sum(float v) {
#pragma unroll
    for (int o = 1; o < 64; o <<= 1) v += __shfl_xor(v, o);
    return v;
}
template <int NP> __device__ __forceinline__ float part_sum(const float* p) { float t = 0.f;
#pragma unroll
    for (int i = 0; i < NP / 4; ++i) { const f32x4 a = *(const f32x4*)(p + 4 * i); t += (a[0] + a[1]) + (a[2] + a[3]); }
    return t; }
#define LDS_WAIT() asm volatile("s_waitcnt lgkmcnt(0)" ::: "memory")
#define VM_WAIT() asm volatile("s_waitcnt vmcnt(0)" ::: "memory")

namespace pg8 {
constexpr int BM = 256, BK = 64, HALF = 128, HTB = HALF * BK * 2, NXCD = 8, WGM = 8;
__host__ __device__ __forceinline__ int lds_byte(int r, int c) { const int st = (r >> 4) * 2 + (c >> 5), rr = r & 15, cc = c & 31, ob = rr * 64 + cc * 2; return st * 1024 + (ob ^ (((ob >> 9) & 1) << 5)); }
__host__ __device__ __forceinline__ void stage_rc(int b, int& R, int& C) { const int st = b / 1024, sb = b % 1024, swz = sb ^ (((sb >> 9) & 1) << 5); R = (st >> 1) * 16 + swz / 64; C = (st & 1) * 32 + (swz % 64) / 2; }
__host__ __device__ __forceinline__ int perm32(int rho) { const int n = rho >> 4, i = rho & 15; return 8 * (i >> 2) + 4 * n + (i & 3); }

struct Unit { int pm, pn; unsigned a_off, b_off; int ord; int halfn; };
struct Gemm { const bf16_t* A; const bf16_t* Bt; int lda, ldb, K; const int* gather; };

struct DenseOrder {
    int nM, nN, nwg, G, c, lda, ldb, narrow_pn;
    __device__ void init(int nM_, int nN_, int lda_, int ldb_, int G_, int c_, int narrow_pn_ = -1) { nM = nM_; nN = nN_; nwg = nM * nN; G = G_; c = c_; lda = lda_; ldb = ldb_; narrow_pn = narrow_pn_; }
    __device__ __forceinline__ bool next(int i, Unit& u) const {
        const long L = (long)i * G + c; if (L >= nwg) return false;
        u.ord = i; int wgid = (int)L; { const int q = nwg / NXCD, r = nwg % NXCD, xcd = wgid % NXCD, off = wgid / NXCD; wgid = (xcd < r ? xcd * (q + 1) : r * (q + 1) + (xcd - r) * q) + off; }
        const int nig = WGM * nN, gid = wgid / nig, fm = gid * WGM, gsz = (nM - fm) < WGM ? (nM - fm) : WGM;
        u.pm = fm + ((wgid % nig) % gsz); u.pn = (wgid % nig) / gsz;
        u.a_off = (unsigned)u.pm * 256u * (unsigned)lda; u.b_off = (unsigned)u.pn * 256u * (unsigned)ldb; u.halfn = (u.pn == narrow_pn) ? 1 : 0; return true;
    }
};

template <class Epi, class Sched, bool GATHER, bool ALIGN_EPI, bool HALFN = false, bool MID = false>
__device__ __forceinline__ void gemm_phase(LAS unsigned char* lds, const Gemm g, const Sched& S, const Epi& E) {
    int tid_ = threadIdx.x; asm volatile("; gemm_phase entry" : "+v"(tid_));
    const int tid = tid_, wid = __builtin_amdgcn_readfirstlane(tid >> 6), lane = tid & 63, wr = wid >> 2, wc = wid & 3, fr = lane & 15, fq = lane >> 4;
    const int K = g.K, nt = K / BK, lda = g.lda, ldb = g.ldb;
    unsigned voffB[2], vAc[2][2], vAn[2][2]; int Rst[2], Cst[2];
#pragma unroll
    for (int i = 0; i < 2; ++i) { int R, C; stage_rc(tid * 16 + i * 8192, R, C); const int Rb = (R & ~31) + perm32(R & 31);
        Rst[i] = R; Cst[i] = C; voffB[i] = (unsigned)(Rb * ldb + C) * 2u;
        vAc[0][i] = (unsigned)(R * lda + C) * 2u; vAc[1][i] = (unsigned)((R + HALF) * lda + C) * 2u; vAn[0][i] = vAc[0][i]; vAn[1][i] = vAc[1][i]; }
    const size_t kstep = (size_t)(BK * 2);
    const size_t hstepB = (size_t)HALF * ldb * 2;
    const unsigned ldsw = (unsigned)wid * 1024u;
    const int aoff = lds_byte(wr * 64 + fr, fq * 8), boff = lds_byte(wc * 32 + fr, fq * 8);
#define PG8_SA(b, h) (((b) * 2 + (h)) * HTB)
#define PG8_SB(b, h) ((4 + (b) * 2 + (h)) * HTB)
#define PG8_STAGE(bufoff, gbase, voff) do { _Pragma("unroll") for (int _i = 0; _i < 2; ++_i) \
        __builtin_amdgcn_global_load_lds((const unsigned*)((const char*)(gbase) + (voff)[_i]), (LAS unsigned*)(lds + (bufoff) + ldsw + _i * 8192), 16, 0, 0); } while (0)
#define PG8_STAGE_A(bufoff, gbase, h, nx) do { _Pragma("unroll") for (int _i = 0; _i < 2; ++_i) \
        __builtin_amdgcn_global_load_lds((const unsigned*)((const char*)(gbase) + ((GATHER && (nx)) ? vAn[h][_i] : vAc[h][_i])), (LAS unsigned*)(lds + (bufoff) + ldsw + _i * 8192), 16, 0, 0); } while (0)
#define PG8_LDA(dst, b, h) do { _Pragma("unroll") for (int m = 0; m < 4; ++m) _Pragma("unroll") for (int k = 0; k < 2; ++k) dst[m][k] = *(const LAS bf16x8*)(lds + PG8_SA(b, h) + aoff + m * 2048 + k * 1024); } while (0)
#define PG8_LDB(dst, b, h) do { _Pragma("unroll") for (int n = 0; n < 2; ++n) _Pragma("unroll") for (int k = 0; k < 2; ++k) dst[n][k] = *(const LAS bf16x8*)(lds + PG8_SB(b, h) + boff + n * 2048 + k * 1024); } while (0)
#define PG8_MMA(ai, bj, At, Bt) do { __builtin_amdgcn_s_setprio(1); _Pragma("unroll") for (int m = 0; m < 4; ++m) _Pragma("unroll") for (int n = 0; n < 2; ++n) _Pragma("unroll") for (int k = 0; k < 2; ++k) \
        acc[ai][bj][m][n] = __builtin_amdgcn_mfma_f32_16x16x32_bf16(Bt[n][k], At[m][k], acc[ai][bj][m][n], 0, 0, 0); __builtin_amdgcn_s_setprio(0); } while (0)
#define PG8_WAIT_V(n) asm volatile("s_waitcnt vmcnt(" #n ")" ::: "memory")
#define PG8_WAIT_L(n) asm volatile("s_waitcnt lgkmcnt(" #n ")" ::: "memory")
#define PG8_BAR __builtin_amdgcn_s_barrier()
#define PG8_SCHED __builtin_amdgcn_sched_barrier(0)
    Unit cur, nxt; int ui = 0;
    if (!S.next(0, cur)) return;
    if constexpr (GATHER) {
#pragma unroll
        for (int h = 0; h < 2; ++h)
#pragma unroll
            for (int i = 0; i < 2; ++i) vAc[h][i] = (unsigned)(g.gather[cur.pm * 256 + h * HALF + Rst[i]] * lda + Cst[i]) * 2u;
    }
    f32x4 acc[2][2][4][2];
#pragma unroll
    for (int a = 0; a < 2; ++a)
#pragma unroll
        for (int b = 0; b < 2; ++b)
#pragma unroll
            for (int m = 0; m < 4; ++m)
#pragma unroll
                for (int n = 0; n < 2; ++n) acc[a][b][m][n] = (f32x4){0.f, 0.f, 0.f, 0.f};
    bf16x8 At[4][2], B0[2][2], B1[2][2];
    const char* cA = (const char*)g.A + (size_t)cur.a_off * 2; const char* cB = (const char*)g.Bt + (size_t)cur.b_off * 2;
    PG8_STAGE(PG8_SB(0, 0), cB, voffB); PG8_STAGE(PG8_SB(0, 1), cB + hstepB, voffB); PG8_STAGE_A(PG8_SA(0, 0), cA, 0, false); PG8_STAGE_A(PG8_SA(0, 1), cA, 1, false);
    if (wr == 1) PG8_BAR;
    PG8_WAIT_V(2); PG8_BAR;
    PG8_STAGE(PG8_SB(1, 0), cB + kstep, voffB); PG8_STAGE_A(PG8_SA(1, 0), cA + kstep, 0, false); PG8_STAGE(PG8_SB(1, 1), cB + hstepB + kstep, voffB);
    PG8_WAIT_V(6); PG8_BAR;
    for (;;) {
        const bool has_next = S.next(ui + 1, nxt);
        const char* nA = has_next ? (const char*)g.A + (size_t)nxt.a_off * 2 : cA; const char* nB = has_next ? (const char*)g.Bt + (size_t)nxt.b_off * 2 : cB;
        if constexpr (GATHER) {
#pragma unroll
            for (int h = 0; h < 2; ++h)
#pragma unroll
                for (int i = 0; i < 2; ++i) vAn[h][i] = has_next ? (unsigned)(g.gather[nxt.pm * 256 + h * HALF + Rst[i]] * lda + Cst[i]) * 2u : vAc[h][i];
        }
        const bool hn = HALFN && cur.halfn != 0;
#pragma unroll 1
        for (int t = 0; t < nt; t += 2) {
            const bool last = (t == nt - 2);
            const char* a1 = cA + (size_t)(t + 1) * kstep;
            const char* a2 = last ? nA : cA + (size_t)(t + 2) * kstep; const char* b2 = last ? nB : cB + (size_t)(t + 2) * kstep;
            const char* a3 = a2 + kstep; const char* b3 = b2 + kstep;
            PG8_LDB(B0, 0, 0); if (!hn) PG8_LDB(B1, 0, 1); PG8_SCHED; PG8_LDA(At, 0, 0); PG8_STAGE_A(PG8_SA(1, 1), a1, 1, false);
            PG8_WAIT_V(8); PG8_WAIT_L(0); PG8_BAR; PG8_MMA(0, 0, At, B0); if (!hn) PG8_MMA(0, 1, At, B1); PG8_BAR; PG8_SCHED;
            PG8_LDA(At, 0, 1); PG8_STAGE(PG8_SB(0, 0), b2, voffB); PG8_STAGE(PG8_SB(0, 1), b2 + hstepB, voffB); PG8_STAGE_A(PG8_SA(0, 0), a2, 0, last);
            PG8_WAIT_V(8); PG8_WAIT_L(0); PG8_BAR; PG8_MMA(1, 0, At, B0); if (!hn) PG8_MMA(1, 1, At, B1); PG8_BAR; PG8_SCHED;
            PG8_LDB(B0, 1, 0); if (!hn) PG8_LDB(B1, 1, 1); PG8_SCHED; PG8_LDA(At, 1, 0); PG8_STAGE_A(PG8_SA(0, 1), a2, 1, last);
            PG8_WAIT_V(8); PG8_WAIT_L(0); PG8_BAR; PG8_MMA(0, 0, At, B0); if (!hn) PG8_MMA(0, 1, At, B1); PG8_BAR; PG8_SCHED;
            PG8_LDA(At, 1, 1); PG8_STAGE(PG8_SB(1, 0), b3, voffB); PG8_STAGE(PG8_SB(1, 1), b3 + hstepB, voffB); PG8_STAGE_A(PG8_SA(1, 0), a3, 0, last);
            PG8_WAIT_V(8); PG8_WAIT_L(0); PG8_BAR; PG8_MMA(1, 0, At, B0); if (!hn) PG8_MMA(1, 1, At, B1); PG8_BAR; PG8_SCHED;
            if constexpr (MID) { if (t == 2) E.mid(acc, cur, wr, wc, fr, fq); }
        }
        if constexpr (ALIGN_EPI) { if (wr == 0) PG8_BAR; }
        { int fr_ = fr, fq_ = fq, wr_ = wr, wc_ = wc; asm volatile("; epilogue entry" : "+v"(fr_), "+v"(fq_)); asm volatile("" : "+s"(wr_), "+s"(wc_));
          E(acc, cur, wr_, wc_, fr_, fq_); }
        if (!has_next) break;
#pragma unroll
        for (int a = 0; a < 2; ++a)
#pragma unroll
            for (int b = 0; b < 2; ++b)
#pragma unroll
                for (int m = 0; m < 4; ++m)
#pragma unroll
                    for (int n = 0; n < 2; ++n) acc[a][b][m][n] = (f32x4){0.f, 0.f, 0.f, 0.f};
        cur = nxt; cA = nA; cB = nB; ++ui;
        if constexpr (GATHER) {
#pragma unroll
            for (int h = 0; h < 2; ++h)
#pragma unroll
                for (int i = 0; i < 2; ++i) vAc[h][i] = vAn[h][i];
        }
        if constexpr (ALIGN_EPI) { if (wr == 1) PG8_BAR; }
    }
    PG8_WAIT_V(0);
    if constexpr (!ALIGN_EPI) { if (wr == 0) PG8_BAR; }
    PG8_BAR;
#undef PG8_SA
#undef PG8_SB
#undef PG8_STAGE
#undef PG8_STAGE_A
#undef PG8_LDA
#undef PG8_LDB
#undef PG8_MMA
#undef PG8_WAIT_V
#undef PG8_WAIT_L
#undef PG8_BAR
#undef PG8_SCHED
}
}
using pg8::Unit;

#define XB_TMO      128
#define XB_XCNT(j)  (256  + 64 * (j))
#define XB_XSUB(j)  (1280 + 64 * (j))
#define XB_XGEN(j)  (2304 + 64 * (j))
#define XB_TOP      3328
#define XB_TOPGEN   3392
#define XCD_BAR_WORDS 3456
#define XB_SPIN_CAP (1u << 18)
__device__ __forceinline__ unsigned xb_ld(unsigned* p)              { return __hip_atomic_load(p, __ATOMIC_RELAXED, __HIP_MEMORY_SCOPE_AGENT); }
__device__ __forceinline__ unsigned xb_add(unsigned* p, unsigned v) { return __hip_atomic_fetch_add(p, v, __ATOMIC_RELAXED, __HIP_MEMORY_SCOPE_AGENT); }
__device__ __forceinline__ unsigned xb_xcc_id() { return (unsigned)__builtin_amdgcn_s_getreg((3 << 11) | 20) & 0xFu; }
#define XB_SPIN(cond, bar) do { unsigned _sp = 0; while (cond) { __builtin_amdgcn_s_sleep(1); \
    if ((++_sp & 255u) == 0u) { if (xb_ld(&(bar)[XB_TMO])) break; if (_sp > XB_SPIN_CAP) { atomicAdd(&(bar)[XB_TMO], 1u); break; } } } } while (0)
struct XcdBarrier { unsigned* bar; unsigned x; volatile LAS unsigned* st; };
__device__ __forceinline__ XcdBarrier xcd_barrier_post(unsigned* bar, volatile LAS unsigned* st) {
    XcdBarrier b; b.bar = bar; b.x = xb_xcc_id(); b.st = st;
    if (threadIdx.x == 0) (void)xb_add(&bar[XB_XCNT(b.x)], 1u);
    return b;
}
__device__ __forceinline__ void xcd_barrier_complete(unsigned* bar, unsigned x, unsigned& nloc, unsigned& nx) {
    const unsigned G = gridDim.x * gridDim.y * gridDim.z;
    unsigned sum, cnt, mine, sp = 0u;
    for (;;) {
        sum = 0u; cnt = 0u; mine = 0u;
#pragma unroll
        for (unsigned j = 0; j < 16; ++j) { const unsigned c = xb_ld(&bar[XB_XCNT(j)]); sum += c; cnt += (c > 0u) ? 1u : 0u; mine = (j == x) ? c : mine; }
        if (sum == G) break;
        __builtin_amdgcn_s_sleep(1);
        if ((++sp & 255u) == 0u) { if (xb_ld(&bar[XB_TMO])) break; if (sp > XB_SPIN_CAP) { atomicAdd(&bar[XB_TMO], 1u); break; } }
    }
    nloc = mine > 0u ? mine : 1u; nx = cnt > 0u ? cnt : 1u;
}
__device__ __forceinline__ void xcd_barrier(const XcdBarrier& b) {
    asm volatile("s_waitcnt vmcnt(0)" ::: "memory");
    __syncthreads();
    if (threadIdx.x == 0) {
        unsigned* bar = b.bar;
        __builtin_amdgcn_s_waitcnt(0);
        unsigned nloc = b.st[0], nx = b.st[1];
        if (nloc == 0u) { xcd_barrier_complete(bar, b.x, nloc, nx); b.st[0] = nloc; b.st[1] = nx; }
        const unsigned old = xb_add(&bar[XB_XSUB(b.x)], 1u);
        const unsigned gen = old / nloc;
        if (old + 1u == (gen + 1u) * nloc) {
            __builtin_amdgcn_fence(__ATOMIC_RELEASE, "agent");
            asm volatile("s_waitcnt vmcnt(0)" ::: "memory");
            __builtin_amdgcn_fence(__ATOMIC_ACQUIRE, "agent");
            const unsigned og = xb_add(&bar[XB_TOP], 1u);
            const unsigned tg = og / nx;
            if (og + 1u == (tg + 1u) * nx) xb_add(&bar[XB_TOPGEN], 1u);
            else XB_SPIN(xb_ld(&bar[XB_TOPGEN]) == tg, bar);
            xb_add(&bar[XB_XGEN(b.x)], 1u);
            asm volatile("s_waitcnt vmcnt(0)" ::: "memory");
        } else {
            __builtin_amdgcn_fence(__ATOMIC_ACQUIRE, "agent");
            XB_SPIN(xb_ld(&bar[XB_XGEN(b.x)]) == gen, bar);
            asm volatile("s_waitcnt vmcnt(0)" ::: "memory");
        }
    }
    __syncthreads();
}

__device__ __forceinline__ void xcd_barrier_local(const XcdBarrier& b) {
    asm volatile("s_waitcnt vmcnt(0)" ::: "memory");
    __syncthreads();
    if (threadIdx.x == 0) {
        unsigned* bar = b.bar;
        __builtin_amdgcn_s_waitcnt(0);
        unsigned nloc = b.st[0], nx = b.st[1];
        if (nloc == 0u) { xcd_barrier_complete(bar, b.x, nloc, nx); b.st[0] = nloc; b.st[1] = nx; }
        const unsigned old = xb_add(&bar[XB_XSUB(b.x)], 1u);
        const unsigned gen = old / nloc;
        if (old + 1u == (gen + 1u) * nloc) {
            xb_add(&bar[XB_XGEN(b.x)], 1u);
            __builtin_amdgcn_fence(__ATOMIC_ACQUIRE, "agent");
            asm volatile("s_waitcnt vmcnt(0)" ::: "memory");
        } else {
            __builtin_amdgcn_fence(__ATOMIC_ACQUIRE, "agent");
            XB_SPIN(xb_ld(&bar[XB_XGEN(b.x)]) == gen, bar);
            asm volatile("s_waitcnt vmcnt(0)" ::: "memory");
        }
    }
    __syncthreads();
}

struct Args { const void* in[24]; float* out; unsigned char* ws; int ph_lo, ph_hi; };

struct Frame {
    LAS unsigned char* lds;
    int tid, lane, wave, vcu, G; float diag_scale;
    unsigned char* ws;
    float* X;
};

__device__ __forceinline__ int rl_first(const Frame& F) { return F.G == 256 ? (F.vcu >> 5) * 2048 + (F.vcu & 31) * 8 + F.wave : F.vcu * NWAVES + F.wave; }
__device__ __forceinline__ int rl_step(const Frame& F) { return F.G == 256 ? 256 : F.G * NWAVES; }
__device__ __forceinline__ int rl_end(const Frame& F) { return F.G == 256 ? (F.vcu >> 5) * 2048 + 2048 : T; }
#define EPI_ROW(ai, m) (u.pm * 256 + (ai) * 128 + wr * 64 + (m) * 16 + fr)
#define EPI_FOR_ROWS _Pragma("unroll") for (int ai = 0; ai < 2; ++ai) _Pragma("unroll") for (int m = 0; m < 4; ++m)

#define ROWI(it) (u.pm * 256 + ((it) >> 2) * 128 + wr * 64 + ((it) & 3) * 16 + fr)
#define TABI(it) (u.ord * 256 + ((it) >> 2) * 128 + wr * 64 + ((it) & 3) * 16 + fr)
#define SCHED_FENCE() __builtin_amdgcn_sched_barrier(0)
template <class Sched, class Fn> __device__ __forceinline__ void fill_tab(Frame& F, const Sched& S, const Fn& f) {
    LAS float* tab = (LAS float*)(F.lds + TAB_OFF); Unit u;
    for (int i = F.wave >> 2; i < TAB_UNITS && S.next(i, u); i += 2) { const int r = F.tid & 255; tab[i * 256 + r] = f(u.pm * 256 + r); }
    __syncthreads();
}
template <int XM> __device__ __forceinline__ void rope8(f32x4 (&v)[2], const f32x4 (&cs)[4], bool is_lo, bool is_rot) {
    const float sgn = is_lo ? -1.f : 1.f;
#pragma unroll
    for (int n = 0; n < 2; ++n)
#pragma unroll
        for (int e = 0; e < 4; ++e) { const int j = 4 * n + e; const float c = cs[j >> 1][(j & 1) * 2], sn = cs[j >> 1][(j & 1) * 2 + 1];
            const float mine = v[n][e], oth = __shfl_xor(mine, XM) * sgn; const float r = mine * c + oth * sn; v[n][e] = is_rot ? r : mine; }
}
struct EpiInProj {
    bf16_t *CQ, *CKV, *KPE, *DIL, *SG; float *ssq_q, *ssq_kv; const f32x2* rope_dil; const f32x2* rope_mla; const LAS float* tab;
    __device__ __forceinline__ void operator()(const f32x4 (&acc)[2][2][4][2], const Unit& u, int wr, int wc, int fr, int fq) const {
        const int pn = u.pn;
        float rsv[8];
#pragma unroll
        for (int it = 0; it < 8; ++it) rsv[it] = tab[TABI(it)];
        if (pn < 3) {
            bf16_t* dst = pn < 2 ? CQ : CKV; const int ld = pn < 2 ? 512 : 256; const int cb = (pn == 1 ? 256 : 0) + wc * 32 + 8 * fq; float* sq = pn < 2 ? ssq_q : ssq_kv;
#pragma unroll
            for (int it = 0; it < 8; ++it) { const int row = ROWI(it); const float rs = rsv[it]; float s = 0.f;
#pragma unroll
                for (int bj = 0; bj < 2; ++bj) { const f32x4 v0 = acc[it >> 2][bj][it & 3][0] * rs, v1 = acc[it >> 2][bj][it & 3][1] * rs;
                    s += (v0[0] * v0[0] + v0[1] * v0[1]) + (v0[2] * v0[2] + v0[3] * v0[3]) + (v1[0] * v1[0] + v1[1] * v1[1]) + (v1[2] * v1[2] + v1[3] * v1[3]);
                    *(u32x4*)(dst + (size_t)row * ld + cb + bj * 128) = pack8(v0, v1); }
                s += __shfl_xor(s, 16); s += __shfl_xor(s, 32);
                if (fq == 0) { if (pn < 2) sq[(size_t)row * 8 + pn * 4 + wc] = s; else sq[(size_t)row * 4 + wc] = s; } }
        } else if (pn < 12) {
            const int t = pn - 3, kind = t % 3; const bool rope = (kind < 2) && ((wc & 1) == 0);
            const int cb = t * 256 + wc * 32 + 8 * fq;
            f32x4 cs[2][4];
            if (rope) {
#pragma unroll
                for (int j = 0; j < 4; ++j) cs[0][j] = *(const f32x4*)(rope_dil + (size_t)ROWI(0) * 8 + 2 * j);
            }
            const float qsc = kind == 0 ? 0.18033688f : 1.0f;
#pragma unroll
            for (int it = 0; it < 8; ++it) { const int row = ROWI(it); const float rs = rsv[it] * qsc;
                if (rope && it < 7) {
#pragma unroll
                    for (int j = 0; j < 4; ++j) cs[(it + 1) & 1][j] = *(const f32x4*)(rope_dil + (size_t)ROWI(it + 1) * 8 + 2 * j);
                    SCHED_FENCE();
                }
#pragma unroll
                for (int bj = 0; bj < 2; ++bj) { f32x4 v[2] = {acc[it >> 2][bj][it & 3][0] * rs, acc[it >> 2][bj][it & 3][1] * rs};
                    if (rope) rope8<16>(v, cs[it & 1], fq == 0, fq < 2);
                    *(u32x4*)(DIL + (size_t)row * 2304 + cb + bj * 128) = pack8(v[0], v[1]); } }
        } else if (pn < 20) {
            const int cb = (pn - 12) * 256 + wc * 32 + 8 * fq;
#pragma unroll
            for (int it = 0; it < 8; ++it) { const int row = ROWI(it); const float rs = rsv[it];
#pragma unroll
                for (int bj = 0; bj < 2; ++bj) { f32x4 v0 = acc[it >> 2][bj][it & 3][0] * rs, v1 = acc[it >> 2][bj][it & 3][1] * rs;
#pragma unroll
                    for (int e = 0; e < 4; ++e) { v0[e] = sigmoidf_(v0[e]); v1[e] = sigmoidf_(v1[e]); }
                    *(u32x4*)(SG + (size_t)row * 2048 + cb + bj * 128) = pack8(v0, v1); } }
        } else {
            if (wc == 0) {
                const int jb = 8 * (fq & 1);
                f32x4 cs[2][4];
#pragma unroll
                for (int j = 0; j < 4; ++j) cs[0][j] = *(const f32x4*)(rope_mla + (size_t)ROWI(0) * 16 + jb + 2 * j);
#pragma unroll
                for (int it = 0; it < 8; ++it) { const int row = ROWI(it); const float rs = rsv[it];
                    if (it < 7) {
#pragma unroll
                        for (int j = 0; j < 4; ++j) cs[(it + 1) & 1][j] = *(const f32x4*)(rope_mla + (size_t)ROWI(it + 1) * 16 + jb + 2 * j);
                        SCHED_FENCE();
                    }
                    f32x4 v[2] = {acc[it >> 2][0][it & 3][0] * rs, acc[it >> 2][0][it & 3][1] * rs};
                    rope8<32>(v, cs[it & 1], fq < 2, true);
                    *(u32x4*)(KPE + (size_t)row * 32 + 8 * fq) = pack8(v[0], v[1]); }
            }
        }
    }
};

struct EpiQup {
    bf16_t* Q; const f32x2* rope_mla; const LAS float* tab;
    __device__ __forceinline__ void operator()(const f32x4 (&acc)[2][2][4][2], const Unit& u, int wr, int wc, int fr, int fq) const {
        float rsv[8];
#pragma unroll
        for (int it = 0; it < 8; ++it) rsv[it] = tab[TABI(it)] * 0.14724353f;
        const int jb = 8 * (fq & 1); const bool r0 = ((u.pn * 8 + wc) % 3) == 2, r1 = ((u.pn * 8 + 4 + wc) % 3) == 2, anyr = r0 || r1;
        f32x4 cs[2][4];
        if (anyr) {
#pragma unroll
            for (int j = 0; j < 4; ++j) cs[0][j] = *(const f32x4*)(rope_mla + (size_t)ROWI(0) * 16 + jb + 2 * j);
        }
#pragma unroll
        for (int it = 0; it < 8; ++it) { const int row = ROWI(it); const float rs = rsv[it];
            if (anyr && it < 7) {
#pragma unroll
                for (int j = 0; j < 4; ++j) cs[(it + 1) & 1][j] = *(const f32x4*)(rope_mla + (size_t)ROWI(it + 1) * 16 + jb + 2 * j);
                SCHED_FENCE();
            }
#pragma unroll
            for (int bj = 0; bj < 2; ++bj) { f32x4 v[2] = {acc[it >> 2][bj][it & 3][0] * rs, acc[it >> 2][bj][it & 3][1] * rs};
                if (bj == 0 ? r0 : r1) rope8<32>(v, cs[it & 1], fq < 2, true);
                *(u32x4*)(Q + (size_t)row * 1536 + u.pn * 256 + bj * 128 + wc * 32 + 8 * fq) = pack8(v[0], v[1]); } }
    }
};

struct EpiScaleStore {
    const LAS float* tab; bf16_t* O; int ld; bf16_t* O2; int split;
    __device__ __forceinline__ void operator()(const f32x4 (&acc)[2][2][4][2], const Unit& u, int wr, int wc, int fr, int fq) const {
        bf16_t* dst = (O2 && u.pn >= split) ? O2 + (u.pn - split) * 256 : O + u.pn * 256;
#pragma unroll
        for (int it = 0; it < 8; ++it) { const int row = ROWI(it); const float rs = tab ? tab[TABI(it)] : 1.0f;
#pragma unroll
            for (int bj = 0; bj < 2; ++bj) *(u32x4*)(dst + (size_t)row * ld + bj * 128 + wc * 32 + 8 * fq) = pack8(acc[it >> 2][bj][it & 3][0] * rs, acc[it >> 2][bj][it & 3][1] * rs); }
    }
};

template <int MODE> struct EpiGate {
    const bf16_t* G; int goff; const bf16_t* ADD; bf16_t* O;
    __device__ __forceinline__ void operator()(const f32x4 (&acc)[2][2][4][2], const Unit& u, int wr, int wc, int fr, int fq) const {
        const int colb = u.pn * 256 + wc * 32 + 8 * fq;
        u32x4 gb[2], ab[2];
        gb[0] = *(const u32x4*)(G + (size_t)ROWI(0) * 2048 + goff + colb); if (MODE == 1) ab[0] = *(const u32x4*)(ADD + (size_t)ROWI(0) * 1024 + colb);
#pragma unroll
        for (int s2 = 0; s2 < 16; ++s2) { const int it = s2 >> 1, bj = s2 & 1, row = ROWI(it), col = colb + bj * 128;
            if (s2 < 15) { const int nrow = ROWI((s2 + 1) >> 1), ncol = colb + ((s2 + 1) & 1) * 128;
                gb[(s2 + 1) & 1] = *(const u32x4*)(G + (size_t)nrow * 2048 + goff + ncol); if (MODE == 1) ab[(s2 + 1) & 1] = *(const u32x4*)(ADD + (size_t)nrow * 1024 + ncol);
                SCHED_FENCE(); }
            f32x4 g0, g1; unpack8(gb[s2 & 1], g0, g1);
            f32x4 v0 = acc[it >> 2][bj][it & 3][0] * g0, v1 = acc[it >> 2][bj][it & 3][1] * g1;
            if (MODE == 1) { f32x4 a0, a1; unpack8(ab[s2 & 1], a0, a1); v0 += a0; v1 += a1; }
            *(u32x4*)(O + (size_t)row * 1024 + col) = pack8(v0, v1); }
    }
};

struct EpiGateFused {
    const bf16_t* G; bf16_t* O;
    __device__ __forceinline__ void mid(f32x4 (&acc)[2][2][4][2], const Unit& u, int wr, int wc, int fr, int fq) const {
        const int colb = u.pn * 256 + wc * 32 + 8 * fq;
        u32x4 ga[2], gb[2];
        ga[0] = *(const u32x4*)(G + (size_t)ROWI(0) * 2048 + colb); gb[0] = *(const u32x4*)(G + (size_t)ROWI(0) * 2048 + 1024 + colb);
#pragma unroll
        for (int s2 = 0; s2 < 16; ++s2) { const int it = s2 >> 1, bj = s2 & 1;
            if (s2 < 15) { const int nrow = ROWI((s2 + 1) >> 1), ncol = colb + ((s2 + 1) & 1) * 128;
                ga[(s2 + 1) & 1] = *(const u32x4*)(G + (size_t)nrow * 2048 + ncol); gb[(s2 + 1) & 1] = *(const u32x4*)(G + (size_t)nrow * 2048 + 1024 + ncol);
                SCHED_FENCE(); }
            f32x4 a0, a1, b0, b1; unpack8(ga[s2 & 1], a0, a1); unpack8(gb[s2 & 1], b0, b1);
#pragma unroll
            for (int e = 0; e < 4; ++e) { b0[e] *= __builtin_amdgcn_rcpf(fmaxf(a0[e], 1e-30f)); b1[e] *= __builtin_amdgcn_rcpf(fmaxf(a1[e], 1e-30f)); }
            acc[it >> 2][bj][it & 3][0] *= b0; acc[it >> 2][bj][it & 3][1] *= b1; }
    }
    __device__ __forceinline__ void operator()(const f32x4 (&acc)[2][2][4][2], const Unit& u, int wr, int wc, int fr, int fq) const {
        const int colb = u.pn * 256 + wc * 32 + 8 * fq;
        u32x4 ga[2];
        ga[0] = *(const u32x4*)(G + (size_t)ROWI(0) * 2048 + colb);
#pragma unroll
        for (int s2 = 0; s2 < 16; ++s2) { const int it = s2 >> 1, bj = s2 & 1, row = ROWI(it), col = colb + bj * 128;
            if (s2 < 15) { const int nrow = ROWI((s2 + 1) >> 1), ncol = colb + ((s2 + 1) & 1) * 128; ga[(s2 + 1) & 1] = *(const u32x4*)(G + (size_t)nrow * 2048 + ncol); SCHED_FENCE(); }
            f32x4 a0, a1; unpack8(ga[s2 & 1], a0, a1);
            *(u32x4*)(O + (size_t)row * 1024 + col) = pack8(acc[it >> 2][bj][it & 3][0] * a0, acc[it >> 2][bj][it & 3][1] * a1); }
    }
};

template <int MODE> struct EpiResid {
    bf16_t* XB; float* ssq; const bf16_t* Eb; const bf16_t* XS; const LAS float* tab;
    __device__ __forceinline__ void operator()(const f32x4 (&acc)[2][2][4][2], const Unit& u, int wr, int wc, int fr, int fq) const {
        const int colb = u.pn * 256 + wc * 32 + 8 * fq;
        u32x4 xw[2], eb[2];
        xw[0] = *(const u32x4*)(XS + (size_t)ROWI(0) * 1024 + colb); if (MODE == 1) eb[0] = *(const u32x4*)(Eb + (size_t)ROWI(0) * 1024 + colb);
        float s = 0.f;
#pragma unroll
        for (int s2 = 0; s2 < 16; ++s2) { const int it = s2 >> 1, bj = s2 & 1, row = ROWI(it), col = colb + bj * 128;
            if (s2 < 15) { const int nrow = ROWI((s2 + 1) >> 1), ncol = colb + ((s2 + 1) & 1) * 128;
                xw[(s2 + 1) & 1] = *(const u32x4*)(XS + (size_t)nrow * 1024 + ncol); if (MODE == 1) eb[(s2 + 1) & 1] = *(const u32x4*)(Eb + (size_t)nrow * 1024 + ncol);
                SCHED_FENCE(); }
            f32x4 x0, x1; unpack8(xw[s2 & 1], x0, x1);
            f32x4 d0 = acc[it >> 2][bj][it & 3][0], d1 = acc[it >> 2][bj][it & 3][1];
            if (MODE == 1) { f32x4 e0, e1; unpack8(eb[s2 & 1], e0, e1); const float rs = tab[TABI(it)];
#pragma unroll
                for (int e = 0; e < 4; ++e) { d0[e] = sigmoidf_(d0[e] * rs) * e0[e]; d1[e] = sigmoidf_(d1[e] * rs) * e1[e]; } }
            x0 += d0; x1 += d1;
            *(u32x4*)(XB + (size_t)row * 1024 + col) = pack8(x0, x1);
            s += (x0[0] * x0[0] + x0[1] * x0[1]) + (x0[2] * x0[2] + x0[3] * x0[3]) + (x1[0] * x1[0] + x1[1] * x1[1]) + (x1[2] * x1[2] + x1[3] * x1[3]);
            if (bj == 1) { s += __shfl_xor(s, 16); s += __shfl_xor(s, 32); if (fq == 0) ssq[(size_t)row * 16 + u.pn * 4 + wc] = s; s = 0.f; } }
    }
};

struct EpiRouter {
    float* RL;
    __device__ __forceinline__ void operator()(const f32x4 (&acc)[2][2][4][2], const Unit& u, int wr, int wc, int fr, int fq) const {
        const int c0 = wc * 32 + 8 * fq;
        if (c0 < 72) {
#pragma unroll
            for (int it = 0; it < 8; ++it) { const int row = ROWI(it); float* p = RL + (size_t)row * 72 + c0;
                *(f32x4*)p = acc[it >> 2][0][it & 3][0]; *(f32x4*)(p + 4) = acc[it >> 2][0][it & 3][1]; }
        }
    }
};

struct EpiExp1 {
    const LAS float* tab; bf16_t* H;
    __device__ __forceinline__ void operator()(const f32x4 (&acc)[2][2][4][2], const Unit& u, int wr, int wc, int fr, int fq) const {
#pragma unroll
        for (int it = 0; it < 8; ++it) { const int row = ROWI(it); const float rs = tab[TABI(it)];
            f32x4 h[2];
#pragma unroll
            for (int n = 0; n < 2; ++n)
#pragma unroll
                for (int e = 0; e < 4; ++e) { const float gt = acc[it >> 2][0][it & 3][n][e] * rs, up = acc[it >> 2][1][it & 3][n][e] * rs; h[n][e] = gt * sigmoidf_(gt) * up; }
            *(u32x4*)(H + (size_t)row * 256 + u.pn * 128 + wc * 32 + 8 * fq) = pack8(h[0], h[1]); }
    }
};
struct EpiExp2 {
    const LAS float* tab; bf16_t* YS;
    __device__ __forceinline__ void operator()(const f32x4 (&acc)[2][2][4][2], const Unit& u, int wr, int wc, int fr, int fq) const {
#pragma unroll
        for (int it = 0; it < 8; ++it) { const int row = ROWI(it); const float w = tab[TABI(it)];
#pragma unroll
            for (int bj = 0; bj < 2; ++bj) *(u32x4*)(YS + (size_t)row * 1024 + u.pn * 256 + bj * 128 + wc * 32 + 8 * fq) = pack8(acc[it >> 2][bj][it & 3][0] * w, acc[it >> 2][bj][it & 3][1] * w); }
    }
};

struct RouterOrder {
    int G, c;
    __device__ __forceinline__ bool next(int i, Unit& u) const { const int L = i * G + c; if (L >= 256) return false;
        u.ord = i; u.pm = L >> 2; u.pn = L & 3; u.a_off = (unsigned)u.pm * 256u * 1024u + (unsigned)u.pn * 256u; u.b_off = (unsigned)u.pn * 256u; return true; }
};
struct RouterFullOrder {
    int G, c;
    __device__ __forceinline__ bool next(int i, Unit& u) const { int L; if (G == 256) { if (i > 0 || c >= 64) return false; L = c; } else { L = i * G + c; if (L >= 64) return false; }
        u.ord = i; u.halfn = 1; u.pm = L; u.pn = 0; u.a_off = (unsigned)L * 256u * 1024u; u.b_off = 0u; return true; }
};
struct PleProjOrder {
    int G, c;
    __device__ __forceinline__ bool next(int i, Unit& u) const { int L; if (G == 256) { if (c < 64) return false; L = i * 192 + (c - 64); } else L = i * G + c; if (L >= 256) return false;
        u.ord = i; u.halfn = 0; u.pm = L >> 2; u.pn = L & 3; u.a_off = (unsigned)u.pm * 256u * 256u; u.b_off = (unsigned)u.pn * 256u * 256u; return true; }
};
template <int NJ> struct BlockUnits {
    const int* blk_e; int blk;
    __device__ __forceinline__ bool next(int i, Unit& u) const { if (i >= NJ) return false; const int e = blk_e[blk]; u.pm = blk; u.pn = i; u.ord = i; u.halfn = 0;
        if (NJ == 2) { u.a_off = 0u; u.b_off = (unsigned)(e * 512 + i * 256) * 1024u; } else { u.a_off = (unsigned)blk * 256u * 256u; u.b_off = (unsigned)(e * 1024 + i * 256) * 256u; }
        return true; }
};
struct PleProjRange {
    int rank, cnt;
    __device__ __forceinline__ bool next(int i, Unit& u) const { if (rank < 0) return false; const int L = i * cnt + rank; if (L >= 256) return false;
        u.ord = i; u.halfn = 0; u.pm = L >> 2; u.pn = L & 3; u.a_off = (unsigned)u.pm * 256u * 256u; u.b_off = (unsigned)u.pn * 256u * 256u; return true; }
};
template <int NJ> struct ExpertOrder {
    const int* blk_e; int G, c;
    __device__ __forceinline__ bool next(int i, Unit& u) const { const int nblk = blk_e[255]; const int L = i * G + c; if (L >= nblk * NJ) return false;
        const int blk = L / NJ, j = L % NJ, e = blk_e[blk]; u.pm = blk; u.pn = j; u.ord = i; u.halfn = 0;
        if (NJ == 2) { u.a_off = 0u; u.b_off = (unsigned)(e * 512 + j * 256) * 1024u; } else { u.a_off = (unsigned)blk * 256u * 256u; u.b_off = (unsigned)(e * 1024 + j * 256) * 256u; }
        return true; }
};

__device__ __forceinline__ void tr_load(float (&v)[32], const float* W, int ldw, int n_src0, int k0, int lane) {
    asm volatile("" : "+v"(lane));
    const GAS float* wp = (const GAS float*)(W + (size_t)(k0 + (lane >> 5)) * ldw + n_src0 + (lane & 31));
#pragma unroll
    for (int i = 0; i < 32; ++i) { v[i] = __builtin_nontemporal_load(wp); wp += 2 * ldw; asm volatile("" : "+v"(wp)); }
}
__device__ __forceinline__ void tr_store(const float (&v)[32], const float* g, bf16_t* WT, int K, int n_dst0, int k0, LAS float* scr, int lane) {
    asm volatile("" : "+v"(lane));
    const int c = lane & 7;
    f32x4 g0 = {1.f, 1.f, 1.f, 1.f}, g1 = g0;
    if (g) { g0 = *(const f32x4*)(g + k0 + 8 * c); g1 = *(const f32x4*)(g + k0 + 8 * c + 4); }
#pragma unroll
    for (int i = 0; i < 32; ++i) scr[(2 * i + (lane >> 5)) * 33 + (lane & 31)] = v[i];
    LDS_WAIT(); asm volatile("" ::: "memory");
#pragma unroll
    for (int j = 0; j < 4; ++j) { const int n = (lane >> 3) + 8 * j; const LAS float* s = scr + (8 * c) * 33 + n;
        u32x4 o; o.x = cvt_pk_bf16(s[0 * 33] * g0[0], s[1 * 33] * g0[1]); o.y = cvt_pk_bf16(s[2 * 33] * g0[2], s[3 * 33] * g0[3]); o.z = cvt_pk_bf16(s[4 * 33] * g1[0], s[5 * 33] * g1[1]); o.w = cvt_pk_bf16(s[6 * 33] * g1[2], s[7 * 33] * g1[3]);
        *(u32x4*)(WT + (size_t)(n_dst0 + n) * K + k0 + 8 * c) = o; }
    LDS_WAIT(); asm volatile("" ::: "memory");
}
__device__ __forceinline__ void tr_item(const float* W, int ldw, int n_src0, const float* g, bf16_t* WT, int K, int n_dst0, int k0, LAS float* scr, int lane) {
    float v[32]; tr_load(v, W, ldw, n_src0, k0, lane); tr_store(v, g, WT, K, n_dst0, k0, scr, lane);
}
__device__ __forceinline__ void tr_pair(const float* W, int ldw, int n_src0, const float* g, bf16_t* WT, int K, int n_dst0, int k0, LAS float* scr, int lane) {
    float va[32], vb[32]; tr_load(va, W, ldw, n_src0, k0, lane); tr_load(vb, W, ldw, n_src0, k0 + 64, lane);
    tr_store(va, g, WT, K, n_dst0, k0, scr, lane); tr_store(vb, g, WT, K, n_dst0, k0 + 64, scr, lane);
}

__device__ __forceinline__ void convert_dense(Frame& F, const AS4 Args* a, int l, int rank, int count) {
    LAS float* scr = (LAS float*)(F.lds + F.wave * 16384);
    const float* g_mix = (const float*)a->in[3]; const float* w_in = (const float*)a->in[4]; const float* g_q = (const float*)a->in[5]; const float* w_q = (const float*)a->in[6];
    const float* g_kv = (const float*)a->in[7]; const float* w_kv = (const float*)a->in[8]; const float* w_a = (const float*)a->in[9]; const float* w_b = (const float*)a->in[10];
    const float* w_o = (const float*)a->in[11]; const float* w_pg = (const float*)a->in[21]; const float* w_pp = (const float*)a->in[22];
    unsigned char* wd = F.ws + WS_WD + (size_t)l * WD_STRIDE;
    constexpr int I_IN = 8 * 161, I_Q = 4 * 48, I_KV = 2 * 64, I_A = 8 * 32, I_B = 2 * 32;
    constexpr int I_LAYER = I_IN + I_Q + I_KV + I_A + I_B + I_A + I_A + I_B;
    for (int it = rank * NWAVES + F.wave; it < I_LAYER; it += count * NWAVES) {
        int r = it;
        if (r < I_IN) { const int kb = r / 161, nb = r % 161, ns = nb * 32; const int nd = ns < 768 ? ns : (ns < 800 ? 5120 : ns - 32);
            tr_pair(w_in + (size_t)l * 1024 * NIN_SRC, NIN_SRC, ns, g_mix + l * 1024, (bf16_t*)(wd + WD_IN), 1024, nd, kb * 128, scr, F.lane); continue; } r -= I_IN;
        if (r < I_Q) { const int kb = r / 48, nb = r % 48;
            tr_pair(w_q + (size_t)l * 512 * 1536, 1536, nb * 32, g_q + l * 512, (bf16_t*)(wd + WD_Q), 512, nb * 32, kb * 128, scr, F.lane); continue; } r -= I_Q;
        if (r < I_KV) { const int kb = r / 64, nb = r % 64, h = nb >> 2, part = nb & 3;
            tr_pair(w_kv + (size_t)l * 256 * 2048, 2048, nb * 32, g_kv + l * 256, (bf16_t*)(wd + (part < 2 ? WD_K : WD_V)), 256, h * 64 + (part & 1) * 32, kb * 128, scr, F.lane); continue; } r -= I_KV;
        if (r < I_A) { const int kb = r / 32, nb = r % 32; tr_pair(w_a + (size_t)l * 1024 * 1024, 1024, nb * 32, nullptr, (bf16_t*)(wd + WD_A) + 256, 1280, nb * 32, kb * 128, scr, F.lane); continue; } r -= I_A;
        if (r < I_B) { const int kb = r / 32, nb = r % 32; tr_pair(w_b + (size_t)l * 256 * 1024, 1024, nb * 32, nullptr, (bf16_t*)(wd + WD_A), 1280, nb * 32, kb * 128, scr, F.lane); continue; } r -= I_B;
        if (r < I_A) { const int kb = r / 32, nb = r % 32; tr_pair(w_o + (size_t)l * 1024 * 1024, 1024, nb * 32, nullptr, (bf16_t*)(wd + WD_O), 1024, nb * 32, kb * 128, scr, F.lane); continue; } r -= I_A;
        if (r < I_A) { const int kb = r / 32, nb = r % 32; tr_pair(w_pg + (size_t)l * 1024 * 1024, 1024, nb * 32, (const float*)a->in[20] + l * 1024, (bf16_t*)(wd + WD_G), 1024, nb * 32, kb * 128, scr, F.lane); continue; } r -= I_A;
        { const int kb = r / 32, nb = r % 32; tr_pair(w_pp + (size_t)l * 256 * 1024, 1024, nb * 32, nullptr, (bf16_t*)(wd + WD_P), 256, nb * 32, kb * 128, scr, F.lane); }
    }
}
__device__ __forceinline__ void convert_p(Frame& F, const AS4 Args* a, int l, int rank, int count) {
    const f32x4* p = (const f32x4*)((const float*)a->in[1] + (size_t)l * T * 256); u32x4* dst = (u32x4*)(F.ws + WS_PB) + (size_t)l * T * 256 / 8;
    for (int i = rank * NTHR + F.tid; i < T * 256 / 8; i += count * NTHR) { const f32x4 a0 = p[2 * i], a1 = p[2 * i + 1]; dst[i] = pack8(a0, a1); }
}

__device__ __forceinline__ void prologue(Frame& F, const AS4 Args* a) {
    LAS float* scr = (LAS float*)(F.lds + F.wave * 16384);
    const int gw = F.vcu * NWAVES + F.wave, NGW = F.G * NWAVES;
    const float* x = (const float*)a->in[0]; const float* p = (const float*)a->in[1]; const int* pos = (const int*)a->in[2];
    const float* g_mix = (const float*)a->in[3]; const float* w_in = (const float*)a->in[4]; const float* g_q = (const float*)a->in[5]; const float* w_q = (const float*)a->in[6];
    const float* g_kv = (const float*)a->in[7]; const float* w_kv = (const float*)a->in[8]; const float* w_a = (const float*)a->in[9]; const float* w_b = (const float*)a->in[10];
    const float* w_o = (const float*)a->in[11]; const float* g_ffn = (const float*)a->in[12]; const float* w_rg = (const float*)a->in[13]; const float* w_re = (const float*)a->in[15];
    const float* w_eg = (const float*)a->in[17]; const float* w_eu = (const float*)a->in[18]; const float* w_ed = (const float*)a->in[19];
    const float* w_pg = (const float*)a->in[21]; const float* w_pp = (const float*)a->in[22];
    unsigned char* ws = F.ws;
    convert_dense(F, a, 0, F.vcu, F.G);
    const int gt = F.vcu * NTHR + F.tid, NGT = F.G * NTHR;
    for (int i = gt; i < DEPTH * 256 * 1024; i += NGT) { const int l = i >> 18, n = (i >> 10) & 255, k = i & 1023;
        float v = 0.f; if (n < 8) v = w_rg[((size_t)l * 1024 + k) * 8 + n] * g_ffn[l * 1024 + k]; else if (n < 72) v = w_re[((size_t)l * 1024 + k) * 64 + (n - 8)] * g_ffn[l * 1024 + k];
        ((bf16_t*)(ws + WS_WD + (size_t)l * WD_STRIDE + WD_R))[n * 1024 + k] = (bf16_t)(cvt_pk_bf16(v, 0.f) & 0xffffu); }
    for (int i = gt; i < T * 16; i += NGT) { const int row = i >> 4, j = i & 15; const float inv = exp2f(-(float)j * (1.0f / 16.0f) * 13.287712379549449f);
        const float ang = (float)pos[row] * inv; ((f32x2*)(ws + WS_ROPE_MLA))[i] = (f32x2){cosf(ang), sinf(ang)}; }
    for (int i = gt; i < T * 8; i += NGT) { const int row = i >> 3, j = i & 7; const float inv = exp2f(-(float)j * (1.0f / 8.0f) * 18.931568569324174f);
        const float ang = (float)pos[row] * inv; ((f32x2*)(ws + WS_ROPE_DIL))[i] = (f32x2){cosf(ang), sinf(ang)}; }
    convert_p(F, a, 0, F.vcu, F.G);
    float* ssq1 = (float*)(ws + WS_SSQ1); bf16_t* XB = (bf16_t*)(ws + WS_XB);
    for (int m = rl_first(F), m_end = rl_end(F), m_step = rl_step(F); m < m_end; m += m_step) { const f32x4* xr = (const f32x4*)(x + (size_t)m * 1024) + F.lane; f32x4 v[4]; float s = 0.f;
#pragma unroll
        for (int j = 0; j < 4; ++j) { v[j] = xr[64 * j]; s += (v[j][0] * v[j][0] + v[j][1] * v[j][1]) + (v[j][2] * v[j][2] + v[j][3] * v[j][3]); }
        s = wave_sum(s); if (F.lane < 16) ssq1[(size_t)m * 16 + F.lane] = F.lane == 0 ? s : 0.f;
#pragma unroll
        for (int j = 0; j < 4; ++j) {
            ((u32x2*)(XB + (size_t)m * 1024))[F.lane + 64 * j] = (u32x2){cvt_pk_bf16(v[j][0], v[j][1]), cvt_pk_bf16(v[j][2], v[j][3])}; } }
}

__device__ __forceinline__ void convert_w13(Frame& F, const AS4 Args* a, int l, int rank, int count, int it0, int it1) {
    LAS float* scr = (LAS float*)(F.lds + F.wave * 16384);
    const float* g_ffn = (const float*)a->in[12] + l * 1024; const float* w_eg = (const float*)a->in[17]; const float* w_eu = (const float*)a->in[18];
    bf16_t* dst = (bf16_t*)(F.ws + WS_W13 + (size_t)(l & 1) * W13_STRIDE);
    auto ld = [&](float (&v)[32], int r) { const int e = r >> 8, q = r & 255, up = q >> 7, kb = (q & 127) >> 3, nb = q & 7;
        tr_load(v, (up ? w_eu : w_eg) + ((size_t)l * 64 + e) * 1024 * 256, 256, nb * 32, kb * 64, F.lane); };
    auto st = [&](const float (&v)[32], int r) { const int e = r >> 8, q = r & 255, up = q >> 7, kb = (q & 127) >> 3, nb = q & 7; const int f0 = nb * 32, nd = (f0 >> 7) * 256 + up * 128 + (f0 & 127);
        tr_store(v, g_ffn, dst + (size_t)e * 512 * 1024, 1024, nd, kb * 64, scr, F.lane); };
    float va[32], vb[32];
    for (int pr = (it0 >> 1) + rank * NWAVES + F.wave; pr < (it1 >> 1); pr += count * NWAVES) { const int r0 = (pr >> 6) * 128 + (((pr >> 3) & 7) * 2) * 8 + (pr & 7);
        ld(va, r0); ld(vb, r0 + 8);
        st(va, r0); st(vb, r0 + 8); }
}
__device__ __forceinline__ void convert_w13_single(Frame& F, const AS4 Args* a, int l, int rank, int count, int it0, int it1) {
    LAS float* scr = (LAS float*)(F.lds + F.wave * 16384);
    const float* g_ffn = (const float*)a->in[12] + l * 1024; const float* w_eg = (const float*)a->in[17]; const float* w_eu = (const float*)a->in[18];
    bf16_t* dst = (bf16_t*)(F.ws + WS_W13 + (size_t)(l & 1) * W13_STRIDE);
    for (int r = it0 + rank * NWAVES + F.wave; r < it1; r += count * NWAVES) { const int e = r >> 8, q = r & 255, up = q >> 7, kb = (q & 127) >> 3, nb = q & 7; const int f0 = nb * 32, nd = (f0 >> 7) * 256 + up * 128 + (f0 & 127);
        tr_item((up ? w_eu : w_eg) + ((size_t)l * 64 + e) * 1024 * 256, 256, f0, g_ffn, dst + (size_t)e * 512 * 1024, 1024, nd, kb * 64, scr, F.lane); }
}
__device__ __forceinline__ void convert_w2(Frame& F, const AS4 Args* a, int l, int rank, int count, int it0 = 0, int it1 = 64 * 128) {
    LAS float* scr = (LAS float*)(F.lds + F.wave * 16384);
    const float* w_ed = (const float*)a->in[19]; bf16_t* dst = (bf16_t*)(F.ws + WS_W2);
    auto ld = [&](float (&v)[32], int r) { const int e = r >> 7, q = r & 127, kb = q >> 5, nb = q & 31;
        tr_load(v, w_ed + ((size_t)l * 64 + e) * 256 * 1024, 1024, nb * 32, kb * 64, F.lane); };
    auto st = [&](const float (&v)[32], int r) { const int e = r >> 7, q = r & 127, kb = q >> 5, nb = q & 31;
        tr_store(v, nullptr, dst + (size_t)e * 1024 * 256, 256, nb * 32, kb * 64, scr, F.lane); };
    float va[32], vb[32];
    for (int pr = (it0 >> 1) + rank * NWAVES + F.wave; pr < (it1 >> 1); pr += count * NWAVES) { const int r0 = (pr >> 5) * 64 + (pr & 31);
        ld(va, r0); ld(vb, r0 + 32);
        st(va, r0); st(vb, r0 + 32); }
}

typedef float f32x16 __attribute__((ext_vector_type(16)));
typedef short v4i16_t __attribute__((ext_vector_type(4)));
constexpr int W2_SPLIT = 5376;
constexpr int W13_EARLY = 12800;
constexpr int W13_SPLIT2 = 16384;
constexpr int W13_SPLIT = 15872;
constexpr int AT_KP0 = 208, AT_KP1 = 144, AT_VP = 192;
constexpr int AT_KBYTES = 64 * 208, AT_VBYTES = 64 * 192, AT_STAGE = AT_KBYTES + AT_VBYTES, AT_NST = 5;
static_assert(AT_NST * AT_STAGE <= RING_BYTES && TAB_OFF + 8 * 1024 <= LDS_BYTES, "attention LDS");
struct AttnDesc {
    const bf16_t* q; const bf16_t* k; const bf16_t* k2; const bf16_t* v; bf16_t* o; float* lse;
    int qs, ks, k2s, vs, os, lses;
    int m0, nq;
    int kt0, kt1;
};
__device__ __forceinline__ void attn_unit_pipe(Frame& F, const AttnDesc& D) {
    constexpr int NKS = 6, KP = AT_KP0;
    int lane_ = F.lane; asm volatile("" : "+v"(lane_));
    const int lane = lane_, w = F.wave, r = lane & 31, hh = lane >> 5;
    LAS unsigned char* lds = F.lds;
    const bool active = w * 32 < D.nq;
    const int mq = D.m0 + 32 * w + r;
    const int kt_hi = (D.m0 + 32 * w + 31) >> 6;
    bf16x8 qf[NKS];
    if (active) {
#pragma unroll
        for (int ks = 0; ks < NKS; ++ks) qf[ks] = *(const bf16x8*)(D.q + (size_t)mq * D.qs + 16 * ks + 8 * hh);
    } else {
#pragma unroll
        for (int ks = 0; ks < NKS; ++ks) qf[ks] = (bf16x8){0, 0, 0, 0, 0, 0, 0, 0};
    }
    f32x16 o0, o1;
#pragma unroll
    for (int i = 0; i < 16; ++i) { o0[i] = 0.f; o1[i] = 0.f; }
    float mrun = -1024.0f, lrun = 0.f;
    const char* srcp[4]; unsigned incb[4];
#pragma unroll
    for (int j = 0; j < 4; ++j) { const int slot = j * 8 + w; int c = slot * 64 + lane; if (c > 1599) c = 1599;
        if (c < 832) { const int row = c / 13; int part = c % 13; if (part == 12) part = 0;
            if (part < 8) { srcp[j] = (const char*)(D.k + (size_t)row * D.ks + part * 8); incb[j] = 128u * (unsigned)D.ks; } else { srcp[j] = (const char*)(D.k2 + (size_t)row * D.k2s + (part - 8) * 8); incb[j] = 128u * (unsigned)D.k2s; } }
        else { const int c2 = c - 832, row = c2 / 12; int part = c2 % 12; if (part >= 8) part = 0; srcp[j] = (const char*)(D.v + (size_t)row * D.vs + part * 8); incb[j] = 128u * (unsigned)D.vs; } }
    auto dma_issue = [&](int kt, int stage) {
#pragma unroll
        for (int j = 0; j < 4; ++j) { const int slot = j * 8 + w; const int dst = slot < 25 ? stage * AT_STAGE + slot * 1024 : TAB_OFF + w * 1024;
            __builtin_amdgcn_global_load_lds((const unsigned*)(srcp[j] + (size_t)kt * incb[j]), (LAS unsigned*)(lds + dst), 16, 0, 0); }
    };
#define AT_SYNC(n) do { asm volatile("s_waitcnt vmcnt(" #n ") lgkmcnt(0)" ::: "memory"); __builtin_amdgcn_s_barrier(); asm volatile("" ::: "memory"); } while (0)
    const int vlane = (hh * 4 + ((lane & 15) >> 2)) * AT_VP + (16 * ((lane >> 4) & 1) + 4 * (lane & 3)) * 2;
    bf16x8 pf[2][2], vfr[2][2][2];
    f32x16 sa0, sa1, sb0, sb1;
    auto vload = [&](int buf, int sb) {
        int vo = buf * AT_STAGE + AT_KBYTES + vlane; asm volatile("" : "+v"(vo));
        const LAS unsigned char* Vl = lds + vo;
        {
#pragma unroll
            for (int s2 = 0; s2 < 2; ++s2)
#pragma unroll
                for (int blk = 0; blk < 2; ++blk) { const LAS unsigned char* vb = Vl + (32 * sb + 16 * s2) * AT_VP + blk * 64;
                    const v4i16_t t0 = __builtin_amdgcn_ds_read_tr16_b64_v4i16((LAS v4i16_t*)(vb));
                    const v4i16_t t1 = __builtin_amdgcn_ds_read_tr16_b64_v4i16((LAS v4i16_t*)(vb + 8 * AT_VP));
                    vfr[sb][s2][blk] = (bf16x8){t0[0], t0[1], t0[2], t0[3], t1[0], t1[1], t1[2], t1[3]}; }
        }
    };
    auto pvm = [&](int buf) {
        vload(buf, 1);
#pragma unroll
        for (int sb = 0; sb < 2; ++sb)
#pragma unroll
            for (int s2 = 0; s2 < 2; ++s2) {
                o0 = __builtin_amdgcn_mfma_f32_32x32x16_bf16(vfr[sb][s2][0], pf[sb][s2], o0, 0, 0, 0);
                o1 = __builtin_amdgcn_mfma_f32_32x32x16_bf16(vfr[sb][s2][1], pf[sb][s2], o1, 0, 0, 0); }
    };
    auto qk = [&](int buf, f32x16& x0, f32x16& x1) {
        int ko = buf * AT_STAGE + r * KP + 16 * hh; asm volatile("" : "+v"(ko));
        const LAS unsigned char* Kl = lds + ko;
        const float ninit = -mrun;
        x0 = (f32x16){ninit, ninit, ninit, ninit, ninit, ninit, ninit, ninit, ninit, ninit, ninit, ninit, ninit, ninit, ninit, ninit}; x1 = x0;
#pragma unroll
        for (int ks = 0; ks < NKS; ++ks) {
            const bf16x8 k0 = *(const LAS bf16x8*)(Kl + 32 * ks), k1 = *(const LAS bf16x8*)(Kl + 32 * KP + 32 * ks);
            x0 = __builtin_amdgcn_mfma_f32_32x32x16_bf16(k0, qf[ks], x0, 0, 0, 0);
            x1 = __builtin_amdgcn_mfma_f32_32x32x16_bf16(k1, qf[ks], x1, 0, 0, 0);
        }
    };
    auto sm_pre = [&](int kt, f32x16& x0, f32x16& x1) {
        if (kt == kt_hi) {
#pragma unroll
            for (int i = 0; i < 16; ++i) { const int key0 = 64 * kt + (i & 3) + 8 * (i >> 2) + 4 * hh, key1 = key0 + 32;
                x0[i] = key0 <= mq ? x0[i] : -3.0e38f; x1[i] = key1 <= mq ? x1[i] : -3.0e38f; }
        }
        float mx = fmaxf(x0[0], x1[0]);
#pragma unroll
        for (int i = 1; i < 16; ++i) mx = fmaxf(mx, fmaxf(x0[i], x1[i]));
        { const auto t = __builtin_amdgcn_permlane32_swap(__float_as_uint(mx), __float_as_uint(mx), false, false); mx = fmaxf(__uint_as_float(t[0]), __uint_as_float(t[1])); }
        if (__any(mx > 8.0f)) {
            const float delta = mx > 8.0f ? mx : 0.f, alpha = __builtin_amdgcn_exp2f(-delta);
            mrun += delta; lrun *= alpha;
            x0 = x0 - delta; x1 = x1 - delta; o0 = o0 * alpha; o1 = o1 * alpha;
        }
    };
    auto sm_post = [&](f32x16& x0, f32x16& x1) {
        float ps = 0.f;
#pragma unroll
        for (int i = 0; i < 16; ++i) { x0[i] = __builtin_amdgcn_exp2f(x0[i]); x1[i] = __builtin_amdgcn_exp2f(x1[i]); ps += x0[i] + x1[i]; }
        lrun += ps;
#pragma unroll
        for (int sb = 0; sb < 2; ++sb)
#pragma unroll
            for (int s2 = 0; s2 < 2; ++s2) { const f32x16& pp = sb == 0 ? x0 : x1;
                u32x4 pw; pw.x = cvt_pk_bf16(pp[8 * s2 + 0], pp[8 * s2 + 1]); pw.y = cvt_pk_bf16(pp[8 * s2 + 2], pp[8 * s2 + 3]); pw.z = cvt_pk_bf16(pp[8 * s2 + 4], pp[8 * s2 + 5]); pw.w = cvt_pk_bf16(pp[8 * s2 + 6], pp[8 * s2 + 7]);
                pf[sb][s2] = __builtin_bit_cast(bf16x8, pw); }
    };
    auto qk_exp = [&](int buf, f32x16& x0, f32x16& x1, f32x16& e0, f32x16& e1) {
        int ko = buf * AT_STAGE + r * KP + 16 * hh; asm volatile("" : "+v"(ko));
        const LAS unsigned char* Kl = lds + ko;
        const float ninit = -mrun;
        x0 = (f32x16){ninit, ninit, ninit, ninit, ninit, ninit, ninit, ninit, ninit, ninit, ninit, ninit, ninit, ninit, ninit, ninit}; x1 = x0;
        bf16x8 kf[2][2];
        kf[0][0] = *(const LAS bf16x8*)(Kl); kf[0][1] = *(const LAS bf16x8*)(Kl + 32 * KP);
        float ps = 0.f;
#pragma unroll
        for (int ks = 0; ks < NKS; ++ks) {
            if (ks + 1 < NKS) { kf[(ks + 1) & 1][0] = *(const LAS bf16x8*)(Kl + 32 * (ks + 1)); kf[(ks + 1) & 1][1] = *(const LAS bf16x8*)(Kl + 32 * KP + 32 * (ks + 1)); }
            x0 = __builtin_amdgcn_mfma_f32_32x32x16_bf16(kf[ks & 1][0], qf[ks], x0, 0, 0, 0);
            x1 = __builtin_amdgcn_mfma_f32_32x32x16_bf16(kf[ks & 1][1], qf[ks], x1, 0, 0, 0);
            constexpr int LO[7] = {0, 6, 12, 16, 22, 28, 32};
#pragma unroll
            for (int e = LO[ks]; e < LO[ks + 1]; ++e) { if (e < 16) { e0[e] = __builtin_amdgcn_exp2f(e0[e]); ps += e0[e]; } else { e1[e - 16] = __builtin_amdgcn_exp2f(e1[e - 16]); ps += e1[e - 16]; } }
            SCHED_FENCE();
        }
        lrun += ps;
#pragma unroll
        for (int sb = 0; sb < 2; ++sb)
#pragma unroll
            for (int s2 = 0; s2 < 2; ++s2) { const f32x16& pp = sb == 0 ? e0 : e1;
                u32x4 pw; pw.x = cvt_pk_bf16(pp[8 * s2 + 0], pp[8 * s2 + 1]); pw.y = cvt_pk_bf16(pp[8 * s2 + 2], pp[8 * s2 + 3]); pw.z = cvt_pk_bf16(pp[8 * s2 + 4], pp[8 * s2 + 5]); pw.w = cvt_pk_bf16(pp[8 * s2 + 6], pp[8 * s2 + 7]);
                pf[sb][s2] = __builtin_bit_cast(bf16x8, pw); }
    };
    const int ntile = D.kt1 - D.kt0 + 1;
    int nmine = active ? kt_hi - D.kt0 + 1 : 0; if (nmine > ntile) nmine = ntile;
    auto step = [&](int i, f32x16& c0, f32x16& c1, f32x16& n0, f32x16& n1) {
        if (i < nmine) {
            sm_pre(D.kt0 + i, c0, c1);
            vload(i % AT_NST, 0);
            if (i + 1 < nmine) qk_exp((i + 1) % AT_NST, n0, n1, c0, c1); else sm_post(c0, c1);
            pvm(i % AT_NST);
        }
    };
    __syncthreads();
    dma_issue(D.kt0, 0);
    if (ntile > 1) dma_issue(D.kt0 + 1, 1);
    if (ntile > 2) dma_issue(D.kt0 + 2, 2);
    AT_SYNC(0);
    if (nmine > 0) qk(0, sa0, sa1);
    for (int i = 0; i < ntile; i += 2) {
        if (i + 3 < ntile) dma_issue(D.kt0 + i + 3, (i + 3) % AT_NST);
        if (i + 4 < ntile) dma_issue(D.kt0 + i + 4, (i + 4) % AT_NST);
        step(i, sa0, sa1, sb0, sb1);
        if (i + 1 < ntile) step(i + 1, sb0, sb1, sa0, sa1);
        AT_SYNC(0);
    }
#undef AT_SYNC
    if (active) {
        const float lt = lrun + __shfl_xor(lrun, 32), il = 1.0f / lt;
        bf16_t* op = D.o + (size_t)mq * D.os;
#pragma unroll
        for (int blk = 0; blk < 2; ++blk)
#pragma unroll
            for (int g4 = 0; g4 < 4; ++g4) { const f32x16& oo = blk == 0 ? o0 : o1;
                *(u32x2*)(op + 32 * blk + 8 * g4 + 4 * hh) = (u32x2){cvt_pk_bf16(oo[4 * g4] * il, oo[4 * g4 + 1] * il), cvt_pk_bf16(oo[4 * g4 + 2] * il, oo[4 * g4 + 3] * il)}; }
    }
}

__device__ __forceinline__ void mla_attn_phase(Frame& F) {
    unsigned char* ws = F.ws;
    for (int p0 = F.vcu; p0 < 512; p0 += F.G) {
        const int p = F.G == 256 ? (F.vcu >> 5) * 64 + (p0 >> 8) * 32 + (F.vcu & 31) : p0;
        const int bh = p >> 2, j = p & 3, b = bh >> 4, h = bh & 15;
#pragma unroll 1
        for (int half = 0; half < 2; ++half) { const int qb = half == 0 ? 7 - j : j;
            AttnDesc D;
            D.q = (const bf16_t*)(ws + WS_Q) + (size_t)b * SEQ * 1536 + h * 96; D.qs = 1536;
            D.k = (const bf16_t*)(ws + WS_KN) + (size_t)b * SEQ * 1024 + h * 64; D.ks = 1024;
            D.k2 = (const bf16_t*)(ws + WS_KPE) + (size_t)b * SEQ * 32; D.k2s = 32;
            D.v = (const bf16_t*)(ws + WS_V) + (size_t)b * SEQ * 1024 + h * 64; D.vs = 1024;
            D.o = (bf16_t*)(ws + WS_OA) + (size_t)b * SEQ * 1280 + 256 + h * 64; D.os = 1280; D.lse = nullptr; D.lses = 0;
            D.m0 = qb * 256; D.nq = 256; D.kt0 = 0; D.kt1 = 4 * qb + 3;
            attn_unit_pipe(F, D); }
    }
}
constexpr int DL_P = 144, DL_TILE = 2 * 64 * DL_P;
struct DilUnit { const bf16_t* q; bf16_t* o; float* lse; int d, os, lses, m0, nq, kt0, nt; };
__device__ __forceinline__ DilUnit dil_decode(unsigned char* ws, int u) {
    const bf16_t* DIL = (const bf16_t*)(ws + WS_DIL); bf16_t* OG = (bf16_t*)(ws + WS_OG); float* LSE = (float*)(ws + WS_LSE);
    int g, b, h, rr, c, d, nq;
    if (u < 256) { g = 0; b = u >> 5; h = (u >> 3) & 3; c = u & 7; rr = 0; d = 1; nq = 256; }
    else if (u < 512) { const int v = u - 256; g = 1; b = v >> 5; h = (v >> 3) & 3; rr = (v >> 1) & 3; c = v & 1; d = 4; nq = 256; }
    else { const int v = u - 512; g = 2; b = v >> 6; h = (v >> 4) & 3; rr = v & 15; c = 0; d = 16; nq = 128; }
    DilUnit D; const size_t row0 = (size_t)b * SEQ + rr;
    D.q = DIL + row0 * 2304 + g * 768 + h * 64; D.d = d;
    D.o = OG + ((size_t)g * T + row0) * 256 + h * 64; D.os = d * 256; D.lse = LSE + ((size_t)g * T + row0) * 4 + h; D.lses = d * 4;
    D.m0 = c * 256; D.nq = nq; D.kt0 = max(0, 4 * c - 2); D.nt = (nq == 256 ? 4 * c + 3 : 1) - D.kt0 + 1;
    return D;
}
__device__ __forceinline__ void dil_attn_phase(Frame& F) {
    unsigned char* ws = F.ws; LAS unsigned char* lds = F.lds;
    const int lane = F.lane, w = F.wave, r = lane & 31, hh = lane >> 5, tid = F.tid;
    const int part = tid & 15, keyA = tid >> 4;
    const int ldsA = (part < 8 ? 0 : 64 * DL_P) + keyA * DL_P + (part & 7) * 16;
    const int vlane = 64 * DL_P + (hh * 4 + ((lane & 15) >> 2)) * DL_P + (16 * ((lane >> 4) & 1) + 4 * (lane & 3)) * 2;
    u32x4 st[12]; bf16x8 qn[4];
    auto issue = [&](const DilUnit& D) {
        const bf16_t* src = D.q + (part < 8 ? 256 : 512) + (part & 7) * 8; const size_t rs_ = (size_t)D.d * 2304;
#pragma unroll
        for (int j = 0; j < 6; ++j) if (j < D.nt) { const size_t mk = (size_t)(64 * (D.kt0 + j) + keyA);
            st[2 * j] = *(const u32x4*)(src + mk * rs_); st[2 * j + 1] = *(const u32x4*)(src + (mk + 32) * rs_); }
        if (w * 32 < D.nq) { const size_t mq = (size_t)(D.m0 + 32 * w + r);
#pragma unroll
            for (int ks = 0; ks < 4; ++ks) qn[ks] = *(const bf16x8*)(D.q + mq * rs_ + 16 * ks + 8 * hh); }
    };
    auto store = [&](const DilUnit& D) {
#pragma unroll
        for (int j = 0; j < 6; ++j) if (j < D.nt) { *(LAS u32x4*)(lds + j * DL_TILE + ldsA) = st[2 * j]; *(LAS u32x4*)(lds + j * DL_TILE + ldsA + 32 * DL_P) = st[2 * j + 1]; }
    };
    int u = F.vcu;
    if (u >= 1024) return;
    auto umap = [&](int uu) { return (F.G == 256 && uu >= 512) ? 512 + 64 * (F.vcu >> 5) + 32 * ((uu - 512) >> 8) + (F.vcu & 31) : uu; };
    DilUnit cur = dil_decode(ws, umap(u));
    __syncthreads();
    issue(cur); store(cur);
    bf16x8 qf[4];
#pragma unroll
    for (int ks = 0; ks < 4; ++ks) qf[ks] = qn[ks];
    __syncthreads();
    for (;;) {
        const int un = u + F.G; const bool has_next = un < 1024;
        DilUnit nxt = cur; if (has_next) { nxt = dil_decode(ws, umap(un)); issue(nxt); }
        if (w * 32 < cur.nq) {
            const int mq = cur.m0 + 32 * w + r;
            const int kt_hi = (cur.m0 + 32 * w + 31) >> 6, kt_lo = max(0, (cur.m0 + 32 * w - 128) >> 6);
            f32x16 o0, o1;
#pragma unroll
            for (int i = 0; i < 16; ++i) { o0[i] = 0.f; o1[i] = 0.f; }
            float mrun = -1024.0f, lrun = 0.f;
#pragma unroll 1
            for (int kt = kt_lo; kt <= kt_hi; ++kt) {
                int ko = (kt - cur.kt0) * DL_TILE + r * DL_P + 16 * hh; asm volatile("" : "+v"(ko));
                const LAS unsigned char* Kl = lds + ko;
                const float ninit = -mrun;
                f32x16 s0 = (f32x16){ninit, ninit, ninit, ninit, ninit, ninit, ninit, ninit, ninit, ninit, ninit, ninit, ninit, ninit, ninit, ninit}, s1 = s0;
#pragma unroll
                for (int ks = 0; ks < 4; ++ks) {
                    const bf16x8 k0 = *(const LAS bf16x8*)(Kl + 32 * ks), k1 = *(const LAS bf16x8*)(Kl + 32 * DL_P + 32 * ks);
                    s0 = __builtin_amdgcn_mfma_f32_32x32x16_bf16(k0, qf[ks], s0, 0, 0, 0);
                    s1 = __builtin_amdgcn_mfma_f32_32x32x16_bf16(k1, qf[ks], s1, 0, 0, 0);
                }
                if (kt == kt_hi || kt <= kt_lo + 1) {
#pragma unroll
                    for (int i = 0; i < 16; ++i) { const int key0 = 64 * kt + (i & 3) + 8 * (i >> 2) + 4 * hh, key1 = key0 + 32;
                        s0[i] = (key0 <= mq && key0 >= mq - 128) ? s0[i] : -3.0e38f; s1[i] = (key1 <= mq && key1 >= mq - 128) ? s1[i] : -3.0e38f; }
                }
                float mx = fmaxf(s0[0], s1[0]);
#pragma unroll
                for (int i = 1; i < 16; ++i) mx = fmaxf(mx, fmaxf(s0[i], s1[i]));
                mx = fmaxf(mx, __shfl_xor(mx, 32));
                if (__any(mx > 8.0f)) {
                    const float delta = mx > 8.0f ? mx : 0.f, alpha = __builtin_amdgcn_exp2f(-delta);
                    mrun += delta; lrun *= alpha;
                    s0 = s0 - delta; s1 = s1 - delta; o0 = o0 * alpha; o1 = o1 * alpha;
                }
                float ps = 0.f;
#pragma unroll
                for (int i = 0; i < 16; ++i) { s0[i] = __builtin_amdgcn_exp2f(s0[i]); s1[i] = __builtin_amdgcn_exp2f(s1[i]); ps += s0[i] + s1[i]; }
                lrun += ps;
                int vo = (kt - cur.kt0) * DL_TILE + vlane; asm volatile("" : "+v"(vo));
                const LAS unsigned char* Vl = lds + vo;
#pragma unroll
                for (int sb = 0; sb < 2; ++sb)
#pragma unroll
                    for (int s2 = 0; s2 < 2; ++s2) { const f32x16& pp = sb == 0 ? s0 : s1;
                        u32x4 pw; pw.x = cvt_pk_bf16(pp[8 * s2 + 0], pp[8 * s2 + 1]); pw.y = cvt_pk_bf16(pp[8 * s2 + 2], pp[8 * s2 + 3]); pw.z = cvt_pk_bf16(pp[8 * s2 + 4], pp[8 * s2 + 5]); pw.w = cvt_pk_bf16(pp[8 * s2 + 6], pp[8 * s2 + 7]);
                        const bf16x8 pfr = __builtin_bit_cast(bf16x8, pw);
                        const LAS unsigned char* vb = Vl + (32 * sb + 16 * s2) * DL_P;
#pragma unroll
                        for (int blk = 0; blk < 2; ++blk) {
                            const v4i16_t t0 = __builtin_amdgcn_ds_read_tr16_b64_v4i16((LAS v4i16_t*)(vb + blk * 64));
                            const v4i16_t t1 = __builtin_amdgcn_ds_read_tr16_b64_v4i16((LAS v4i16_t*)(vb + blk * 64 + 8 * DL_P));
                            const bf16x8 vf = (bf16x8){t0[0], t0[1], t0[2], t0[3], t1[0], t1[1], t1[2], t1[3]};
                            if (blk == 0) o0 = __builtin_amdgcn_mfma_f32_32x32x16_bf16(vf, pfr, o0, 0, 0, 0); else o1 = __builtin_amdgcn_mfma_f32_32x32x16_bf16(vf, pfr, o1, 0, 0, 0);
                        } }
            }
            const float lt = lrun + __shfl_xor(lrun, 32), il = 1.0f / lt;
            bf16_t* op = cur.o + (size_t)mq * cur.os;
#pragma unroll
            for (int blk = 0; blk < 2; ++blk)
#pragma unroll
                for (int g4 = 0; g4 < 4; ++g4) { const f32x16& oo = blk == 0 ? o0 : o1;
                    *(u32x2*)(op + 32 * blk + 8 * g4 + 4 * hh) = (u32x2){cvt_pk_bf16(oo[4 * g4] * il, oo[4 * g4 + 1] * il), cvt_pk_bf16(oo[4 * g4 + 2] * il, oo[4 * g4 + 3] * il)}; }
            if (hh == 0) cur.lse[(size_t)mq * cur.lses] = mrun + __builtin_amdgcn_logf(lt);
        }
        if (!has_next) break;
        __syncthreads();
        store(nxt);
#pragma unroll
        for (int ks = 0; ks < 4; ++ks) qf[ks] = qn[ks];
        cur = nxt; u = un;
        __syncthreads();
    }
    __syncthreads();
}
__device__ __forceinline__ void dil_merge(Frame& F) {
    unsigned char* ws = F.ws; const bf16_t* OG = (const bf16_t*)(ws + WS_OG); const float* LSE = (const float*)(ws + WS_LSE); bf16_t* OB = (bf16_t*)(ws + WS_OA);
    const bool xr = F.G == 256;
    for (int i = xr ? F.tid : F.vcu * NTHR + F.tid; i < (xr ? 2048 : T * 32); i += xr ? NTHR : F.G * NTHR) { const int row = xr ? (F.vcu >> 5) * 2048 + (F.vcu & 31) * 64 + (i >> 5) : i >> 5, ch = i & 31, h = ch >> 3;
        const float l0 = LSE[(size_t)row * 4 + h], l1 = LSE[((size_t)T + row) * 4 + h], l2 = LSE[((size_t)2 * T + row) * 4 + h];
        const float mx = fmaxf(l0, fmaxf(l1, l2)); const float w0 = __builtin_amdgcn_exp2f(l0 - mx), w1 = __builtin_amdgcn_exp2f(l1 - mx), w2 = __builtin_amdgcn_exp2f(l2 - mx); const float inv = 1.0f / (w0 + w1 + w2);
        f32x4 a0, a1, b0, b1, c0, c1;
        unpack8(*(const u32x4*)(OG + (size_t)row * 256 + ch * 8), a0, a1); unpack8(*(const u32x4*)(OG + ((size_t)T + row) * 256 + ch * 8), b0, b1); unpack8(*(const u32x4*)(OG + ((size_t)2 * T + row) * 256 + ch * 8), c0, c1);
        const f32x4 r0 = (a0 * w0 + b0 * w1 + c0 * w2) * inv, r1 = (a1 * w0 + b1 * w1 + c1 * w2) * inv;
        *(u32x4*)(OB + (size_t)row * 1280 + ch * 8) = pack8(r0, r1); }
}

template <class Sched> __device__ __forceinline__ void dispatch1(Frame& F, const Sched& S, const float* b_g, const float* b_e, int l) {
    unsigned char* ws = F.ws; const float* RL = (const float*)(ws + WS_RL); const float* ssq2 = (const float*)(ws + WS_SSQ2) + (size_t)l * T * 16;
    int* tok_e = (int*)(ws + RT_TOK_E); float* tok_w = (float*)(ws + RT_TOK_W); float* tok_rs = (float*)(ws + RT_TOK_RS);
    int* hist_g = (int*)(ws + RT_HIST) + l * 4096;
    LAS int* hist = (LAS int*)F.lds;
    VM_WAIT(); __syncthreads();
    Unit u;
    for (int i = 0; S.next(i, u); ++i) {
      if (F.tid < 64) hist[F.tid] = 0;
      __syncthreads();
      if (F.tid < 256) { const int t = u.pm * 256 + F.tid;
        const float rs = rsqrtf(part_sum<16>(ssq2 + (size_t)t * 16) * (1.0f / 1024.0f) + EPS);
        const float* lg = RL + (size_t)t * 72;
        float gl[8];
#pragma unroll
        for (int j = 0; j < 8; ++j) gl[j] = lg[j] * rs + b_g[j];
        int gs = 0; float gm = gl[0];
#pragma unroll
        for (int j = 1; j < 8; ++j) if (gl[j] > gm) { gm = gl[j]; gs = j; }
        float den = 0.f;
#pragma unroll
        for (int j = 0; j < 8; ++j) den += __expf(gl[j] - gm);
        const float pg = 1.0f / den;
        float el[8];
        { const f32x4 e0 = *(const f32x4*)(lg + 8 + gs * 8), e1 = *(const f32x4*)(lg + 12 + gs * 8);
#pragma unroll
          for (int j = 0; j < 4; ++j) { el[j] = e0[j] * rs + b_e[gs * 8 + j]; el[4 + j] = e1[j] * rs + b_e[gs * 8 + 4 + j]; } }
        int i0 = 0; float v0 = el[0];
#pragma unroll
        for (int j = 1; j < 8; ++j) if (el[j] > v0) { v0 = el[j]; i0 = j; }
        int i1 = -1; float v1 = -3.0e38f;
#pragma unroll
        for (int j = 0; j < 8; ++j) if (j != i0 && el[j] > v1) { v1 = el[j]; i1 = j; }
        const float ex = __expf(v1 - v0), w0 = pg / (1.0f + ex), w1 = pg * ex / (1.0f + ex);
        const int e0i = gs * 8 + i0, e1i = gs * 8 + i1;
        tok_e[2 * t] = e0i; tok_e[2 * t + 1] = e1i; tok_w[2 * t] = w0; tok_w[2 * t + 1] = w1; tok_rs[t] = rs;
        atomicAdd((int*)&hist[e0i], 1); atomicAdd((int*)&hist[e1i], 1); }
      __syncthreads();
      if (F.tid < 64) hist_g[u.pm * 64 + F.tid] = hist[F.tid];
      __syncthreads(); }
}
__device__ __forceinline__ void dispatch2(Frame& F, int l) {
    unsigned char* ws = F.ws;
    const int* tok_e = (const int*)(ws + RT_TOK_E); const float* tok_w = (const float*)(ws + RT_TOK_W); const float* tok_rs = (const float*)(ws + RT_TOK_RS);
    int* dest = (int*)(ws + RT_DEST); int* row_tok = (int*)(ws + RT_ROW_TOK); float* row_w = (float*)(ws + RT_ROW_W); float* row_rs = (float*)(ws + RT_ROW_RS); int* blk_e = (int*)(ws + RT_BLK_E);
    const int* hist_g = (const int*)(ws + RT_HIST) + l * 4096;
    LAS int* pst = (LAS int*)F.lds;
    LAS int* hl = pst + 1024;
    const int vp = F.G == 256 ? ((F.vcu & 31) < 8 ? (F.vcu >> 5) * 8 + (F.vcu & 31) : 64) : F.vcu;
    if (vp >= 64) return;
    for (int i = F.tid; i < 4096; i += NTHR) hl[i] = hist_g[i];
    __syncthreads();
    if (F.tid < 64) { int c = 0; for (int p = 0; p < 64; ++p) c += hl[p * 64 + F.tid];
        const int pad = (c + 255) & ~255; int incl = pad;
#pragma unroll
        for (int d = 1; d < 64; d <<= 1) { const int t = __shfl_up(incl, d); if (F.tid >= d) incl += t; }
        pst[64 + F.tid] = c; pst[F.tid] = incl - pad; if (F.tid == 63) pst[128] = incl; }
    __syncthreads();
    for (int pm = vp; pm < 64; pm += F.G) {
        if (F.tid < 64) { int bsum = 0; for (int p = 0; p < pm; ++p) bsum += hl[p * 64 + F.tid]; pst[192 + F.tid] = pst[F.tid] + bsum; pst[256 + F.tid] = 0; }
        __syncthreads();
        if (F.tid < 256) { const int t = pm * 256 + F.tid;
#pragma unroll
            for (int k = 0; k < 2; ++k) { const int e = tok_e[2 * t + k]; const int slot = pst[192 + e] + atomicAdd((int*)&pst[256 + e], 1);
                row_tok[slot] = t; row_w[slot] = tok_w[2 * t + k]; row_rs[slot] = tok_rs[t]; dest[2 * t + k] = slot; } }
        __syncthreads();
    }
    for (int e = vp; e < 64; e += F.G) { const int c = pst[64 + e], pc = (c + 255) & ~255;
        for (int s2 = c + F.tid; s2 < pc; s2 += NTHR) { row_tok[pst[e] + s2] = 0; row_w[pst[e] + s2] = 0.f; row_rs[pst[e] + s2] = 0.f; } }
    if (vp == 0) { const int nblk = pst[128] >> 8;
        for (int bk = F.tid; bk < nblk; bk += NTHR) { int ee = 0; for (int j = 0; j < 64; ++j) if (pst[64 + j] > 0 && pst[j] <= bk * 256) ee = j; blk_e[bk] = ee; }
        if (F.tid == 0) blk_e[255] = nblk; }
    __syncthreads();
}

__device__ __forceinline__ void combine_norm(Frame& F) {
    unsigned char* ws = F.ws; const bf16_t* YS = (const bf16_t*)(ws + WS_YS); const int* dest = (const int*)(ws + RT_DEST); bf16_t* XS = (bf16_t*)(ws + WS_XN); const bf16_t* XB = (const bf16_t*)(ws + WS_XB); float* rsp = (float*)(ws + RT_PLE_RS);
    const int gw = F.vcu * NWAVES + F.wave, NGW = F.G * NWAVES;
    for (int m = rl_first(F), m_end = rl_end(F), m_step = rl_step(F); m < m_end; m += m_step) { const int d0 = dest[2 * m], d1 = dest[2 * m + 1];
        const u32x2* xr = (const u32x2*)(XB + (size_t)m * 1024) + F.lane; const u32x2* y0 = (const u32x2*)(YS + (size_t)d0 * 1024) + F.lane; const u32x2* y1 = (const u32x2*)(YS + (size_t)d1 * 1024) + F.lane;
        float s = 0.f;
#pragma unroll
        for (int j = 0; j < 4; ++j) { const u32x2 x = xr[64 * j], a = y0[64 * j], b = y1[64 * j];
            const float v0 = bf_lo(x.x) + (bf_lo(a.x) + bf_lo(b.x)), v1 = bf_hi(x.x) + (bf_hi(a.x) + bf_hi(b.x)), v2 = bf_lo(x.y) + (bf_lo(a.y) + bf_lo(b.y)), v3 = bf_hi(x.y) + (bf_hi(a.y) + bf_hi(b.y));
            const u32x2 o = (u32x2){cvt_pk_bf16(v0, v1), cvt_pk_bf16(v2, v3)};
            ((u32x2*)(XS + (size_t)m * 1024))[F.lane + 64 * j] = o;
            const float r0 = bf_lo(o.x), r1 = bf_hi(o.x), r2 = bf_lo(o.y), r3 = bf_hi(o.y);
            s += (r0 * r0 + r1 * r1) + (r2 * r2 + r3 * r3); }
        s = wave_sum(s); if (F.lane == 0) rsp[m] = rsqrtf(s * (1.0f / 1024.0f) + EPS); }
}
__device__ __forceinline__ void final_norm(Frame& F, const float* g_final) {
    const float* ssq = (const float*)(F.ws + WS_SSQ1) + (size_t)4 * T * 16; const bf16_t* XB = (const bf16_t*)(F.ws + WS_XB);
    const int gw = F.vcu * NWAVES + F.wave, NGW = F.G * NWAVES;
    f32x4 gp[4];
#pragma unroll
    for (int j = 0; j < 4; ++j) gp[j] = ((const f32x4*)g_final)[F.lane + 64 * j];
    for (int m = rl_first(F), m_end = rl_end(F), m_step = rl_step(F); m < m_end; m += m_step) { const float rs = rsqrtf(part_sum<16>(ssq + (size_t)m * 16) * (1.0f / 1024.0f) + EPS) * F.diag_scale;
        const u32x2* xr = (const u32x2*)(XB + (size_t)m * 1024) + F.lane; f32x4* orow = (f32x4*)(F.X + (size_t)m * 1024) + F.lane;
#pragma unroll
        for (int j = 0; j < 4; ++j) { const u32x2 x = xr[64 * j]; orow[64 * j] = (f32x4){bf_lo(x.x), bf_hi(x.x), bf_lo(x.y), bf_hi(x.y)} * rs * gp[j]; } }
}

constexpr int PH_PER_LAYER = 13, N_PHASES = 2 + DEPTH * PH_PER_LAYER;
__global__ void __launch_bounds__(NTHR, 2) fwd_kernel(Args args) {
    extern __shared__ __attribute__((aligned(16))) unsigned char lds_raw[];
    Frame F;
    F.lds = (LAS unsigned char*)lds_raw;
    F.tid = threadIdx.x; F.lane = F.tid & 63; F.wave = __builtin_amdgcn_readfirstlane(F.tid >> 6);
    F.G = gridDim.x; { const int bx = blockIdx.x; F.vcu = (F.G % 8 == 0) ? (bx % 8) * (F.G / 8) + bx / 8 : bx; }
    F.ws = nullptr; F.X = nullptr; F.diag_scale = 1.0f;
    for (int u = F.tid; u < (LDS_BYTES - LDSCTL_OFF) / 4; u += NTHR) ((LAS unsigned*)(F.lds + LDSCTL_OFF))[u] = 0u;
    __syncthreads();
    const int lo = args.ph_lo, hi = args.ph_hi;
    const bool use_bar = (hi - lo) > 1;
    XcdBarrier bar; bar.bar = (unsigned*)(args.ws + WS_CTL) + CW_BAR; bar.x = 0; bar.st = nullptr;
    if (use_bar) bar = xcd_barrier_post((unsigned*)(args.ws + WS_CTL) + CW_BAR, (volatile LAS unsigned*)(F.lds + MISC_OFF + 32));
#ifndef PH_EN
#define PH_EN(j) 1
#endif
#define IN(k) (lo <= (k) && (k) < hi)
#define INL(j) (PH_EN(j) && IN(p0 + (j)))
#ifdef DIAG_J
#define SEAM(k) do { if (IN(k) && IN((k) + 1)) xcd_barrier(bar); if (blockIdx.x == 0 && threadIdx.x == 0) ((unsigned long long*)(args.ws + RT_TS))[(k) + 1] = __builtin_amdgcn_s_memtime(); } while (0)
#else
#define SEAM(k) do { if (IN(k) && IN((k) + 1)) xcd_barrier(bar); } while (0)
#endif
#define SEAML(k) do { if (IN(k) && IN((k) + 1)) { if (local_ok) xcd_barrier_local(bar); else xcd_barrier(bar); } } while (0)
#define KARGS() ({ const AS4 Args* _p = (const AS4 Args*)__builtin_amdgcn_kernarg_segment_ptr(); asm volatile("" : "+s"(_p)); _p; })
#define PHASE_ENV const AS4 Args* ap = KARGS(); unsigned char* ws = ap->ws; Frame P = F; P.ws = ws; P.X = ap->out; int cidl = cid; P.tid = threadIdx.x; asm volatile("" : "+v"(P.tid)); P.lane = P.tid & 63; \
    asm volatile("" : "+v"(P.lane)); asm volatile("" : "+s"(P.vcu), "+s"(P.G), "+s"(P.wave), "+s"(cidl)); (void)ws; (void)cidl
    const int cid = (int)blockIdx.x;
#ifdef DIAG_J
    if (blockIdx.x == 0 && threadIdx.x == 0) ((unsigned long long*)(args.ws + RT_TS))[0] = __builtin_amdgcn_s_memtime();
#endif

    if (use_bar && threadIdx.x == 0) __hip_atomic_store((unsigned*)(args.ws + WS_CTL) + CW_XCT + blockIdx.x, xb_xcc_id() + 1u, __ATOMIC_RELAXED, __HIP_MEMORY_SCOPE_AGENT);
    if (IN(0)) { PHASE_ENV; prologue(P, ap); }
    SEAM(0);
    bool local_ok = false;
    if (use_bar && lo == 0 && hi == N_PHASES && gridDim.x == 256) {
        volatile LAS unsigned* fl = (volatile LAS unsigned*)(F.lds + MISC_OFF + 192);
        if (threadIdx.x == 0) fl[0] = 0u;
        __syncthreads();
        if (threadIdx.x < 256) { const unsigned* xct = (const unsigned*)(args.ws + WS_CTL) + CW_XCT; const int t = threadIdx.x;
            const unsigned mine = __hip_atomic_load(xct + t, __ATOMIC_RELAXED, __HIP_MEMORY_SCOPE_AGENT), lead = __hip_atomic_load(xct + (t & 7), __ATOMIC_RELAXED, __HIP_MEMORY_SCOPE_AGENT);
            unsigned bad = (mine == 0u || mine != lead) ? 1u : 0u;
            if (t < 8) for (int j = 0; j < t; ++j) bad |= (__hip_atomic_load(xct + j, __ATOMIC_RELAXED, __HIP_MEMORY_SCOPE_AGENT) == mine) ? 1u : 0u;
            if (bad) fl[0] = 1u; }
        __syncthreads();
        local_ok = __builtin_amdgcn_readfirstlane(fl[0]) == 0u;
    }

#pragma unroll 1
    for (int l = 0; l < DEPTH; ++l) {
        const int p0 = 1 + PH_PER_LAYER * l;
        if (INL(0)) {
            PHASE_ENV; unsigned char* wd = ws + WS_WD + (size_t)l * WD_STRIDE;
            pg8::Gemm g{(const bf16_t*)(ws + WS_XB), (const bf16_t*)(wd + WD_IN), 1024, 1024, 1024, nullptr}; pg8::DenseOrder S; S.init(64, 21, 1024, 1024, P.G, cidl, 20);
            { const float* sq = (const float*)(ws + WS_SSQ1) + (size_t)l * T * 16; fill_tab(P, S, [=](int row) { return rsqrtf(part_sum<16>(sq + (size_t)row * 16) * (1.0f / 1024.0f) + EPS); }); }
            EpiInProj E{(bf16_t*)(ws + WS_CQ), (bf16_t*)(ws + WS_CKV), (bf16_t*)(ws + WS_KPE), (bf16_t*)(ws + WS_DIL), (bf16_t*)(ws + WS_SG),
                        (float*)(ws + WS_SSQQ) + (size_t)l * T * 8, (float*)(ws + WS_SSQKV) + (size_t)l * T * 4, (const f32x2*)(ws + WS_ROPE_DIL), (const f32x2*)(ws + WS_ROPE_MLA), (const LAS float*)(P.lds + TAB_OFF)};
#ifdef EXP_SIMPLE_EPI
            EpiScaleStore E2{nullptr, 0.f, (bf16_t*)(ws + WS_YS), NIN}; pg8::gemm_phase<EpiScaleStore, pg8::DenseOrder, false, true>(P.lds, g, S, E2); (void)E;
#else
            pg8::gemm_phase<EpiInProj, pg8::DenseOrder, false, true, true>(P.lds, g, S, E);
#endif
            if (P.G == 256) { if (cidl >= 64) { const int s1 = l == 0 ? 11264 : W13_SPLIT, s2 = l == 0 ? 12800 : W13_SPLIT2; convert_w13(P, ap, l, cidl - 64, 192, l == 0 ? 0 : W13_EARLY, s1); convert_w13_single(P, ap, l, cidl - 64, 192, s1, s2); } }
        }
        SEAML(p0 + 0);
        if (INL(1)) {
            { PHASE_ENV; unsigned char* wd = ws + WS_WD + (size_t)l * WD_STRIDE;
              pg8::Gemm g{(const bf16_t*)(ws + WS_CQ), (const bf16_t*)(wd + WD_Q), 512, 512, 512, nullptr}; pg8::DenseOrder S; S.init(64, 6, 512, 512, P.G, cidl);
              { const float* sq = (const float*)(ws + WS_SSQQ) + (size_t)l * T * 8; fill_tab(P, S, [=](int row) { return rsqrtf(part_sum<8>(sq + (size_t)row * 8) * (1.0f / 512.0f) + EPS); }); }
              EpiQup E{(bf16_t*)(ws + WS_Q), (const f32x2*)(ws + WS_ROPE_MLA), (const LAS float*)(P.lds + TAB_OFF)}; pg8::gemm_phase<EpiQup, pg8::DenseOrder, false, true>(P.lds, g, S, E);
              if (P.G == 256 && cidl >= 128) convert_w13(P, ap, l, cidl - 128, 128, l == 0 ? 12800 : W13_SPLIT2, 64 * 256); }
            { PHASE_ENV; unsigned char* wd = ws + WS_WD + (size_t)l * WD_STRIDE;
              static_assert(WD_V == WD_K + 1024 * 256 * 2, "k/v weight blocks adjacent");
              pg8::Gemm g{(const bf16_t*)(ws + WS_CKV), (const bf16_t*)(wd + WD_K), 256, 256, 256, nullptr}; pg8::DenseOrder S; S.init(64, 8, 256, 256, P.G, cidl);
              { const float* sq = (const float*)(ws + WS_SSQKV) + (size_t)l * T * 4; fill_tab(P, S, [=](int row) { return rsqrtf(part_sum<4>(sq + (size_t)row * 4) * (1.0f / 256.0f) + EPS); }); }
              EpiScaleStore E{(const LAS float*)(P.lds + TAB_OFF), (bf16_t*)(ws + WS_KN), 1024, (bf16_t*)(ws + WS_V), 4}; pg8::gemm_phase<EpiScaleStore, pg8::DenseOrder, false, true>(P.lds, g, S, E); }
            { PHASE_ENV; dil_attn_phase(P); }
        }
        SEAML(p0 + 1);
        if (INL(2)) { { PHASE_ENV; mla_attn_phase(P); } { PHASE_ENV; dil_merge(P); } }
        SEAML(p0 + 2);
#ifdef DIAG_J
        if (blockIdx.x == 0 && threadIdx.x == 0) ((unsigned long long*)(args.ws + RT_TS))[p0 + 3 + 1] = __builtin_amdgcn_s_memtime();
#endif
        if (INL(4)) {
            PHASE_ENV; unsigned char* wd = ws + WS_WD + (size_t)l * WD_STRIDE;
            static_assert(WD_B == WD_A + 2 * MiB && WS_OB == WS_OA + 32 * MiB, "combined branch operands: [1024][1280] weights at WD_A, [T][1280] activations at WS_OA");
            pg8::Gemm g{(const bf16_t*)(ws + WS_OA), (const bf16_t*)(wd + WD_A), 1280, 1280, 1280, nullptr}; pg8::DenseOrder S; S.init(64, 4, 1280, 1280, P.G, cidl);
            EpiGateFused E{(const bf16_t*)(ws + WS_SG), (bf16_t*)(ws + WS_MERGED)}; pg8::gemm_phase<EpiGateFused, pg8::DenseOrder, false, false, false, true>(P.lds, g, S, E);
        }
        SEAML(p0 + 4);
        if (INL(5)) {
            PHASE_ENV; unsigned char* wd = ws + WS_WD + (size_t)l * WD_STRIDE;
            pg8::Gemm g{(const bf16_t*)(ws + WS_MERGED), (const bf16_t*)(wd + WD_O), 1024, 1024, 1024, nullptr}; pg8::DenseOrder S; S.init(64, 4, 1024, 1024, P.G, cidl);
            EpiResid<0> E{(bf16_t*)(ws + WS_XB), (float*)(ws + WS_SSQ2) + (size_t)l * T * 16, nullptr, (const bf16_t*)(ws + WS_XB), nullptr}; pg8::gemm_phase<EpiResid<0>, pg8::DenseOrder, false, false>(P.lds, g, S, E);
        }
        SEAML(p0 + 5);
        if (INL(6)) {
            PHASE_ENV; unsigned char* wd = ws + WS_WD + (size_t)l * WD_STRIDE;
            if (P.G == 256) { const int x = cidl & 7, j = cidl >> 3; cidl = j < 8 ? 8 * x + j : 64 + 24 * x + (j - 8); }
            pg8::Gemm g{(const bf16_t*)(ws + WS_XB), (const bf16_t*)(wd + WD_R), 1024, 1024, 1024, nullptr}; RouterFullOrder S{P.G, cidl};
            EpiRouter E{(float*)(ws + WS_RL)}; pg8::gemm_phase<EpiRouter, RouterFullOrder, false, false, true>(P.lds, g, S, E);
            dispatch1(P, S, (const float*)ap->in[14] + l * 8, (const float*)ap->in[16] + l * 64, l);
            if (P.G == 256) { if (cidl >= 64) convert_w2(P, ap, l, cidl - 64, 192, 0, W2_SPLIT); } else convert_w2(P, ap, l, cidl, P.G);
        }
        SEAM(p0 + 6);
#ifdef DIAG_J
        if (blockIdx.x == 0 && threadIdx.x == 0) ((unsigned long long*)(args.ws + RT_TS))[p0 + 7 + 1] = __builtin_amdgcn_s_memtime();
#endif
        if (INL(8)) { PHASE_ENV; dispatch2(P, l); if (P.G == 256 && (P.vcu & 31) >= 8) convert_w2(P, ap, l, (P.vcu >> 5) * 24 + (P.vcu & 31) - 8, 192, W2_SPLIT, 64 * 128); }
        SEAM(p0 + 8);
        if (INL(9)) {
            const int nblk = ((const int*)(args.ws + RT_BLK_E))[255];
            const int vb = gridDim.x == 256 ? (cid & 7) * 32 + (cid >> 3) : cid;
#pragma unroll 1
            for (int blk = vb; blk < nblk; blk += (int)gridDim.x) {
                { PHASE_ENV; pg8::Gemm g{(const bf16_t*)(ws + WS_XB), (const bf16_t*)(ws + WS_W13 + (size_t)(l & 1) * W13_STRIDE), 1024, 1024, 1024, (const int*)(ws + RT_ROW_TOK)}; BlockUnits<2> S{(const int*)(ws + RT_BLK_E), blk};
                  { const float* rr = (const float*)(ws + RT_ROW_RS); fill_tab(P, S, [=](int row) { return rr[row]; }); }
                  EpiExp1 E{(const LAS float*)(P.lds + TAB_OFF), (bf16_t*)(ws + WS_H)}; pg8::gemm_phase<EpiExp1, BlockUnits<2>, true, true>(P.lds, g, S, E); }
                VM_WAIT(); __syncthreads();
                { PHASE_ENV; pg8::Gemm g{(const bf16_t*)(ws + WS_H), (const bf16_t*)(ws + WS_W2), 256, 256, 256, nullptr}; BlockUnits<4> S{(const int*)(ws + RT_BLK_E), blk};
                  { const float* rw = (const float*)(ws + RT_ROW_W); fill_tab(P, S, [=](int row) { return rw[row]; }); }
                  EpiExp2 E{(const LAS float*)(P.lds + TAB_OFF), (bf16_t*)(ws + WS_YS)}; pg8::gemm_phase<EpiExp2, BlockUnits<4>, false, true>(P.lds, g, S, E); }
            }
            { PHASE_ENV; int vbl = vb; asm volatile("" : "+s"(vbl)); const int nidle = P.G > nblk ? P.G - nblk : 0; const int rank = nidle >= 32 ? (vbl >= nblk ? vbl - nblk : -1) : vbl, cnt = nidle >= 32 ? nidle : P.G;
              unsigned char* wd = ws + WS_WD + (size_t)l * WD_STRIDE;
              pg8::Gemm g{(const bf16_t*)(ws + WS_PB) + (size_t)l * T * 256, (const bf16_t*)(wd + WD_P), 256, 256, 256, nullptr}; PleProjRange S{rank, cnt};
              EpiScaleStore E{nullptr, (bf16_t*)(ws + WS_E), 1024, nullptr, 0}; pg8::gemm_phase<EpiScaleStore, PleProjRange, false, true>(P.lds, g, S, E);
              if (rank >= 0 && l + 1 < DEPTH) { convert_dense(P, ap, l + 1, rank, cnt); convert_p(P, ap, l + 1, rank, cnt); convert_w13(P, ap, l + 1, rank, cnt, 0, W13_EARLY); } }
        }
        SEAM(p0 + 9);
#ifdef DIAG_J
        if (blockIdx.x == 0 && threadIdx.x == 0) ((unsigned long long*)(args.ws + RT_TS))[p0 + 10 + 1] = __builtin_amdgcn_s_memtime();
#endif
        if (INL(11)) { PHASE_ENV; combine_norm(P); }
        SEAML(p0 + 11);
        if (INL(12)) {
            PHASE_ENV; unsigned char* wd = ws + WS_WD + (size_t)l * WD_STRIDE;
            pg8::Gemm g{(const bf16_t*)(ws + WS_XN), (const bf16_t*)(wd + WD_G), 1024, 1024, 1024, nullptr}; pg8::DenseOrder S; S.init(64, 4, 1024, 1024, P.G, cidl);
            { const float* rr = (const float*)(ws + RT_PLE_RS); fill_tab(P, S, [=](int row) { return rr[row]; }); }
            EpiResid<1> E{(bf16_t*)(ws + WS_XB), (float*)(ws + WS_SSQ1) + (size_t)(l + 1) * T * 16, (const bf16_t*)(ws + WS_E), (const bf16_t*)(ws + WS_XN), (const LAS float*)(P.lds + TAB_OFF)}; pg8::gemm_phase<EpiResid<1>, pg8::DenseOrder, false, false>(P.lds, g, S, E);
        }
        SEAML(p0 + 12);
    }
#ifdef DIAG_J
    { xcd_barrier(bar); PHASE_ENV; const unsigned long long* ts = (const unsigned long long*)(ws + RT_TS); unsigned long long tot = 0;
      if (DIAG_J < 0) tot = ts[1] - ts[0]; else if (DIAG_J >= 100) tot = ts[N_PHASES - 1] - ts[0]; else for (int l2 = 1; l2 < DEPTH; ++l2) tot += ts[2 + PH_PER_LAYER * l2 + DIAG_J] - ts[1 + PH_PER_LAYER * l2 + DIAG_J];
      const float t_us = (float)tot * 0.001f;
#ifndef DIAG_RES
#define DIAG_RES 3.0f
#endif
      const float q = floorf(log2f(fmaxf(t_us, 1.0f)) * DIAG_RES + DIAG_SHIFT);
#ifndef DIAG_OFF
#define DIAG_OFF 0.0f
#endif
      P.diag_scale = 1.0f + 0.01f * (q - DIAG_SHIFT + 0.5f - DIAG_OFF); final_norm(P, (const float*)ap->in[23]); }
#else
    if (IN(N_PHASES - 1)) { PHASE_ENV; final_norm(P, (const float*)ap->in[23]); }
#endif
#undef IN
#undef INL
#undef SEAM
#undef SEAML
}


#ifdef DUMP_MODE
__global__ void dump_kernel(unsigned char* ws, float* out) {
    const size_t N = (size_t)T * 1024;
    for (size_t i = blockIdx.x * (size_t)blockDim.x + threadIdx.x; i < N; i += (size_t)gridDim.x * blockDim.x) {
        float v = 0.f;
#if DUMP_MODE == 1
        const bf16_t* CQ = (const bf16_t*)(ws + WS_CQ); const bf16_t* CKV = (const bf16_t*)(ws + WS_CKV); const bf16_t* KPE = (const bf16_t*)(ws + WS_KPE);
        const bf16_t* DIL = (const bf16_t*)(ws + WS_DIL); const bf16_t* SG = (const bf16_t*)(ws + WS_SG);
        v = bf_lo(CQ[i % ((size_t)T * 512)]) + bf_lo(CKV[i % ((size_t)T * 256)]) + bf_lo(KPE[i % ((size_t)T * 32)]) + bf_lo(DIL[i]) + bf_lo(DIL[i + N]) + bf_lo(DIL[(i % ((size_t)T * 256)) + 2 * N]) + bf_lo(SG[i]) + bf_lo(SG[i + N]);
#elif DUMP_MODE == 2
        const bf16_t* Q = (const bf16_t*)(ws + WS_Q); const bf16_t* KN = (const bf16_t*)(ws + WS_KN); const bf16_t* V = (const bf16_t*)(ws + WS_V);
        v = bf_lo(Q[i]) + bf_lo(Q[(i % ((size_t)T * 512)) + N]) + bf_lo(KN[i]) + bf_lo(V[i]);
#elif DUMP_MODE == 4
        const bf16_t* W = (const bf16_t*)(ws + WS_WD); const bf16_t* XB = (const bf16_t*)(ws + WS_XB); const float* R1 = (const float*)(ws + WS_ROPE_MLA); const float* R2 = (const float*)(ws + WS_ROPE_DIL);
        const bf16_t* W13 = (const bf16_t*)(ws + WS_W13); const bf16_t* W2 = (const bf16_t*)(ws + WS_W2); const bf16_t* PB = (const bf16_t*)(ws + WS_PB); const float* S1 = (const float*)(ws + WS_SSQ1);
        v = bf_lo(XB[i]) + R1[i % ((size_t)T * 32)] + R2[i % ((size_t)T * 16)] + bf_lo(PB[i]) + S1[i % T] * 1e-3f;
        for (int l = 0; l < 4; ++l) { const bf16_t* wl = (const bf16_t*)(ws + WS_WD + (size_t)l * WD_STRIDE); v += bf_lo(wl[i % ((size_t)5152 * 1024)]) + bf_lo(wl[(WD_Q / 2) + (i % ((size_t)5242880))]);
            for (int k = 0; k < 2; ++k) v += bf_lo(W13[(size_t)l * (W13_STRIDE / 2) + k * N + i]) + bf_lo(W2[(size_t)l * (W2_STRIDE / 2) + (k * N + i) % ((size_t)16 * 1024 * 1024)]); }
        (void)W;
#elif DUMP_MODE == 5
        const bf16_t* Y = (const bf16_t*)(ws + WS_YS);
        { const size_t row = i / 1024, c = i % 1024; v = 0.f; for (int k = 0; k < 5; ++k) v += bf_lo(Y[row * 5376 + k * 1024 + c]); }
#elif DUMP_MODE == 6
        const bf16_t* SG = (const bf16_t*)(ws + WS_SG);
        v = bf_lo(SG[i]) + bf_lo(SG[i + N]);
#elif DUMP_MODE == 7
        const bf16_t* CQ = (const bf16_t*)(ws + WS_CQ); const bf16_t* CKV = (const bf16_t*)(ws + WS_CKV);
        v = bf_lo(CQ[i % ((size_t)T * 512)]) + bf_lo(CKV[i % ((size_t)T * 256)]);
#elif DUMP_MODE == 8
        const bf16_t* DIL = (const bf16_t*)(ws + WS_DIL);
        v = bf_lo(DIL[i]) + bf_lo(DIL[i + N]) + bf_lo(DIL[(i % ((size_t)T * 256)) + 2 * N]);
#elif DUMP_MODE == 3
        const bf16_t* OA = (const bf16_t*)(ws + WS_OA); const bf16_t* OB = (const bf16_t*)(ws + WS_OB);
        v = bf_lo(OA[i]) + bf_lo(OB[i % ((size_t)T * 256)]);
#endif
        out[i] = v;
    }
}
#endif
extern "C" void kernel_launch(void* const* d_in, const int* in_sizes, int n_in, void* d_out, int out_size, void* d_ws, size_t ws_size, hipStream_t stream) {
    static int grid = 0;
    if (grid == 0) {
        if (n_in != 24 || out_size != T * DM || ws_size < WS_END) { fprintf(stderr, "kernel_launch: unexpected shapes n_in %d out %d ws %zu\n", n_in, out_size, ws_size); grid = -1; return; }
        int dev = 0, cus = 0, per_cu = 0;
        if (hipGetDevice(&dev) != hipSuccess || hipDeviceGetAttribute(&cus, hipDeviceAttributeMultiprocessorCount, dev) != hipSuccess) { grid = -1; return; }
        if (hipFuncSetAttribute((const void*)fwd_kernel, hipFuncAttributeMaxDynamicSharedMemorySize, LDS_BYTES) != hipSuccess) { fprintf(stderr, "kernel_launch: hipFuncSetAttribute failed\n"); grid = -1; return; }
        if (hipOccupancyMaxActiveBlocksPerMultiprocessor(&per_cu, (const void*)fwd_kernel, NTHR, LDS_BYTES) != hipSuccess || per_cu < 1) fprintf(stderr, "kernel_launch: occupancy query says %d\n", per_cu);
        (void)hipGetLastError();
        grid = cus;
    }
    if (grid < 0) return;
    (void)hipMemsetAsync((char*)d_ws + WS_CTL, 0, CTL_ZERO_BYTES, stream);
    Args a{};
    for (int i = 0; i < 24; ++i) a.in[i] = d_in[i];
    a.out = (float*)d_out; a.ws = (unsigned char*)d_ws;
#if MK_PER_PHASE
#ifndef RUN_PHASES
#define RUN_PHASES N_PHASES
#endif
    for (int ph = 0; ph < RUN_PHASES; ++ph) { a.ph_lo = ph; a.ph_hi = ph + 1; hipLaunchKernelGGL(fwd_kernel, dim3(grid), dim3(NTHR), LDS_BYTES, stream, a); }
#ifdef DUMP_MODE
    hipLaunchKernelGGL(dump_kernel, dim3(1024), dim3(256), 0, stream, (unsigned char*)d_ws, (float*)d_out);
#endif
#else
    a.ph_lo = 0; a.ph_hi = N_PHASES; hipLaunchKernelGGL(fwd_kernel, dim3(grid), dim3(NTHR), LDS_BYTES, stream, a);
#endif
}
```

```cpp
#include <hip/hip_runtime.h>
#include <cstdio>
#include <cstdint>

#define LAS __attribute__((address_space(3)))
#define GAS __attribute__((address_space(1)))
#define AS4 __attribute__((address_space(4)))
typedef unsigned short bf16_t;
typedef short bf16x8 __attribute__((ext_vector_type(8)));
typedef float f32x4 __attribute__((ext_vector_type(4)));
typedef float f32x2 __attribute__((ext_vector_type(2)));
typedef unsigned u32x4 __attribute__((ext_vector_type(4)));
typedef unsigned u32x2 __attribute__((ext_vector_type(2)));

#ifndef MK_PER_PHASE
#define MK_PER_PHASE 0
#endif

constexpr int T = 16384, DM = 1024, SEQ = 2048, NBATCH = 8, DEPTH = 4;
constexpr int NIN_SRC = 5152, NIN = 5376;
constexpr int NE = 64;
constexpr int MAXBLK = 192;
constexpr float EPS = 1e-6f;
constexpr int NWAVES = 8, NTHR = 512;

constexpr size_t MiB = 1u << 20, KiB = 1u << 10;
constexpr size_t WS_CTL = 0, CTL_ZERO_BYTES = 192 * KiB;
constexpr int CW_TMO = 0, CW_BAR = 4096, CW_XCT = 20480, CW_XFLAG = 20480 + 256;
constexpr size_t CTL_CNT = 128 * KiB;
static_assert(CTL_CNT + 4096 <= CTL_ZERO_BYTES, "ctl");
constexpr size_t WS_ROPE_MLA = 2 * MiB;
constexpr size_t WS_ROPE_DIL = 4 * MiB;
constexpr size_t WS_ROUTE = 5 * MiB;
constexpr size_t RT_TOK_E = WS_ROUTE;
constexpr size_t RT_TOK_W = RT_TOK_E + 128 * KiB;
constexpr size_t RT_TOK_RS = RT_TOK_W + 128 * KiB;
constexpr size_t RT_DEST = RT_TOK_RS + 64 * KiB;
constexpr size_t RT_ROW_TOK = RT_DEST + 128 * KiB;
constexpr size_t RT_ROW_W = RT_ROW_TOK + 192 * KiB;
constexpr size_t RT_ROW_RS = RT_ROW_W + 192 * KiB;
constexpr size_t RT_BLK_E = RT_ROW_RS + 192 * KiB;
constexpr size_t RT_HIST = RT_BLK_E + 4096;
constexpr size_t RT_TS = RT_HIST + 4 * 64 * 64 * 4;
constexpr size_t RT_PLE_RS = RT_TS + 1024;
static_assert(RT_PLE_RS + 64 * KiB <= 8 * MiB, "route");
constexpr size_t WS_WD = 8 * MiB, WD_STRIDE = 21 * MiB;
constexpr size_t WD_IN = 0, WD_Q = 10 * MiB + 512 * KiB, WD_K = 12 * MiB, WD_V = 12 * MiB + 512 * KiB, WD_A = 13 * MiB, WD_B = 15 * MiB,
                 WD_O = 15 * MiB + 512 * KiB, WD_R = 17 * MiB + 512 * KiB, WD_G = 18 * MiB, WD_P = 20 * MiB;
constexpr size_t WS_W13 = 92 * MiB, W13_STRIDE = 64 * MiB;
constexpr size_t WS_W2 = 348 * MiB, W2_STRIDE = 32 * MiB;
constexpr size_t WS_PB = 476 * MiB;
constexpr size_t WS_XB = 508 * MiB, WS_XN = 540 * MiB, WS_CQ = 572 * MiB, WS_CKV = 588 * MiB, WS_KPE = 596 * MiB, WS_Q = 598 * MiB,
                 WS_KN = 646 * MiB, WS_V = 678 * MiB, WS_OA = 710 * MiB, WS_OB = 742 * MiB, WS_TMPB = 750 * MiB, WS_MERGED = 750 * MiB  ,
                 WS_E = 814 * MiB, WS_RL = 846 * MiB, WS_DIL = 866 * MiB, WS_SG = 938 * MiB, WS_YS = 220 * MiB  , WS_H = 316 * MiB  , WS_OG = 782 * MiB  , WS_LSE = 806 * MiB  ,
                 WS_SSQ1 = 1002 * MiB  , WS_SSQ2 = 1007 * MiB  , WS_SSQQ = 1011 * MiB  , WS_SSQKV = 1013 * MiB  , WS_END = 1014 * MiB;

constexpr int RING_BYTES = 131072, LDSCTL_OFF = RING_BYTES, MISC_OFF = LDSCTL_OFF + 320, LDS_BYTES = 147456;
constexpr int TAB_OFF = RING_BYTES + 1024, TAB_UNITS = 8;
static_assert(TAB_OFF + TAB_UNITS * 1024 <= LDS_BYTES, "lds");

typedef __bf16 bf16x2_t __attribute__((ext_vector_type(2)));
__device__ __forceinline__ unsigned cvt_pk_bf16(float lo, float hi) { f32x2 v = {lo, hi}; bf16x2_t b = __builtin_convertvector(v, bf16x2_t); return __builtin_bit_cast(unsigned, b); }
__device__ __forceinline__ float bf_lo(unsigned w) { return __uint_as_float(w << 16); }
__device__ __forceinline__ float bf_hi(unsigned w) { return __uint_as_float(w & 0xffff0000u); }
__device__ __forceinline__ float sigmoidf_(float x) { return __builtin_amdgcn_rcpf(1.0f + __expf(-x)); }
__device__ __forceinline__ u32x4 pack8(f32x4 a, f32x4 b) { u32x4 w; w.x = cvt_pk_bf16(a[0], a[1]); w.y = cvt_pk_bf16(a[2], a[3]); w.z = cvt_pk_bf16(b[0], b[1]); w.w = cvt_pk_bf16(b[2], b[3]); return w; }
__device__ __forceinline__ void unpack8(u32x4 w, f32x4& a, f32x4& b) { a = (f32x4){bf_lo(w.x), bf_hi(w.x), bf_lo(w.y), bf_hi(w.y)}; b = (f32x4){bf_lo(w.z), bf_hi(w.z), bf_lo(w.w), bf_hi(w.w)}; }
__device__ __forceinline__ float wave_sum(float v) {
#pragma unroll
    for (int o = 1; o < 64; o <<= 1) v += __shfl_xor(v, o);
    return v;
}
template <int NP> __device__ __forceinline__ float part_sum(const float* p) { float t = 0.f;
#pragma unroll
    for (int i = 0; i < NP / 4; ++i) { const f32x4 a = *(const f32x4*)(p + 4 * i); t += (a[0] + a[1]) + (a[2] + a[3]); }
    return t; }
#define LDS_WAIT() asm volatile("s_waitcnt lgkmcnt(0)" ::: "memory")
#define VM_WAIT() asm volatile("s_waitcnt vmcnt(0)" ::: "memory")

namespace pg8 {
constexpr int BM = 256, BK = 64, HALF = 128, HTB = HALF * BK * 2, NXCD = 8, WGM = 8;
__host__ __device__ __forceinline__ int lds_byte(int r, int c) { const int st = (r >> 4) * 2 + (c >> 5), rr = r & 15, cc = c & 31, ob = rr * 64 + cc * 2; return st * 1024 + (ob ^ (((ob >> 9) & 1) << 5)); }
__host__ __device__ __forceinline__ void stage_rc(int b, int& R, int& C) { const int st = b / 1024, sb = b % 1024, swz = sb ^ (((sb >> 9) & 1) << 5); R = (st >> 1) * 16 + swz / 64; C = (st & 1) * 32 + (swz % 64) / 2; }
__host__ __device__ __forceinline__ int perm32(int rho) { const int n = rho >> 4, i = rho & 15; return 8 * (i >> 2) + 4 * n + (i & 3); }

struct Unit { int pm, pn; unsigned a_off, b_off; int ord; int halfn; };
struct Gemm { const bf16_t* A; const bf16_t* Bt; int lda, ldb, K; const int* gather; };

struct DenseOrder {
    int nM, nN, nwg, G, c, lda, ldb, narrow_pn;
    __device__ void init(int nM_, int nN_, int lda_, int ldb_, int G_, int c_, int narrow_pn_ = -1) { nM = nM_; nN = nN_; nwg = nM * nN; G = G_; c = c_; lda = lda_; ldb = ldb_; narrow_pn = narrow_pn_; }
    __device__ __forceinline__ bool next(int i, Unit& u) const {
        const long L = (long)i * G + c; if (L >= nwg) return false;
        u.ord = i; int wgid = (int)L; { const int q = nwg / NXCD, r = nwg % NXCD, xcd = wgid % NXCD, off = wgid / NXCD; wgid = (xcd < r ? xcd * (q + 1) : r * (q + 1) + (xcd - r) * q) + off; }
        const int nig = WGM * nN, gid = wgid / nig, fm = gid * WGM, gsz = (nM - fm) < WGM ? (nM - fm) : WGM;
        u.pm = fm + ((wgid % nig) % gsz); u.pn = (wgid % nig) / gsz;
        u.a_off = (unsigned)u.pm * 256u * (unsigned)lda; u.b_off = (unsigned)u.pn * 256u * (unsigned)ldb; u.halfn = (u.pn == narrow_pn) ? 1 : 0; return true;
    }
};

template <class Epi, class Sched, bool GATHER, bool ALIGN_EPI, bool HALFN = false, bool MID = false>
__device__ __forceinline__ void gemm_phase(LAS unsigned char* lds, const Gemm g, const Sched& S, const Epi& E) {
    int tid_ = threadIdx.x; asm volatile("; gemm_phase entry" : "+v"(tid_));
    const int tid = tid_, wid = __builtin_amdgcn_readfirstlane(tid >> 6), lane = tid & 63, wr = wid >> 2, wc = wid & 3, fr = lane & 15, fq = lane >> 4;
    const int K = g.K, nt = K / BK, lda = g.lda, ldb = g.ldb;
    unsigned voffB[2], vAc[2][2], vAn[2][2]; int Rst[2], Cst[2];
#pragma unroll
    for (int i = 0; i < 2; ++i) { int R, C; stage_rc(tid * 16 + i * 8192, R, C); const int Rb = (R & ~31) + perm32(R & 31);
        Rst[i] = R; Cst[i] = C; voffB[i] = (unsigned)(Rb * ldb + C) * 2u;
        vAc[0][i] = (unsigned)(R * lda + C) * 2u; vAc[1][i] = (unsigned)((R + HALF) * lda + C) * 2u; vAn[0][i] = vAc[0][i]; vAn[1][i] = vAc[1][i]; }
    const size_t kstep = (size_t)(BK * 2);
    const size_t hstepB = (size_t)HALF * ldb * 2;
    const unsigned ldsw = (unsigned)wid * 1024u;
    const int aoff = lds_byte(wr * 64 + fr, fq * 8), boff = lds_byte(wc * 32 + fr, fq * 8);
#define PG8_SA(b, h) (((b) * 2 + (h)) * HTB)
#define PG8_SB(b, h) ((4 + (b) * 2 + (h)) * HTB)
#define PG8_STAGE(bufoff, gbase, voff) do { _Pragma("unroll") for (int _i = 0; _i < 2; ++_i) \
        __builtin_amdgcn_global_load_lds((const unsigned*)((const char*)(gbase) + (voff)[_i]), (LAS unsigned*)(lds + (bufoff) + ldsw + _i * 8192), 16, 0, 0); } while (0)
#define PG8_STAGE_A(bufoff, gbase, h, nx) do { _Pragma("unroll") for (int _i = 0; _i < 2; ++_i) \
        __builtin_amdgcn_global_load_lds((const unsigned*)((const char*)(gbase) + ((GATHER && (nx)) ? vAn[h][_i] : vAc[h][_i])), (LAS unsigned*)(lds + (bufoff) + ldsw + _i * 8192), 16, 0, 0); } while (0)
#define PG8_LDA(dst, b, h) do { _Pragma("unroll") for (int m = 0; m < 4; ++m) _Pragma("unroll") for (int k = 0; k < 2; ++k) dst[m][k] = *(const LAS bf16x8*)(lds + PG8_SA(b, h) + aoff + m * 2048 + k * 1024); } while (0)
#define PG8_LDB(dst, b, h) do { _Pragma("unroll") for (int n = 0; n < 2; ++n) _Pragma("unroll") for (int k = 0; k < 2; ++k) dst[n][k] = *(const LAS bf16x8*)(lds + PG8_SB(b, h) + boff + n * 2048 + k * 1024); } while (0)
#define PG8_MMA(ai, bj, At, Bt) do { __builtin_amdgcn_s_setprio(1); _Pragma("unroll") for (int m = 0; m < 4; ++m) _Pragma("unroll") for (int n = 0; n < 2; ++n) _Pragma("unroll") for (int k = 0; k < 2; ++k) \
        acc[ai][bj][m][n] = __builtin_amdgcn_mfma_f32_16x16x32_bf16(Bt[n][k], At[m][k], acc[ai][bj][m][n], 0, 0, 0); __builtin_amdgcn_s_setprio(0); } while (0)
#define PG8_WAIT_V(n) asm volatile("s_waitcnt vmcnt(" #n ")" ::: "memory")
#define PG8_WAIT_L(n) asm volatile("s_waitcnt lgkmcnt(" #n ")" ::: "memory")
#define PG8_BAR __builtin_amdgcn_s_barrier()
#define PG8_SCHED __builtin_amdgcn_sched_barrier(0)
    Unit cur, nxt; int ui = 0;
    if (!S.next(0, cur)) return;
    if constexpr (GATHER) {
#pragma unroll
        for (int h = 0; h < 2; ++h)
#pragma unroll
            for (int i = 0; i < 2; ++i) vAc[h][i] = (unsigned)(g.gather[cur.pm * 256 + h * HALF + Rst[i]] * lda + Cst[i]) * 2u;
    }
    f32x4 acc[2][2][4][2];
#pragma unroll
    for (int a = 0; a < 2; ++a)
#pragma unroll
        for (int b = 0; b < 2; ++b)
#pragma unroll
            for (int m = 0; m < 4; ++m)
#pragma unroll
                for (int n = 0; n < 2; ++n) acc[a][b][m][n] = (f32x4){0.f, 0.f, 0.f, 0.f};
    bf16x8 At[4][2], B0[2][2], B1[2][2];
    const char* cA = (const char*)g.A + (size_t)cur.a_off * 2; const char* cB = (const char*)g.Bt + (size_t)cur.b_off * 2;
    PG8_STAGE(PG8_SB(0, 0), cB, voffB); PG8_STAGE(PG8_SB(0, 1), cB + hstepB, voffB); PG8_STAGE_A(PG8_SA(0, 0), cA, 0, false); PG8_STAGE_A(PG8_SA(0, 1), cA, 1, false);
    if (wr == 1) PG8_BAR;
    PG8_WAIT_V(2); PG8_BAR;
    PG8_STAGE(PG8_SB(1, 0), cB + kstep, voffB); PG8_STAGE_A(PG8_SA(1, 0), cA + kstep, 0, false); PG8_STAGE(PG8_SB(1, 1), cB + hstepB + kstep, voffB);
    PG8_WAIT_V(6); PG8_BAR;
    for (;;) {
        const bool has_next = S.next(ui + 1, nxt);
        const char* nA = has_next ? (const char*)g.A + (size_t)nxt.a_off * 2 : cA; const char* nB = has_next ? (const char*)g.Bt + (size_t)nxt.b_off * 2 : cB;
        if constexpr (GATHER) {
#pragma unroll
            for (int h = 0; h < 2; ++h)
#pragma unroll
                for (int i = 0; i < 2; ++i) vAn[h][i] = has_next ? (unsigned)(g.gather[nxt.pm * 256 + h * HALF + Rst[i]] * lda + Cst[i]) * 2u : vAc[h][i];
        }
        const bool hn = HALFN && cur.halfn != 0;
#pragma unroll 1
        for (int t = 0; t < nt; t += 2) {
            const bool last = (t == nt - 2);
            const char* a1 = cA + (size_t)(t + 1) * kstep;
            const char* a2 = last ? nA : cA + (size_t)(t + 2) * kstep; const char* b2 = last ? nB : cB + (size_t)(t + 2) * kstep;
            const char* a3 = a2 + kstep; const char* b3 = b2 + kstep;
            PG8_LDB(B0, 0, 0); if (!hn) PG8_LDB(B1, 0, 1); PG8_SCHED; PG8_LDA(At, 0, 0); PG8_STAGE_A(PG8_SA(1, 1), a1, 1, false);
            PG8_WAIT_V(8); PG8_WAIT_L(0); PG8_BAR; PG8_MMA(0, 0, At, B0); if (!hn) PG8_MMA(0, 1, At, B1); PG8_BAR; PG8_SCHED;
            PG8_LDA(At, 0, 1); PG8_STAGE(PG8_SB(0, 0), b2, voffB); PG8_STAGE(PG8_SB(0, 1), b2 + hstepB, voffB); PG8_STAGE_A(PG8_SA(0, 0), a2, 0, last);
            PG8_WAIT_V(8); PG8_WAIT_L(0); PG8_BAR; PG8_MMA(1, 0, At, B0); if (!hn) PG8_MMA(1, 1, At, B1); PG8_BAR; PG8_SCHED;
            PG8_LDB(B0, 1, 0); if (!hn) PG8_LDB(B1, 1, 1); PG8_SCHED; PG8_LDA(At, 1, 0); PG8_STAGE_A(PG8_SA(0, 1), a2, 1, last);
            PG8_WAIT_V(8); PG8_WAIT_L(0); PG8_BAR; PG8_MMA(0, 0, At, B0); if (!hn) PG8_MMA(0, 1, At, B1); PG8_BAR; PG8_SCHED;
            PG8_LDA(At, 1, 1); PG8_STAGE(PG8_SB(1, 0), b3, voffB); PG8_STAGE(PG8_SB(1, 1), b3 + hstepB, voffB); PG8_STAGE_A(PG8_SA(1, 0), a3, 0, last);
            PG8_WAIT_V(8); PG8_WAIT_L(0); PG8_BAR; PG8_MMA(1, 0, At, B0); if (!hn) PG8_MMA(1, 1, At, B1); PG8_BAR; PG8_SCHED;
            if constexpr (MID) { if (t == 2) E.mid(acc, cur, wr, wc, fr, fq); }
        }
        if constexpr (ALIGN_EPI) { if (wr == 0) PG8_BAR; }
        { int fr_ = fr, fq_ = fq, wr_ = wr, wc_ = wc; asm volatile("; epilogue entry" : "+v"(fr_), "+v"(fq_)); asm volatile("" : "+s"(wr_), "+s"(wc_));
          E(acc, cur, wr_, wc_, fr_, fq_); }
        if (!has_next) break;
#pragma unroll
        for (int a = 0; a < 2; ++a)
#pragma unroll
            for (int b = 0; b < 2; ++b)
#pragma unroll
                for (int m = 0; m < 4; ++m)
#pragma unroll
                    for (int n = 0; n < 2; ++n) acc[a][b][m][n] = (f32x4){0.f, 0.f, 0.f, 0.f};
        cur = nxt; cA = nA; cB = nB; ++ui;
        if constexpr (GATHER) {
#pragma unroll
            for (int h = 0; h < 2; ++h)
#pragma unroll
                for (int i = 0; i < 2; ++i) vAc[h][i] = vAn[h][i];
        }
        if constexpr (ALIGN_EPI) { if (wr == 1) PG8_BAR; }
    }
    PG8_WAIT_V(0);
    if constexpr (!ALIGN_EPI) { if (wr == 0) PG8_BAR; }
    PG8_BAR;
#undef PG8_SA
#undef PG8_SB
#undef PG8_STAGE
#undef PG8_STAGE_A
#undef PG8_LDA
#undef PG8_LDB
#undef PG8_MMA
#undef PG8_WAIT_V
#undef PG8_WAIT_L
#undef PG8_BAR
#undef PG8_SCHED
}
}
using pg8::Unit;

#define XB_TMO      128
#define XB_XCNT(j)  (256  + 64 * (j))
#define XB_XSUB(j)  (1280 + 64 * (j))
#define XB_XGEN(j)  (2304 + 64 * (j))
#define XB_TOP      3328
#define XB_TOPGEN   3392
#define XCD_BAR_WORDS 3456
#define XB_SPIN_CAP (1u << 18)
__device__ __forceinline__ unsigned xb_ld(unsigned* p)              { return __hip_atomic_load(p, __ATOMIC_RELAXED, __HIP_MEMORY_SCOPE_AGENT); }
__device__ __forceinline__ unsigned xb_add(unsigned* p, unsigned v) { return __hip_atomic_fetch_add(p, v, __ATOMIC_RELAXED, __HIP_MEMORY_SCOPE_AGENT); }
__device__ __forceinline__ unsigned xb_xcc_id() { return (unsigned)__builtin_amdgcn_s_getreg((3 << 11) | 20) & 0xFu; }
#define XB_SPIN(cond, bar) do { unsigned _sp = 0; while (cond) { __builtin_amdgcn_s_sleep(1); \
    if ((++_sp & 255u) == 0u) { if (xb_ld(&(bar)[XB_TMO])) break; if (_sp > XB_SPIN_CAP) { atomicAdd(&(bar)[XB_TMO], 1u); break; } } } } while (0)
struct XcdBarrier { unsigned* bar; unsigned x; volatile LAS unsigned* st; };
__device__ __forceinline__ XcdBarrier xcd_barrier_post(unsigned* bar, volatile LAS unsigned* st) {
    XcdBarrier b; b.bar = bar; b.x = xb_xcc_id(); b.st = st;
    if (threadIdx.x == 0) (void)xb_add(&bar[XB_XCNT(b.x)], 1u);
    return b;
}
__device__ __forceinline__ void xcd_barrier_complete(unsigned* bar, unsigned x, unsigned& nloc, unsigned& nx) {
    const unsigned G = gridDim.x * gridDim.y * gridDim.z;
    unsigned sum, cnt, mine, sp = 0u;
    for (;;) {
        sum = 0u; cnt = 0u; mine = 0u;
#pragma unroll
        for (unsigned j = 0; j < 16; ++j) { const unsigned c = xb_ld(&bar[XB_XCNT(j)]); sum += c; cnt += (c > 0u) ? 1u : 0u; mine = (j == x) ? c : mine; }
        if (sum == G) break;
        __builtin_amdgcn_s_sleep(1);
        if ((++sp & 255u) == 0u) { if (xb_ld(&bar[XB_TMO])) break; if (sp > XB_SPIN_CAP) { atomicAdd(&bar[XB_TMO], 1u); break; } }
    }
    nloc = mine > 0u ? mine : 1u; nx = cnt > 0u ? cnt : 1u;
}
__device__ __forceinline__ void xcd_barrier(const XcdBarrier& b) {
    asm volatile("s_waitcnt vmcnt(0)" ::: "memory");
    __syncthreads();
    if (threadIdx.x == 0) {
        unsigned* bar = b.bar;
        __builtin_amdgcn_s_waitcnt(0);
        unsigned nloc = b.st[0], nx = b.st[1];
        if (nloc == 0u) { xcd_barrier_complete(bar, b.x, nloc, nx); b.st[0] = nloc; b.st[1] = nx; }
        const unsigned old = xb_add(&bar[XB_XSUB(b.x)], 1u);
        const unsigned gen = old / nloc;
        if (old + 1u == (gen + 1u) * nloc) {
            __builtin_amdgcn_fence(__ATOMIC_RELEASE, "agent");
            asm volatile("s_waitcnt vmcnt(0)" ::: "memory");
            __builtin_amdgcn_fence(__ATOMIC_ACQUIRE, "agent");
            const unsigned og = xb_add(&bar[XB_TOP], 1u);
            const unsigned tg = og / nx;
            if (og + 1u == (tg + 1u) * nx) xb_add(&bar[XB_TOPGEN], 1u);
            else XB_SPIN(xb_ld(&bar[XB_TOPGEN]) == tg, bar);
            xb_add(&bar[XB_XGEN(b.x)], 1u);
            asm volatile("s_waitcnt vmcnt(0)" ::: "memory");
        } else {
            __builtin_amdgcn_fence(__ATOMIC_ACQUIRE, "agent");
            XB_SPIN(xb_ld(&bar[XB_XGEN(b.x)]) == gen, bar);
            asm volatile("s_waitcnt vmcnt(0)" ::: "memory");
        }
    }
    __syncthreads();
}

__device__ __forceinline__ void xcd_barrier_local(const XcdBarrier& b) {
    asm volatile("s_waitcnt vmcnt(0)" ::: "memory");
    __syncthreads();
    if (threadIdx.x == 0) {
        unsigned* bar = b.bar;
        __builtin_amdgcn_s_waitcnt(0);
        unsigned nloc = b.st[0], nx = b.st[1];
        if (nloc == 0u) { xcd_barrier_complete(bar, b.x, nloc, nx); b.st[0] = nloc; b.st[1] = nx; }
        const unsigned old = xb_add(&bar[XB_XSUB(b.x)], 1u);
        const unsigned gen = old / nloc;
        if (old + 1u == (gen + 1u) * nloc) {
            xb_add(&bar[XB_XGEN(b.x)], 1u);
            __builtin_amdgcn_fence(__ATOMIC_ACQUIRE, "agent");
            asm volatile("s_waitcnt vmcnt(0)" ::: "memory");
        } else {
            __builtin_amdgcn_fence(__ATOMIC_ACQUIRE, "agent");
            XB_SPIN(xb_ld(&bar[XB_XGEN(b.x)]) == gen, bar);
            asm volatile("s_waitcnt vmcnt(0)" ::: "memory");
        }
    }
    __syncthreads();
}

struct Args { const void* in[24]; float* out; unsigned char* ws; int ph_lo, ph_hi; };

struct Frame {
    LAS unsigned char* lds;
    int tid, lane, wave, vcu, G; float diag_scale;
    unsigned char* ws;
    float* X;
};

__device__ __forceinline__ int rl_first(const Frame& F) { return F.G == 256 ? (F.vcu >> 5) * 2048 + (F.vcu & 31) * 8 + F.wave : F.vcu * NWAVES + F.wave; }
__device__ __forceinline__ int rl_step(const Frame& F) { return F.G == 256 ? 256 : F.G * NWAVES; }
__device__ __forceinline__ int rl_end(const Frame& F) { return F.G == 256 ? (F.vcu >> 5) * 2048 + 2048 : T; }
#define EPI_ROW(ai, m) (u.pm * 256 + (ai) * 128 + wr * 64 + (m) * 16 + fr)
#define EPI_FOR_ROWS _Pragma("unroll") for (int ai = 0; ai < 2; ++ai) _Pragma("unroll") for (int m = 0; m < 4; ++m)

#define ROWI(it) (u.pm * 256 + ((it) >> 2) * 128 + wr * 64 + ((it) & 3) * 16 + fr)
#define TABI(it) (u.ord * 256 + ((it) >> 2) * 128 + wr * 64 + ((it) & 3) * 16 + fr)
#define SCHED_FENCE() __builtin_amdgcn_sched_barrier(0)
template <class Sched, class Fn> __device__ __forceinline__ void fill_tab(Frame& F, const Sched& S, const Fn& f) {
    LAS float* tab = (LAS float*)(F.lds + TAB_OFF); Unit u;
    for (int i = F.wave >> 2; i < TAB_UNITS && S.next(i, u); i += 2) { const int r = F.tid & 255; tab[i * 256 + r] = f(u.pm * 256 + r); }
    __syncthreads();
}
template <int XM> __device__ __forceinline__ void rope8(f32x4 (&v)[2], const f32x4 (&cs)[4], bool is_lo, bool is_rot) {
    const float sgn = is_lo ? -1.f : 1.f;
#pragma unroll
    for (int n = 0; n < 2; ++n)
#pragma unroll
        for (int e = 0; e < 4; ++e) { const int j = 4 * n + e; const float c = cs[j >> 1][(j & 1) * 2], sn = cs[j >> 1][(j & 1) * 2 + 1];
            const float mine = v[n][e], oth = __shfl_xor(mine, XM) * sgn; const float r = mine * c + oth * sn; v[n][e] = is_rot ? r : mine; }
}
struct EpiInProj {
    bf16_t *CQ, *CKV, *KPE, *DIL, *SG; float *ssq_q, *ssq_kv; const f32x2* rope_dil; const f32x2* rope_mla; const LAS float* tab;
    __device__ __forceinline__ void operator()(const f32x4 (&acc)[2][2][4][2], const Unit& u, int wr, int wc, int fr, int fq) const {
        const int pn = u.pn;
        float rsv[8];
#pragma unroll
        for (int it = 0; it < 8; ++it) rsv[it] = tab[TABI(it)];
        if (pn < 3) {
            bf16_t* dst = pn < 2 ? CQ : CKV; const int ld = pn < 2 ? 512 : 256; const int cb = (pn == 1 ? 256 : 0) + wc * 32 + 8 * fq; float* sq = pn < 2 ? ssq_q : ssq_kv;
#pragma unroll
            for (int it = 0; it < 8; ++it) { const int row = ROWI(it); const float rs = rsv[it]; float s = 0.f;
#pragma unroll
                for (int bj = 0; bj < 2; ++bj) { const f32x4 v0 = acc[it >> 2][bj][it & 3][0] * rs, v1 = acc[it >> 2][bj][it & 3][1] * rs;
                    s += (v0[0] * v0[0] + v0[1] * v0[1]) + (v0[2] * v0[2] + v0[3] * v0[3]) + (v1[0] * v1[0] + v1[1] * v1[1]) + (v1[2] * v1[2] + v1[3] * v1[3]);
                    *(u32x4*)(dst + (size_t)row * ld + cb + bj * 128) = pack8(v0, v1); }
                s += __shfl_xor(s, 16); s += __shfl_xor(s, 32);
                if (fq == 0) { if (pn < 2) sq[(size_t)row * 8 + pn * 4 + wc] = s; else sq[(size_t)row * 4 + wc] = s; } }
        } else if (pn < 12) {
            const int t = pn - 3, kind = t % 3; const bool rope = (kind < 2) && ((wc & 1) == 0);
            const int cb = t * 256 + wc * 32 + 8 * fq;
            f32x4 cs[2][4];
            if (rope) {
#pragma unroll
                for (int j = 0; j < 4; ++j) cs[0][j] = *(const f32x4*)(rope_dil + (size_t)ROWI(0) * 8 + 2 * j);
            }
            const float qsc = kind == 0 ? 0.18033688f : 1.0f;
#pragma unroll
            for (int it = 0; it < 8; ++it) { const int row = ROWI(it); const float rs = rsv[it] * qsc;
                if (rope && it < 7) {
#pragma unroll
                    for (int j = 0; j < 4; ++j) cs[(it + 1) & 1][j] = *(const f32x4*)(rope_dil + (size_t)ROWI(it + 1) * 8 + 2 * j);
                    SCHED_FENCE();
                }
#pragma unroll
                for (int bj = 0; bj < 2; ++bj) { f32x4 v[2] = {acc[it >> 2][bj][it & 3][0] * rs, acc[it >> 2][bj][it & 3][1] * rs};
                    if (rope) rope8<16>(v, cs[it & 1], fq == 0, fq < 2);
                    *(u32x4*)(DIL + (size_t)row * 2304 + cb + bj * 128) = pack8(v[0], v[1]); } }
        } else if (pn < 20) {
            const int cb = (pn - 12) * 256 + wc * 32 + 8 * fq;
#pragma unroll
            for (int it = 0; it < 8; ++it) { const int row = ROWI(it); const float rs = rsv[it];
#pragma unroll
                for (int bj = 0; bj < 2; ++bj) { f32x4 v0 = acc[it >> 2][bj][it & 3][0] * rs, v1 = acc[it >> 2][bj][it & 3][1] * rs;
#pragma unroll
                    for (int e = 0; e < 4; ++e) { v0[e] = sigmoidf_(v0[e]); v1[e] = sigmoidf_(v1[e]); }
                    *(u32x4*)(SG + (size_t)row * 2048 + cb + bj * 128) = pack8(v0, v1); } }
        } else {
            if (wc == 0) {
                const int jb = 8 * (fq & 1);
                f32x4 cs[2][4];
#pragma unroll
                for (int j = 0; j < 4; ++j) cs[0][j] = *(const f32x4*)(rope_mla + (size_t)ROWI(0) * 16 + jb + 2 * j);
#pragma unroll
                for (int it = 0; it < 8; ++it) { const int row = ROWI(it); const float rs = rsv[it];
                    if (it < 7) {
#pragma unroll
                        for (int j = 0; j < 4; ++j) cs[(it + 1) & 1][j] = *(const f32x4*)(rope_mla + (size_t)ROWI(it + 1) * 16 + jb + 2 * j);
                        SCHED_FENCE();
                    }
                    f32x4 v[2] = {acc[it >> 2][0][it & 3][0] * rs, acc[it >> 2][0][it & 3][1] * rs};
                    rope8<32>(v, cs[it & 1], fq < 2, true);
                    *(u32x4*)(KPE + (size_t)row * 32 + 8 * fq) = pack8(v[0], v[1]); }
            }
        }
    }
};

struct EpiQup {
    bf16_t* Q; const f32x2* rope_mla; const LAS float* tab;
    __device__ __forceinline__ void operator()(const f32x4 (&acc)[2][2][4][2], const Unit& u, int wr, int wc, int fr, int fq) const {
        float rsv[8];
#pragma unroll
        for (int it = 0; it < 8; ++it) rsv[it] = tab[TABI(it)] * 0.14724353f;
        const int jb = 8 * (fq & 1); const bool r0 = ((u.pn * 8 + wc) % 3) == 2, r1 = ((u.pn * 8 + 4 + wc) % 3) == 2, anyr = r0 || r1;
        f32x4 cs[2][4];
        if (anyr) {
#pragma unroll
            for (int j = 0; j < 4; ++j) cs[0][j] = *(const f32x4*)(rope_mla + (size_t)ROWI(0) * 16 + jb + 2 * j);
        }
#pragma unroll
        for (int it = 0; it < 8; ++it) { const int row = ROWI(it); const float rs = rsv[it];
            if (anyr && it < 7) {
#pragma unroll
                for (int j = 0; j < 4; ++j) cs[(it + 1) & 1][j] = *(const f32x4*)(rope_mla + (size_t)ROWI(it + 1) * 16 + jb + 2 * j);
                SCHED_FENCE();
            }
#pragma unroll
            for (int bj = 0; bj < 2; ++bj) { f32x4 v[2] = {acc[it >> 2][bj][it & 3][0] * rs, acc[it >> 2][bj][it & 3][1] * rs};
                if (bj == 0 ? r0 : r1) rope8<32>(v, cs[it & 1], fq < 2, true);
                *(u32x4*)(Q + (size_t)row * 1536 + u.pn * 256 + bj * 128 + wc * 32 + 8 * fq) = pack8(v[0], v[1]); } }
    }
};

struct EpiScaleStore {
    const LAS float* tab; bf16_t* O; int ld; bf16_t* O2; int split;
    __device__ __forceinline__ void operator()(const f32x4 (&acc)[2][2][4][2], const Unit& u, int wr, int wc, int fr, int fq) const {
        bf16_t* dst = (O2 && u.pn >= split) ? O2 + (u.pn - split) * 256 : O + u.pn * 256;
#pragma unroll
        for (int it = 0; it < 8; ++it) { const int row = ROWI(it); const float rs = tab ? tab[TABI(it)] : 1.0f;
#pragma unroll
            for (int bj = 0; bj < 2; ++bj) *(u32x4*)(dst + (size_t)row * ld + bj * 128 + wc * 32 + 8 * fq) = pack8(acc[it >> 2][bj][it & 3][0] * rs, acc[it >> 2][bj][it & 3][1] * rs); }
    }
};

template <int MODE> struct EpiGate {
    const bf16_t* G; int goff; const bf16_t* ADD; bf16_t* O;
    __device__ __forceinline__ void operator()(const f32x4 (&acc)[2][2][4][2], const Unit& u, int wr, int wc, int fr, int fq) const {
        const int colb = u.pn * 256 + wc * 32 + 8 * fq;
        u32x4 gb[2], ab[2];
        gb[0] = *(const u32x4*)(G + (size_t)ROWI(0) * 2048 + goff + colb); if (MODE == 1) ab[0] = *(const u32x4*)(ADD + (size_t)ROWI(0) * 1024 + colb);
#pragma unroll
        for (int s2 = 0; s2 < 16; ++s2) { const int it = s2 >> 1, bj = s2 & 1, row = ROWI(it), col = colb + bj * 128;
            if (s2 < 15) { const int nrow = ROWI((s2 + 1) >> 1), ncol = colb + ((s2 + 1) & 1) * 128;
                gb[(s2 + 1) & 1] = *(const u32x4*)(G + (size_t)nrow * 2048 + goff + ncol); if (MODE == 1) ab[(s2 + 1) & 1] = *(const u32x4*)(ADD + (size_t)nrow * 1024 + ncol);
                SCHED_FENCE(); }
            f32x4 g0, g1; unpack8(gb[s2 & 1], g0, g1);
            f32x4 v0 = acc[it >> 2][bj][it & 3][0] * g0, v1 = acc[it >> 2][bj][it & 3][1] * g1;
            if (MODE == 1) { f32x4 a0, a1; unpack8(ab[s2 & 1], a0, a1); v0 += a0; v1 += a1; }
            *(u32x4*)(O + (size_t)row * 1024 + col) = pack8(v0, v1); }
    }
};

struct EpiGateFused {
    const bf16_t* G; bf16_t* O;
    __device__ __forceinline__ void mid(f32x4 (&acc)[2][2][4][2], const Unit& u, int wr, int wc, int fr, int fq) const {
        const int colb = u.pn * 256 + wc * 32 + 8 * fq;
        u32x4 ga[2], gb[2];
        ga[0] = *(const u32x4*)(G + (size_t)ROWI(0) * 2048 + colb); gb[0] = *(const u32x4*)(G + (size_t)ROWI(0) * 2048 + 1024 + colb);
#pragma unroll
        for (int s2 = 0; s2 < 16; ++s2) { const int it = s2 >> 1, bj = s2 & 1;
            if (s2 < 15) { const int nrow = ROWI((s2 + 1) >> 1), ncol = colb + ((s2 + 1) & 1) * 128;
                ga[(s2 + 1) & 1] = *(const u32x4*)(G + (size_t)nrow * 2048 + ncol); gb[(s2 + 1) & 1] = *(const u32x4*)(G + (size_t)nrow * 2048 + 1024 + ncol);
                SCHED_FENCE(); }
            f32x4 a0, a1, b0, b1; unpack8(ga[s2 & 1], a0, a1); unpack8(gb[s2 & 1], b0, b1);
#pragma unroll
            for (int e = 0; e < 4; ++e) { b0[e] *= __builtin_amdgcn_rcpf(fmaxf(a0[e], 1e-30f)); b1[e] *= __builtin_amdgcn_rcpf(fmaxf(a1[e], 1e-30f)); }
            acc[it >> 2][bj][it & 3][0] *= b0; acc[it >> 2][bj][it & 3][1] *= b1; }
    }
    __device__ __forceinline__ void operator()(const f32x4 (&acc)[2][2][4][2], const Unit& u, int wr, int wc, int fr, int fq) const {
        const int colb = u.pn * 256 + wc * 32 + 8 * fq;
        u32x4 ga[2];
        ga[0] = *(const u32x4*)(G + (size_t)ROWI(0) * 2048 + colb);
#pragma unroll
        for (int s2 = 0; s2 < 16; ++s2) { const int it = s2 >> 1, bj = s2 & 1, row = ROWI(it), col = colb + bj * 128;
            if (s2 < 15) { const int nrow = ROWI((s2 + 1) >> 1), ncol = colb + ((s2 + 1) & 1) * 128; ga[(s2 + 1) & 1] = *(const u32x4*)(G + (size_t)nrow * 2048 + ncol); SCHED_FENCE(); }
            f32x4 a0, a1; unpack8(ga[s2 & 1], a0, a1);
            *(u32x4*)(O + (size_t)row * 1024 + col) = pack8(acc[it >> 2][bj][it & 3][0] * a0, acc[it >> 2][bj][it & 3][1] * a1); }
    }
};

template <int MODE> struct EpiResid {
    bf16_t* XB; float* ssq; const bf16_t* Eb; const bf16_t* XS; const LAS float* tab;
    __device__ __forceinline__ void operator()(const f32x4 (&acc)[2][2][4][2], const Unit& u, int wr, int wc, int fr, int fq) const {
        const int colb = u.pn * 256 + wc * 32 + 8 * fq;
        u32x4 xw[2], eb[2];
        xw[0] = *(const u32x4*)(XS + (size_t)ROWI(0) * 1024 + colb); if (MODE == 1) eb[0] = *(const u32x4*)(Eb + (size_t)ROWI(0) * 1024 + colb);
        float s = 0.f;
#pragma unroll
        for (int s2 = 0; s2 < 16; ++s2) { const int it = s2 >> 1, bj = s2 & 1, row = ROWI(it), col = colb + bj * 128;
            if (s2 < 15) { const int nrow = ROWI((s2 + 1) >> 1), ncol = colb + ((s2 + 1) & 1) * 128;
                xw[(s2 + 1) & 1] = *(const u32x4*)(XS + (size_t)nrow * 1024 + ncol); if (MODE == 1) eb[(s2 + 1) & 1] = *(const u32x4*)(Eb + (size_t)nrow * 1024 + ncol);
                SCHED_FENCE(); }
            f32x4 x0, x1; unpack8(xw[s2 & 1], x0, x1);
            f32x4 d0 = acc[it >> 2][bj][it & 3][0], d1 = acc[it >> 2][bj][it & 3][1];
            if (MODE == 1) { f32x4 e0, e1; unpack8(eb[s2 & 1], e0, e1); const float rs = tab[TABI(it)];
#pragma unroll
                for (int e = 0; e < 4; ++e) { d0[e] = sigmoidf_(d0[e] * rs) * e0[e]; d1[e] = sigmoidf_(d1[e] * rs) * e1[e]; } }
            x0 += d0; x1 += d1;
            *(u32x4*)(XB + (size_t)row * 1024 + col) = pack8(x0, x1);
            s += (x0[0] * x0[0] + x0[1] * x0[1]) + (x0[2] * x0[2] + x0[3] * x0[3]) + (x1[0] * x1[0] + x1[1] * x1[1]) + (x1[2] * x1[2] + x1[3] * x1[3]);
            if (bj == 1) { s += __shfl_xor(s, 16); s += __shfl_xor(s, 32); if (fq == 0) ssq[(size_t)row * 16 + u.pn * 4 + wc] = s; s = 0.f; } }
    }
};

struct EpiRouter {
    float* RL;
    __device__ __forceinline__ void operator()(const f32x4 (&acc)[2][2][4][2], const Unit& u, int wr, int wc, int fr, int fq) const {
        const int c0 = wc * 32 + 8 * fq;
        if (c0 < 72) {
#pragma unroll
            for (int it = 0; it < 8; ++it) { const int row = ROWI(it); float* p = RL + (size_t)row * 72 + c0;
                *(f32x4*)p = acc[it >> 2][0][it & 3][0]; *(f32x4*)(p + 4) = acc[it >> 2][0][it & 3][1]; }
        }
    }
};

struct EpiExp1 {
    const LAS float* tab; bf16_t* H;
    __device__ __forceinline__ void operator()(const f32x4 (&acc)[2][2][4][2], const Unit& u, int wr, int wc, int fr, int fq) const {
#pragma unroll
        for (int it = 0; it < 8; ++it) { const int row = ROWI(it); const float rs = tab[TABI(it)];
            f32x4 h[2];
#pragma unroll
            for (int n = 0; n < 2; ++n)
#pragma unroll
                for (int e = 0; e < 4; ++e) { const float gt = acc[it >> 2][0][it & 3][n][e] * rs, up = acc[it >> 2][1][it & 3][n][e] * rs; h[n][e] = gt * sigmoidf_(gt) * up; }
            *(u32x4*)(H + (size_t)row * 256 + u.pn * 128 + wc * 32 + 8 * fq) = pack8(h[0], h[1]); }
    }
};
struct EpiExp2 {
    const LAS float* tab; bf16_t* YS;
    __device__ __forceinline__ void operator()(const f32x4 (&acc)[2][2][4][2], const Unit& u, int wr, int wc, int fr, int fq) const {
#pragma unroll
        for (int it = 0; it < 8; ++it) { const int row = ROWI(it); const float w = tab[TABI(it)];
#pragma unroll
            for (int bj = 0; bj < 2; ++bj) *(u32x4*)(YS + (size_t)row * 1024 + u.pn * 256 + bj * 128 + wc * 32 + 8 * fq) = pack8(acc[it >> 2][bj][it & 3][0] * w, acc[it >> 2][bj][it & 3][1] * w); }
    }
};

struct RouterOrder {
    int G, c;
    __device__ __forceinline__ bool next(int i, Unit& u) const { const int L = i * G + c; if (L >= 256) return false;
        u.ord = i; u.pm = L >> 2; u.pn = L & 3; u.a_off = (unsigned)u.pm * 256u * 1024u + (unsigned)u.pn * 256u; u.b_off = (unsigned)u.pn * 256u; return true; }
};
struct RouterFullOrder {
    int G, c;
    __device__ __forceinline__ bool next(int i, Unit& u) const { int L; if (G == 256) { if (i > 0 || c >= 64) return false; L = c; } else { L = i * G + c; if (L >= 64) return false; }
        u.ord = i; u.halfn = 1; u.pm = L; u.pn = 0; u.a_off = (unsigned)L * 256u * 1024u; u.b_off = 0u; return true; }
};
struct PleProjOrder {
    int G, c;
    __device__ __forceinline__ bool next(int i, Unit& u) const { int L; if (G == 256) { if (c < 64) return false; L = i * 192 + (c - 64); } else L = i * G + c; if (L >= 256) return false;
        u.ord = i; u.halfn = 0; u.pm = L >> 2; u.pn = L & 3; u.a_off = (unsigned)u.pm * 256u * 256u; u.b_off = (unsigned)u.pn * 256u * 256u; return true; }
};
template <int NJ> struct BlockUnits {
    const int* blk_e; int blk;
    __device__ __forceinline__ bool next(int i, Unit& u) const { if (i >= NJ) return false; const int e = blk_e[blk]; u.pm = blk; u.pn = i; u.ord = i; u.halfn = 0;
        if (NJ == 2) { u.a_off = 0u; u.b_off = (unsigned)(e * 512 + i * 256) * 1024u; } else { u.a_off = (unsigned)blk * 256u * 256u; u.b_off = (unsigned)(e * 1024 + i * 256) * 256u; }
        return true; }
};
struct PleProjRange {
    int rank, cnt;
    __device__ __forceinline__ bool next(int i, Unit& u) const { if (rank < 0) return false; const int L = i * cnt + rank; if (L >= 256) return false;
        u.ord = i; u.halfn = 0; u.pm = L >> 2; u.pn = L & 3; u.a_off = (unsigned)u.pm * 256u * 256u; u.b_off = (unsigned)u.pn * 256u * 256u; return true; }
};
template <int NJ> struct ExpertOrder {
    const int* blk_e; int G, c;
    __device__ __forceinline__ bool next(int i, Unit& u) const { const int nblk = blk_e[255]; const int L = i * G + c; if (L >= nblk * NJ) return false;
        const int blk = L / NJ, j = L % NJ, e = blk_e[blk]; u.pm = blk; u.pn = j; u.ord = i; u.halfn = 0;
        if (NJ == 2) { u.a_off = 0u; u.b_off = (unsigned)(e * 512 + j * 256) * 1024u; } else { u.a_off = (unsigned)blk * 256u * 256u; u.b_off = (unsigned)(e * 1024 + j * 256) * 256u; }
        return true; }
};

__device__ __forceinline__ void tr_load(float (&v)[32], const float* W, int ldw, int n_src0, int k0, int lane) {
    asm volatile("" : "+v"(lane));
    const GAS float* wp = (const GAS float*)(W + (size_t)(k0 + (lane >> 5)) * ldw + n_src0 + (lane & 31));
#pragma unroll
    for (int i = 0; i < 32; ++i) { v[i] = __builtin_nontemporal_load(wp); wp += 2 * ldw; asm volatile("" : "+v"(wp)); }
}
__device__ __forceinline__ void tr_store(const float (&v)[32], const float* g, bf16_t* WT, int K, int n_dst0, int k0, LAS float* scr, int lane) {
    asm volatile("" : "+v"(lane));
    const int c = lane & 7;
    f32x4 g0 = {1.f, 1.f, 1.f, 1.f}, g1 = g0;
    if (g) { g0 = *(const f32x4*)(g + k0 + 8 * c); g1 = *(const f32x4*)(g + k0 + 8 * c + 4); }
#pragma unroll
    for (int i = 0; i < 32; ++i) scr[(2 * i + (lane >> 5)) * 33 + (lane & 31)] = v[i];
    LDS_WAIT(); asm volatile("" ::: "memory");
#pragma unroll
    for (int j = 0; j < 4; ++j) { const int n = (lane >> 3) + 8 * j; const LAS float* s = scr + (8 * c) * 33 + n;
        u32x4 o; o.x = cvt_pk_bf16(s[0 * 33] * g0[0], s[1 * 33] * g0[1]); o.y = cvt_pk_bf16(s[2 * 33] * g0[2], s[3 * 33] * g0[3]); o.z = cvt_pk_bf16(s[4 * 33] * g1[0], s[5 * 33] * g1[1]); o.w = cvt_pk_bf16(s[6 * 33] * g1[2], s[7 * 33] * g1[3]);
        *(u32x4*)(WT + (size_t)(n_dst0 + n) * K + k0 + 8 * c) = o; }
    LDS_WAIT(); asm volatile("" ::: "memory");
}
__device__ __forceinline__ void tr_item(const float* W, int ldw, int n_src0, const float* g, bf16_t* WT, int K, int n_dst0, int k0, LAS float* scr, int lane) {
    float v[32]; tr_load(v, W, ldw, n_src0, k0, lane); tr_store(v, g, WT, K, n_dst0, k0, scr, lane);
}
__device__ __forceinline__ void tr_pair(const float* W, int ldw, int n_src0, const float* g, bf16_t* WT, int K, int n_dst0, int k0, LAS float* scr, int lane) {
    float va[32], vb[32]; tr_load(va, W, ldw, n_src0, k0, lane); tr_load(vb, W, ldw, n_src0, k0 + 64, lane);
    tr_store(va, g, WT, K, n_dst0, k0, scr, lane); tr_store(vb, g, WT, K, n_dst0, k0 + 64, scr, lane);
}

__device__ __forceinline__ void convert_dense(Frame& F, const AS4 Args* a, int l, int rank, int count) {
    LAS float* scr = (LAS float*)(F.lds + F.wave * 16384);
    const float* g_mix = (const float*)a->in[3]; const float* w_in = (const float*)a->in[4]; const float* g_q = (const float*)a->in[5]; const float* w_q = (const float*)a->in[6];
    const float* g_kv = (const float*)a->in[7]; const float* w_kv = (const float*)a->in[8]; const float* w_a = (const float*)a->in[9]; const float* w_b = (const float*)a->in[10];
    const float* w_o = (const float*)a->in[11]; const float* w_pg = (const float*)a->in[21]; const float* w_pp = (const float*)a->in[22];
    unsigned char* wd = F.ws + WS_WD + (size_t)l * WD_STRIDE;
    constexpr int I_IN = 8 * 161, I_Q = 4 * 48, I_KV = 2 * 64, I_A = 8 * 32, I_B = 2 * 32;
    constexpr int I_LAYER = I_IN + I_Q + I_KV + I_A + I_B + I_A + I_A + I_B;
    for (int it = rank * NWAVES + F.wave; it < I_LAYER; it += count * NWAVES) {
        int r = it;
        if (r < I_IN) { const int kb = r / 161, nb = r % 161, ns = nb * 32; const int nd = ns < 768 ? ns : (ns < 800 ? 5120 : ns - 32);
            tr_pair(w_in + (size_t)l * 1024 * NIN_SRC, NIN_SRC, ns, g_mix + l * 1024, (bf16_t*)(wd + WD_IN), 1024, nd, kb * 128, scr, F.lane); continue; } r -= I_IN;
        if (r < I_Q) { const int kb = r / 48, nb = r % 48;
            tr_pair(w_q + (size_t)l * 512 * 1536, 1536, nb * 32, g_q + l * 512, (bf16_t*)(wd + WD_Q), 512, nb * 32, kb * 128, scr, F.lane); continue; } r -= I_Q;
        if (r < I_KV) { const int kb = r / 64, nb = r % 64, h = nb >> 2, part = nb & 3;
            tr_pair(w_kv + (size_t)l * 256 * 2048, 2048, nb * 32, g_kv + l * 256, (bf16_t*)(wd + (part < 2 ? WD_K : WD_V)), 256, h * 64 + (part & 1) * 32, kb * 128, scr, F.lane); continue; } r -= I_KV;
        if (r < I_A) { const int kb = r / 32, nb = r % 32; tr_pair(w_a + (size_t)l * 1024 * 1024, 1024, nb * 32, nullptr, (bf16_t*)(wd + WD_A) + 256, 1280, nb * 32, kb * 128, scr, F.lane); continue; } r -= I_A;
        if (r < I_B) { const int kb = r / 32, nb = r % 32; tr_pair(w_b + (size_t)l * 256 * 1024, 1024, nb * 32, nullptr, (bf16_t*)(wd + WD_A), 1280, nb * 32, kb * 128, scr, F.lane); continue; } r -= I_B;
        if (r < I_A) { const int kb = r / 32, nb = r % 32; tr_pair(w_o + (size_t)l * 1024 * 1024, 1024, nb * 32, nullptr, (bf16_t*)(wd + WD_O), 1024, nb * 32, kb * 128, scr, F.lane); continue; } r -= I_A;
        if (r < I_A) { const int kb = r / 32, nb = r % 32; tr_pair(w_pg + (size_t)l * 1024 * 1024, 1024, nb * 32, (const float*)a->in[20] + l * 1024, (bf16_t*)(wd + WD_G), 1024, nb * 32, kb * 128, scr, F.lane); continue; } r -= I_A;
        { const int kb = r / 32, nb = r % 32; tr_pair(w_pp + (size_t)l * 256 * 1024, 1024, nb * 32, nullptr, (bf16_t*)(wd + WD_P), 256, nb * 32, kb * 128, scr, F.lane); }
    }
}
__device__ __forceinline__ void convert_p(Frame& F, const AS4 Args* a, int l, int rank, int count) {
    const f32x4* p = (const f32x4*)((const float*)a->in[1] + (size_t)l * T * 256); u32x4* dst = (u32x4*)(F.ws + WS_PB) + (size_t)l * T * 256 / 8;
    for (int i = rank * NTHR + F.tid; i < T * 256 / 8; i += count * NTHR) { const f32x4 a0 = p[2 * i], a1 = p[2 * i + 1]; dst[i] = pack8(a0, a1); }
}

__device__ __forceinline__ void prologue(Frame& F, const AS4 Args* a) {
    LAS float* scr = (LAS float*)(F.lds + F.wave * 16384);
    const int gw = F.vcu * NWAVES + F.wave, NGW = F.G * NWAVES;
    const float* x = (const float*)a->in[0]; const float* p = (const float*)a->in[1]; const int* pos = (const int*)a->in[2];
    const float* g_mix = (const float*)a->in[3]; const float* w_in = (const float*)a->in[4]; const float* g_q = (const float*)a->in[5]; const float* w_q = (const float*)a->in[6];
    const float* g_kv = (const float*)a->in[7]; const float* w_kv = (const float*)a->in[8]; const float* w_a = (const float*)a->in[9]; const float* w_b = (const float*)a->in[10];
    const float* w_o = (const float*)a->in[11]; const float* g_ffn = (const float*)a->in[12]; const float* w_rg = (const float*)a->in[13]; const float* w_re = (const float*)a->in[15];
    const float* w_eg = (const float*)a->in[17]; const float* w_eu = (const float*)a->in[18]; const float* w_ed = (const float*)a->in[19];
    const float* w_pg = (const float*)a->in[21]; const float* w_pp = (const float*)a->in[22];
    unsigned char* ws = F.ws;
    convert_dense(F, a, 0, F.vcu, F.G);
    const int gt = F.vcu * NTHR + F.tid, NGT = F.G * NTHR;
    for (int i = gt; i < DEPTH * 256 * 1024; i += NGT) { const int l = i >> 18, n = (i >> 10) & 255, k = i & 1023;
        float v = 0.f; if (n < 8) v = w_rg[((size_t)l * 1024 + k) * 8 + n] * g_ffn[l * 1024 + k]; else if (n < 72) v = w_re[((size_t)l * 1024 + k) * 64 + (n - 8)] * g_ffn[l * 1024 + k];
        ((bf16_t*)(ws + WS_WD + (size_t)l * WD_STRIDE + WD_R))[n * 1024 + k] = (bf16_t)(cvt_pk_bf16(v, 0.f) & 0xffffu); }
    for (int i = gt; i < T * 16; i += NGT) { const int row = i >> 4, j = i & 15; const float inv = exp2f(-(float)j * (1.0f / 16.0f) * 13.287712379549449f);
        const float ang = (float)pos[row] * inv; ((f32x2*)(ws + WS_ROPE_MLA))[i] = (f32x2){cosf(ang), sinf(ang)}; }
    for (int i = gt; i < T * 8; i += NGT) { const int row = i >> 3, j = i & 7; const float inv = exp2f(-(float)j * (1.0f / 8.0f) * 18.931568569324174f);
        const float ang = (float)pos[row] * inv; ((f32x2*)(ws + WS_ROPE_DIL))[i] = (f32x2){cosf(ang), sinf(ang)}; }
    convert_p(F, a, 0, F.vcu, F.G);
    float* ssq1 = (float*)(ws + WS_SSQ1); bf16_t* XB = (bf16_t*)(ws + WS_XB);
    for (int m = rl_first(F), m_end = rl_end(F), m_step = rl_step(F); m < m_end; m += m_step) { const f32x4* xr = (const f32x4*)(x + (size_t)m * 1024) + F.lane; f32x4 v[4]; float s = 0.f;
#pragma unroll
        for (int j = 0; j < 4; ++j) { v[j] = xr[64 * j]; s += (v[j][0] * v[j][0] + v[j][1] * v[j][1]) + (v[j][2] * v[j][2] + v[j][3] * v[j][3]); }
        s = wave_sum(s); if (F.lane < 16) ssq1[(size_t)m * 16 + F.lane] = F.lane == 0 ? s : 0.f;
#pragma unroll
        for (int j = 0; j < 4; ++j) {
            ((u32x2*)(XB + (size_t)m * 1024))[F.lane + 64 * j] = (u32x2){cvt_pk_bf16(v[j][0], v[j][1]), cvt_pk_bf16(v[j][2], v[j][3])}; } }
}

__device__ __forceinline__ void convert_w13(Frame& F, const AS4 Args* a, int l, int rank, int count, int it0, int it1) {
    LAS float* scr = (LAS float*)(F.lds + F.wave * 16384);
    const float* g_ffn = (const float*)a->in[12] + l * 1024; const float* w_eg = (const float*)a->in[17]; const float* w_eu = (const float*)a->in[18];
    bf16_t* dst = (bf16_t*)(F.ws + WS_W13 + (size_t)(l & 1) * W13_STRIDE);
    auto ld = [&](float (&v)[32], int r) { const int e = r >> 8, q = r & 255, up = q >> 7, kb = (q & 127) >> 3, nb = q & 7;
        tr_load(v, (up ? w_eu : w_eg) + ((size_t)l * 64 + e) * 1024 * 256, 256, nb * 32, kb * 64, F.lane); };
    auto st = [&](const float (&v)[32], int r) { const int e = r >> 8, q = r & 255, up = q >> 7, kb = (q & 127) >> 3, nb = q & 7; const int f0 = nb * 32, nd = (f0 >> 7) * 256 + up * 128 + (f0 & 127);
        tr_store(v, g_ffn, dst + (size_t)e * 512 * 1024, 1024, nd, kb * 64, scr, F.lane); };
    float va[32], vb[32];
    for (int pr = (it0 >> 1) + rank * NWAVES + F.wave; pr < (it1 >> 1); pr += count * NWAVES) { const int r0 = (pr >> 6) * 128 + (((pr >> 3) & 7) * 2) * 8 + (pr & 7);
        ld(va, r0); ld(vb, r0 + 8);
        st(va, r0); st(vb, r0 + 8); }
}
__device__ __forceinline__ void convert_w13_single(Frame& F, const AS4 Args* a, int l, int rank, int count, int it0, int it1) {
    LAS float* scr = (LAS float*)(F.lds + F.wave * 16384);
    const float* g_ffn = (const float*)a->in[12] + l * 1024; const float* w_eg = (const float*)a->in[17]; const float* w_eu = (const float*)a->in[18];
    bf16_t* dst = (bf16_t*)(F.ws + WS_W13 + (size_t)(l & 1) * W13_STRIDE);
    for (int r = it0 + rank * NWAVES + F.wave; r < it1; r += count * NWAVES) { const int e = r >> 8, q = r & 255, up = q >> 7, kb = (q & 127) >> 3, nb = q & 7; const int f0 = nb * 32, nd = (f0 >> 7) * 256 + up * 128 + (f0 & 127);
        tr_item((up ? w_eu : w_eg) + ((size_t)l * 64 + e) * 1024 * 256, 256, f0, g_ffn, dst + (size_t)e * 512 * 1024, 1024, nd, kb * 64, scr, F.lane); }
}
__device__ __forceinline__ void convert_w2(Frame& F, const AS4 Args* a, int l, int rank, int count, int it0 = 0, int it1 = 64 * 128) {
    LAS float* scr = (LAS float*)(F.lds + F.wave * 16384);
    const float* w_ed = (const float*)a->in[19]; bf16_t* dst = (bf16_t*)(F.ws + WS_W2);
    auto ld = [&](float (&v)[32], int r) { const int e = r >> 7, q = r & 127, kb = q >> 5, nb = q & 31;
        tr_load(v, w_ed + ((size_t)l * 64 + e) * 256 * 1024, 1024, nb * 32, kb * 64, F.lane); };
    auto st = [&](const float (&v)[32], int r) { const int e = r >> 7, q = r & 127, kb = q >> 5, nb = q & 31;
        tr_store(v, nullptr, dst + (size_t)e * 1024 * 256, 256, nb * 32, kb * 64, scr, F.lane); };
    float va[32], vb[32];
    for (int pr = (it0 >> 1) + rank * NWAVES + F.wave; pr < (it1 >> 1); pr += count * NWAVES) { const int r0 = (pr >> 5) * 64 + (pr & 31);
        ld(va, r0); ld(vb, r0 + 32);
        st(va, r0); st(vb, r0 + 32); }
}

typedef float f32x16 __attribute__((ext_vector_type(16)));
typedef short v4i16_t __attribute__((ext_vector_type(4)));
constexpr int W2_SPLIT = 5376;
constexpr int W13_EARLY = 8192;
constexpr int W13_SPLIT2 = 12800;
constexpr int W13_SPLIT = 11264;
constexpr int AT_KP0 = 208, AT_KP1 = 144, AT_VP = 192;
constexpr int AT_KBYTES = 64 * 208, AT_VBYTES = 64 * 192, AT_STAGE = AT_KBYTES + AT_VBYTES, AT_NST = 5;
static_assert(AT_NST * AT_STAGE <= RING_BYTES && TAB_OFF + 8 * 1024 <= LDS_BYTES, "attention LDS");
struct AttnDesc {
    const bf16_t* q; const bf16_t* k; const bf16_t* k2; const bf16_t* v; bf16_t* o; float* lse;
    int qs, ks, k2s, vs, os, lses;
    int m0, nq;
    int kt0, kt1;
};
__device__ __forceinline__ void attn_unit_pipe(Frame& F, const AttnDesc& D) {
    constexpr int NKS = 6, KP = AT_KP0;
    int lane_ = F.lane; asm volatile("" : "+v"(lane_));
    const int lane = lane_, w = F.wave, r = lane & 31, hh = lane >> 5;
    LAS unsigned char* lds = F.lds;
    const bool active = w * 32 < D.nq;
    const int mq = D.m0 + 32 * w + r;
    const int kt_hi = (D.m0 + 32 * w + 31) >> 6;
    bf16x8 qf[NKS];
    if (active) {
#pragma unroll
        for (int ks = 0; ks < NKS; ++ks) qf[ks] = *(const bf16x8*)(D.q + (size_t)mq * D.qs + 16 * ks + 8 * hh);
    } else {
#pragma unroll
        for (int ks = 0; ks < NKS; ++ks) qf[ks] = (bf16x8){0, 0, 0, 0, 0, 0, 0, 0};
    }
    f32x16 o0, o1;
#pragma unroll
    for (int i = 0; i < 16; ++i) { o0[i] = 0.f; o1[i] = 0.f; }
    float mrun = -1024.0f, lrun = 0.f;
    const char* srcp[4]; unsigned incb[4];
#pragma unroll
    for (int j = 0; j < 4; ++j) { const int slot = j * 8 + w; int c = slot * 64 + lane; if (c > 1599) c = 1599;
        if (c < 832) { const int row = c / 13; int part = c % 13; if (part == 12) part = 0;
            if (part < 8) { srcp[j] = (const char*)(D.k + (size_t)row * D.ks + part * 8); incb[j] = 128u * (unsigned)D.ks; } else { srcp[j] = (const char*)(D.k2 + (size_t)row * D.k2s + (part - 8) * 8); incb[j] = 128u * (unsigned)D.k2s; } }
        else { const int c2 = c - 832, row = c2 / 12; int part = c2 % 12; if (part >= 8) part = 0; srcp[j] = (const char*)(D.v + (size_t)row * D.vs + part * 8); incb[j] = 128u * (unsigned)D.vs; } }
    auto dma_issue = [&](int kt, int stage) {
#pragma unroll
        for (int j = 0; j < 4; ++j) { const int slot = j * 8 + w; const int dst = slot < 25 ? stage * AT_STAGE + slot * 1024 : TAB_OFF + w * 1024;
            __builtin_amdgcn_global_load_lds((const unsigned*)(srcp[j] + (size_t)kt * incb[j]), (LAS unsigned*)(lds + dst), 16, 0, 0); }
    };
#define AT_SYNC(n) do { asm volatile("s_waitcnt vmcnt(" #n ") lgkmcnt(0)" ::: "memory"); __builtin_amdgcn_s_barrier(); asm volatile("" ::: "memory"); } while (0)
    const int vlane = (hh * 4 + ((lane & 15) >> 2)) * AT_VP + (16 * ((lane >> 4) & 1) + 4 * (lane & 3)) * 2;
    bf16x8 pf[2][2], vfr[2][2][2];
    f32x16 sa0, sa1, sb0, sb1;
    auto vload = [&](int buf, int sb) {
        int vo = buf * AT_STAGE + AT_KBYTES + vlane; asm volatile("" : "+v"(vo));
        const LAS unsigned char* Vl = lds + vo;
        {
#pragma unroll
            for (int s2 = 0; s2 < 2; ++s2)
#pragma unroll
                for (int blk = 0; blk < 2; ++blk) { const LAS unsigned char* vb = Vl + (32 * sb + 16 * s2) * AT_VP + blk * 64;
                    const v4i16_t t0 = __builtin_amdgcn_ds_read_tr16_b64_v4i16((LAS v4i16_t*)(vb));
                    const v4i16_t t1 = __builtin_amdgcn_ds_read_tr16_b64_v4i16((LAS v4i16_t*)(vb + 8 * AT_VP));
                    vfr[sb][s2][blk] = (bf16x8){t0[0], t0[1], t0[2], t0[3], t1[0], t1[1], t1[2], t1[3]}; }
        }
    };
    auto pvm = [&](int buf) {
        vload(buf, 1);
#pragma unroll
        for (int sb = 0; sb < 2; ++sb)
#pragma unroll
            for (int s2 = 0; s2 < 2; ++s2) {
                o0 = __builtin_amdgcn_mfma_f32_32x32x16_bf16(vfr[sb][s2][0], pf[sb][s2], o0, 0, 0, 0);
                o1 = __builtin_amdgcn_mfma_f32_32x32x16_bf16(vfr[sb][s2][1], pf[sb][s2], o1, 0, 0, 0); }
    };
    auto qk = [&](int buf, f32x16& x0, f32x16& x1) {
        int ko = buf * AT_STAGE + r * KP + 16 * hh; asm volatile("" : "+v"(ko));
        const LAS unsigned char* Kl = lds + ko;
        const float ninit = -mrun;
        x0 = (f32x16){ninit, ninit, ninit, ninit, ninit, ninit, ninit, ninit, ninit, ninit, ninit, ninit, ninit, ninit, ninit, ninit}; x1 = x0;
#pragma unroll
        for (int ks = 0; ks < NKS; ++ks) {
            const bf16x8 k0 = *(const LAS bf16x8*)(Kl + 32 * ks), k1 = *(const LAS bf16x8*)(Kl + 32 * KP + 32 * ks);
            x0 = __builtin_amdgcn_mfma_f32_32x32x16_bf16(k0, qf[ks], x0, 0, 0, 0);
            x1 = __builtin_amdgcn_mfma_f32_32x32x16_bf16(k1, qf[ks], x1, 0, 0, 0);
        }
    };
    auto sm_pre = [&](int kt, f32x16& x0, f32x16& x1) {
        if (kt == kt_hi) {
#pragma unroll
            for (int i = 0; i < 16; ++i) { const int key0 = 64 * kt + (i & 3) + 8 * (i >> 2) + 4 * hh, key1 = key0 + 32;
                x0[i] = key0 <= mq ? x0[i] : -3.0e38f; x1[i] = key1 <= mq ? x1[i] : -3.0e38f; }
        }
        float mx = fmaxf(x0[0], x1[0]);
#pragma unroll
        for (int i = 1; i < 16; ++i) mx = fmaxf(mx, fmaxf(x0[i], x1[i]));
        { const auto t = __builtin_amdgcn_permlane32_swap(__float_as_uint(mx), __float_as_uint(mx), false, false); mx = fmaxf(__uint_as_float(t[0]), __uint_as_float(t[1])); }
        if (__any(mx > 8.0f)) {
            const float delta = mx > 8.0f ? mx : 0.f, alpha = __builtin_amdgcn_exp2f(-delta);
            mrun += delta; lrun *= alpha;
            x0 = x0 - delta; x1 = x1 - delta; o0 = o0 * alpha; o1 = o1 * alpha;
        }
    };
    auto sm_post = [&](f32x16& x0, f32x16& x1) {
        float ps = 0.f;
#pragma unroll
        for (int i = 0; i < 16; ++i) { x0[i] = __builtin_amdgcn_exp2f(x0[i]); x1[i] = __builtin_amdgcn_exp2f(x1[i]); ps += x0[i] + x1[i]; }
        lrun += ps;
#pragma unroll
        for (int sb = 0; sb < 2; ++sb)
#pragma unroll
            for (int s2 = 0; s2 < 2; ++s2) { const f32x16& pp = sb == 0 ? x0 : x1;
                u32x4 pw; pw.x = cvt_pk_bf16(pp[8 * s2 + 0], pp[8 * s2 + 1]); pw.y = cvt_pk_bf16(pp[8 * s2 + 2], pp[8 * s2 + 3]); pw.z = cvt_pk_bf16(pp[8 * s2 + 4], pp[8 * s2 + 5]); pw.w = cvt_pk_bf16(pp[8 * s2 + 6], pp[8 * s2 + 7]);
                pf[sb][s2] = __builtin_bit_cast(bf16x8, pw); }
    };
    auto qk_exp = [&](int buf, f32x16& x0, f32x16& x1, f32x16& e0, f32x16& e1) {
        int ko = buf * AT_STAGE + r * KP + 16 * hh; asm volatile("" : "+v"(ko));
        const LAS unsigned char* Kl = lds + ko;
        const float ninit = -mrun;
        x0 = (f32x16){ninit, ninit, ninit, ninit, ninit, ninit, ninit, ninit, ninit, ninit, ninit, ninit, ninit, ninit, ninit, ninit}; x1 = x0;
        bf16x8 kf[2][2];
        kf[0][0] = *(const LAS bf16x8*)(Kl); kf[0][1] = *(const LAS bf16x8*)(Kl + 32 * KP);
        float ps = 0.f;
#pragma unroll
        for (int ks = 0; ks < NKS; ++ks) {
            if (ks + 1 < NKS) { kf[(ks + 1) & 1][0] = *(const LAS bf16x8*)(Kl + 32 * (ks + 1)); kf[(ks + 1) & 1][1] = *(const LAS bf16x8*)(Kl + 32 * KP + 32 * (ks + 1)); }
            x0 = __builtin_amdgcn_mfma_f32_32x32x16_bf16(kf[ks & 1][0], qf[ks], x0, 0, 0, 0);
            x1 = __builtin_amdgcn_mfma_f32_32x32x16_bf16(kf[ks & 1][1], qf[ks], x1, 0, 0, 0);
            constexpr int LO[7] = {0, 6, 12, 16, 22, 28, 32};
#pragma unroll
            for (int e = LO[ks]; e < LO[ks + 1]; ++e) { if (e < 16) { e0[e] = __builtin_amdgcn_exp2f(e0[e]); ps += e0[e]; } else { e1[e - 16] = __builtin_amdgcn_exp2f(e1[e - 16]); ps += e1[e - 16]; } }
            SCHED_FENCE();
        }
        lrun += ps;
#pragma unroll
        for (int sb = 0; sb < 2; ++sb)
#pragma unroll
            for (int s2 = 0; s2 < 2; ++s2) { const f32x16& pp = sb == 0 ? e0 : e1;
                u32x4 pw; pw.x = cvt_pk_bf16(pp[8 * s2 + 0], pp[8 * s2 + 1]); pw.y = cvt_pk_bf16(pp[8 * s2 + 2], pp[8 * s2 + 3]); pw.z = cvt_pk_bf16(pp[8 * s2 + 4], pp[8 * s2 + 5]); pw.w = cvt_pk_bf16(pp[8 * s2 + 6], pp[8 * s2 + 7]);
                pf[sb][s2] = __builtin_bit_cast(bf16x8, pw); }
    };
    const int ntile = D.kt1 - D.kt0 + 1;
    int nmine = active ? kt_hi - D.kt0 + 1 : 0; if (nmine > ntile) nmine = ntile;
    auto step = [&](int i, f32x16& c0, f32x16& c1, f32x16& n0, f32x16& n1) {
        if (i < nmine) {
            sm_pre(D.kt0 + i, c0, c1);
            vload(i % AT_NST, 0);
            if (i + 1 < nmine) qk_exp((i + 1) % AT_NST, n0, n1, c0, c1); else sm_post(c0, c1);
            pvm(i % AT_NST);
        }
    };
    __syncthreads();
    dma_issue(D.kt0, 0);
    if (ntile > 1) dma_issue(D.kt0 + 1, 1);
    if (ntile > 2) dma_issue(D.kt0 + 2, 2);
    AT_SYNC(0);
    if (nmine > 0) qk(0, sa0, sa1);
    for (int i = 0; i < ntile; i += 2) {
        if (i + 3 < ntile) dma_issue(D.kt0 + i + 3, (i + 3) % AT_NST);
        if (i + 4 < ntile) dma_issue(D.kt0 + i + 4, (i + 4) % AT_NST);
        step(i, sa0, sa1, sb0, sb1);
        if (i + 1 < ntile) step(i + 1, sb0, sb1, sa0, sa1);
        AT_SYNC(0);
    }
#undef AT_SYNC
    if (active) {
        const float lt = lrun + __shfl_xor(lrun, 32), il = 1.0f / lt;
        bf16_t* op = D.o + (size_t)mq * D.os;
#pragma unroll
        for (int blk = 0; blk < 2; ++blk)
#pragma unroll
            for (int g4 = 0; g4 < 4; ++g4) { const f32x16& oo = blk == 0 ? o0 : o1;
                *(u32x2*)(op + 32 * blk + 8 * g4 + 4 * hh) = (u32x2){cvt_pk_bf16(oo[4 * g4] * il, oo[4 * g4 + 1] * il), cvt_pk_bf16(oo[4 * g4 + 2] * il, oo[4 * g4 + 3] * il)}; }
    }
}

__device__ __forceinline__ void mla_attn_phase(Frame& F) {
    unsigned char* ws = F.ws;
    for (int p0 = F.vcu; p0 < 512; p0 += F.G) {
        const int p = F.G == 256 ? (F.vcu >> 5) * 64 + (p0 >> 8) * 32 + (F.vcu & 31) : p0;
        const int bh = p >> 2, j = p & 3, b = bh >> 4, h = bh & 15;
#pragma unroll 1
        for (int half = 0; half < 2; ++half) { const int qb = half == 0 ? 7 - j : j;
            AttnDesc D;
            D.q = (const bf16_t*)(ws + WS_Q) + (size_t)b * SEQ * 1536 + h * 96; D.qs = 1536;
            D.k = (const bf16_t*)(ws + WS_KN) + (size_t)b * SEQ * 1024 + h * 64; D.ks = 1024;
            D.k2 = (const bf16_t*)(ws + WS_KPE) + (size_t)b * SEQ * 32; D.k2s = 32;
            D.v = (const bf16_t*)(ws + WS_V) + (size_t)b * SEQ * 1024 + h * 64; D.vs = 1024;
            D.o = (bf16_t*)(ws + WS_OA) + (size_t)b * SEQ * 1280 + 256 + h * 64; D.os = 1280; D.lse = nullptr; D.lses = 0;
            D.m0 = qb * 256; D.nq = 256; D.kt0 = 0; D.kt1 = 4 * qb + 3;
            attn_unit_pipe(F, D); }
    }
}
constexpr int DL_P = 144, DL_TILE = 2 * 64 * DL_P;
struct DilUnit { const bf16_t* q; bf16_t* o; float* lse; int d, os, lses, m0, nq, kt0, nt; };
__device__ __forceinline__ DilUnit dil_decode(unsigned char* ws, int u) {
    const bf16_t* DIL = (const bf16_t*)(ws + WS_DIL); bf16_t* OG = (bf16_t*)(ws + WS_OG); float* LSE = (float*)(ws + WS_LSE);
    int g, b, h, rr, c, d, nq;
    if (u < 256) { g = 0; b = u >> 5; h = (u >> 3) & 3; c = u & 7; rr = 0; d = 1; nq = 256; }
    else if (u < 512) { const int v = u - 256; g = 1; b = v >> 5; h = (v >> 3) & 3; rr = (v >> 1) & 3; c = v & 1; d = 4; nq = 256; }
    else { const int v = u - 512; g = 2; b = v >> 6; h = (v >> 4) & 3; rr = v & 15; c = 0; d = 16; nq = 128; }
    DilUnit D; const size_t row0 = (size_t)b * SEQ + rr;
    D.q = DIL + row0 * 2304 + g * 768 + h * 64; D.d = d;
    D.o = OG + ((size_t)g * T + row0) * 256 + h * 64; D.os = d * 256; D.lse = LSE + ((size_t)g * T + row0) * 4 + h; D.lses = d * 4;
    D.m0 = c * 256; D.nq = nq; D.kt0 = max(0, 4 * c - 2); D.nt = (nq == 256 ? 4 * c + 3 : 1) - D.kt0 + 1;
    return D;
}
__device__ __forceinline__ void dil_attn_phase(Frame& F) {
    unsigned char* ws = F.ws; LAS unsigned char* lds = F.lds;
    const int lane = F.lane, w = F.wave, r = lane & 31, hh = lane >> 5, tid = F.tid;
    const int part = tid & 15, keyA = tid >> 4;
    const int ldsA = (part < 8 ? 0 : 64 * DL_P) + keyA * DL_P + (part & 7) * 16;
    const int vlane = 64 * DL_P + (hh * 4 + ((lane & 15) >> 2)) * DL_P + (16 * ((lane >> 4) & 1) + 4 * (lane & 3)) * 2;
    u32x4 st[12]; bf16x8 qn[4];
    auto issue = [&](const DilUnit& D) {
        const bf16_t* src = D.q + (part < 8 ? 256 : 512) + (part & 7) * 8; const size_t rs_ = (size_t)D.d * 2304;
#pragma unroll
        for (int j = 0; j < 6; ++j) if (j < D.nt) { const size_t mk = (size_t)(64 * (D.kt0 + j) + keyA);
            st[2 * j] = *(const u32x4*)(src + mk * rs_); st[2 * j + 1] = *(const u32x4*)(src + (mk + 32) * rs_); }
        if (w * 32 < D.nq) { const size_t mq = (size_t)(D.m0 + 32 * w + r);
#pragma unroll
            for (int ks = 0; ks < 4; ++ks) qn[ks] = *(const bf16x8*)(D.q + mq * rs_ + 16 * ks + 8 * hh); }
    };
    auto store = [&](const DilUnit& D) {
#pragma unroll
        for (int j = 0; j < 6; ++j) if (j < D.nt) { *(LAS u32x4*)(lds + j * DL_TILE + ldsA) = st[2 * j]; *(LAS u32x4*)(lds + j * DL_TILE + ldsA + 32 * DL_P) = st[2 * j + 1]; }
    };
    int u = F.vcu;
    if (u >= 1024) return;
    auto umap = [&](int uu) { return (F.G == 256 && uu >= 512) ? 512 + 64 * (F.vcu >> 5) + 32 * ((uu - 512) >> 8) + (F.vcu & 31) : uu; };
    DilUnit cur = dil_decode(ws, umap(u));
    __syncthreads();
    issue(cur); store(cur);
    bf16x8 qf[4];
#pragma unroll
    for (int ks = 0; ks < 4; ++ks) qf[ks] = qn[ks];
    __syncthreads();
    for (;;) {
        const int un = u + F.G; const bool has_next = un < 1024;
        DilUnit nxt = cur; if (has_next) { nxt = dil_decode(ws, umap(un)); issue(nxt); }
        if (w * 32 < cur.nq) {
            const int mq = cur.m0 + 32 * w + r;
            const int kt_hi = (cur.m0 + 32 * w + 31) >> 6, kt_lo = max(0, (cur.m0 + 32 * w - 128) >> 6);
            f32x16 o0, o1;
#pragma unroll
            for (int i = 0; i < 16; ++i) { o0[i] = 0.f; o1[i] = 0.f; }
            float mrun = -1024.0f, lrun = 0.f;
#pragma unroll 1
            for (int kt = kt_lo; kt <= kt_hi; ++kt) {
                int ko = (kt - cur.kt0) * DL_TILE + r * DL_P + 16 * hh; asm volatile("" : "+v"(ko));
                const LAS unsigned char* Kl = lds + ko;
                const float ninit = -mrun;
                f32x16 s0 = (f32x16){ninit, ninit, ninit, ninit, ninit, ninit, ninit, ninit, ninit, ninit, ninit, ninit, ninit, ninit, ninit, ninit}, s1 = s0;
#pragma unroll
                for (int ks = 0; ks < 4; ++ks) {
                    const bf16x8 k0 = *(const LAS bf16x8*)(Kl + 32 * ks), k1 = *(const LAS bf16x8*)(Kl + 32 * DL_P + 32 * ks);
                    s0 = __builtin_amdgcn_mfma_f32_32x32x16_bf16(k0, qf[ks], s0, 0, 0, 0);
                    s1 = __builtin_amdgcn_mfma_f32_32x32x16_bf16(k1, qf[ks], s1, 0, 0, 0);
                }
                if (kt == kt_hi || kt <= kt_lo + 1) {
#pragma unroll
                    for (int i = 0; i < 16; ++i) { const int key0 = 64 * kt + (i & 3) + 8 * (i >> 2) + 4 * hh, key1 = key0 + 32;
                        s0[i] = (key0 <= mq && key0 >= mq - 128) ? s0[i] : -3.0e38f; s1[i] = (key1 <= mq && key1 >= mq - 128) ? s1[i] : -3.0e38f; }
                }
                float mx = fmaxf(s0[0], s1[0]);
#pragma unroll
                for (int i = 1; i < 16; ++i) mx = fmaxf(mx, fmaxf(s0[i], s1[i]));
                mx = fmaxf(mx, __shfl_xor(mx, 32));
                if (__any(mx > 8.0f)) {
                    const float delta = mx > 8.0f ? mx : 0.f, alpha = __builtin_amdgcn_exp2f(-delta);
                    mrun += delta; lrun *= alpha;
                    s0 = s0 - delta; s1 = s1 - delta; o0 = o0 * alpha; o1 = o1 * alpha;
                }
                float ps = 0.f;
#pragma unroll
                for (int i = 0; i < 16; ++i) { s0[i] = __builtin_amdgcn_exp2f(s0[i]); s1[i] = __builtin_amdgcn_exp2f(s1[i]); ps += s0[i] + s1[i]; }
                lrun += ps;
                int vo = (kt - cur.kt0) * DL_TILE + vlane; asm volatile("" : "+v"(vo));
                const LAS unsigned char* Vl = lds + vo;
#pragma unroll
                for (int sb = 0; sb < 2; ++sb)
#pragma unroll
                    for (int s2 = 0; s2 < 2; ++s2) { const f32x16& pp = sb == 0 ? s0 : s1;
                        u32x4 pw; pw.x = cvt_pk_bf16(pp[8 * s2 + 0], pp[8 * s2 + 1]); pw.y = cvt_pk_bf16(pp[8 * s2 + 2], pp[8 * s2 + 3]); pw.z = cvt_pk_bf16(pp[8 * s2 + 4], pp[8 * s2 + 5]); pw.w = cvt_pk_bf16(pp[8 * s2 + 6], pp[8 * s2 + 7]);
                        const bf16x8 pfr = __builtin_bit_cast(bf16x8, pw);
                        const LAS unsigned char* vb = Vl + (32 * sb + 16 * s2) * DL_P;
#pragma unroll
                        for (int blk = 0; blk < 2; ++blk) {
                            const v4i16_t t0 = __builtin_amdgcn_ds_read_tr16_b64_v4i16((LAS v4i16_t*)(vb + blk * 64));
                            const v4i16_t t1 = __builtin_amdgcn_ds_read_tr16_b64_v4i16((LAS v4i16_t*)(vb + blk * 64 + 8 * DL_P));
                            const bf16x8 vf = (bf16x8){t0[0], t0[1], t0[2], t0[3], t1[0], t1[1], t1[2], t1[3]};
                            if (blk == 0) o0 = __builtin_amdgcn_mfma_f32_32x32x16_bf16(vf, pfr, o0, 0, 0, 0); else o1 = __builtin_amdgcn_mfma_f32_32x32x16_bf16(vf, pfr, o1, 0, 0, 0);
                        } }
            }
            const float lt = lrun + __shfl_xor(lrun, 32), il = 1.0f / lt;
            bf16_t* op = cur.o + (size_t)mq * cur.os;
#pragma unroll
            for (int blk = 0; blk < 2; ++blk)
#pragma unroll
                for (int g4 = 0; g4 < 4; ++g4) { const f32x16& oo = blk == 0 ? o0 : o1;
                    *(u32x2*)(op + 32 * blk + 8 * g4 + 4 * hh) = (u32x2){cvt_pk_bf16(oo[4 * g4] * il, oo[4 * g4 + 1] * il), cvt_pk_bf16(oo[4 * g4 + 2] * il, oo[4 * g4 + 3] * il)}; }
            if (hh == 0) cur.lse[(size_t)mq * cur.lses] = mrun + __builtin_amdgcn_logf(lt);
        }
        if (!has_next) break;
        __syncthreads();
        store(nxt);
#pragma unroll
        for (int ks = 0; ks < 4; ++ks) qf[ks] = qn[ks];
        cur = nxt; u = un;
        __syncthreads();
    }
    __syncthreads();
}
__device__ __forceinline__ void dil_merge(Frame& F) {
    unsigned char* ws = F.ws; const bf16_t* OG = (const bf16_t*)(ws + WS_OG); const float* LSE = (const float*)(ws + WS_LSE); bf16_t* OB = (bf16_t*)(ws + WS_OA);
    const bool xr = F.G == 256;
    for (int i = xr ? F.tid : F.vcu * NTHR + F.tid; i < (xr ? 2048 : T * 32); i += xr ? NTHR : F.G * NTHR) { const int row = xr ? (F.vcu >> 5) * 2048 + (F.vcu & 31) * 64 + (i >> 5) : i >> 5, ch = i & 31, h = ch >> 3;
        const float l0 = LSE[(size_t)row * 4 + h], l1 = LSE[((size_t)T + row) * 4 + h], l2 = LSE[((size_t)2 * T + row) * 4 + h];
        const float mx = fmaxf(l0, fmaxf(l1, l2)); const float w0 = __builtin_amdgcn_exp2f(l0 - mx), w1 = __builtin_amdgcn_exp2f(l1 - mx), w2 = __builtin_amdgcn_exp2f(l2 - mx); const float inv = 1.0f / (w0 + w1 + w2);
        f32x4 a0, a1, b0, b1, c0, c1;
        unpack8(*(const u32x4*)(OG + (size_t)row * 256 + ch * 8), a0, a1); unpack8(*(const u32x4*)(OG + ((size_t)T + row) * 256 + ch * 8), b0, b1); unpack8(*(const u32x4*)(OG + ((size_t)2 * T + row) * 256 + ch * 8), c0, c1);
        const f32x4 r0 = (a0 * w0 + b0 * w1 + c0 * w2) * inv, r1 = (a1 * w0 + b1 * w1 + c1 * w2) * inv;
        *(u32x4*)(OB + (size_t)row * 1280 + ch * 8) = pack8(r0, r1); }
}

template <class Sched> __device__ __forceinline__ void dispatch1(Frame& F, const Sched& S, const float* b_g, const float* b_e, int l) {
    unsigned char* ws = F.ws; const float* RL = (const float*)(ws + WS_RL); const float* ssq2 = (const float*)(ws + WS_SSQ2) + (size_t)l * T * 16;
    int* tok_e = (int*)(ws + RT_TOK_E); float* tok_w = (float*)(ws + RT_TOK_W); float* tok_rs = (float*)(ws + RT_TOK_RS);
    int* hist_g = (int*)(ws + RT_HIST) + l * 4096;
    LAS int* hist = (LAS int*)F.lds;
    VM_WAIT(); __syncthreads();
    Unit u;
    for (int i = 0; S.next(i, u); ++i) {
      if (F.tid < 64) hist[F.tid] = 0;
      __syncthreads();
      if (F.tid < 256) { const int t = u.pm * 256 + F.tid;
        const float rs = rsqrtf(part_sum<16>(ssq2 + (size_t)t * 16) * (1.0f / 1024.0f) + EPS);
        const float* lg = RL + (size_t)t * 72;
        float gl[8];
#pragma unroll
        for (int j = 0; j < 8; ++j) gl[j] = lg[j] * rs + b_g[j];
        int gs = 0; float gm = gl[0];
#pragma unroll
        for (int j = 1; j < 8; ++j) if (gl[j] > gm) { gm = gl[j]; gs = j; }
        float den = 0.f;
#pragma unroll
        for (int j = 0; j < 8; ++j) den += __expf(gl[j] - gm);
        const float pg = 1.0f / den;
        float el[8];
        { const f32x4 e0 = *(const f32x4*)(lg + 8 + gs * 8), e1 = *(const f32x4*)(lg + 12 + gs * 8);
#pragma unroll
          for (int j = 0; j < 4; ++j) { el[j] = e0[j] * rs + b_e[gs * 8 + j]; el[4 + j] = e1[j] * rs + b_e[gs * 8 + 4 + j]; } }
        int i0 = 0; float v0 = el[0];
#pragma unroll
        for (int j = 1; j < 8; ++j) if (el[j] > v0) { v0 = el[j]; i0 = j; }
        int i1 = -1; float v1 = -3.0e38f;
#pragma unroll
        for (int j = 0; j < 8; ++j) if (j != i0 && el[j] > v1) { v1 = el[j]; i1 = j; }
        const float ex = __expf(v1 - v0), w0 = pg / (1.0f + ex), w1 = pg * ex / (1.0f + ex);
        const int e0i = gs * 8 + i0, e1i = gs * 8 + i1;
        tok_e[2 * t] = e0i; tok_e[2 * t + 1] = e1i; tok_w[2 * t] = w0; tok_w[2 * t + 1] = w1; tok_rs[t] = rs;
        atomicAdd((int*)&hist[e0i], 1); atomicAdd((int*)&hist[e1i], 1); }
      __syncthreads();
      if (F.tid < 64) hist_g[u.pm * 64 + F.tid] = hist[F.tid];
      __syncthreads(); }
}
__device__ __forceinline__ void dispatch2(Frame& F, int l) {
    unsigned char* ws = F.ws;
    const int* tok_e = (const int*)(ws + RT_TOK_E); const float* tok_w = (const float*)(ws + RT_TOK_W); const float* tok_rs = (const float*)(ws + RT_TOK_RS);
    int* dest = (int*)(ws + RT_DEST); int* row_tok = (int*)(ws + RT_ROW_TOK); float* row_w = (float*)(ws + RT_ROW_W); float* row_rs = (float*)(ws + RT_ROW_RS); int* blk_e = (int*)(ws + RT_BLK_E);
    const int* hist_g = (const int*)(ws + RT_HIST) + l * 4096;
    LAS int* pst = (LAS int*)F.lds;
    LAS int* hl = pst + 1024;
    if (F.vcu >= 64) return;
    for (int i = F.tid; i < 4096; i += NTHR) hl[i] = hist_g[i];
    __syncthreads();
    if (F.tid < 64) { int c = 0; for (int p = 0; p < 64; ++p) c += hl[p * 64 + F.tid]; pst[64 + F.tid] = c; }
    __syncthreads();
    if (F.tid == 0) { int acc = 0; for (int e = 0; e < 64; ++e) { pst[e] = acc; acc += (pst[64 + e] + 255) & ~255; } pst[128] = acc; }
    __syncthreads();
    for (int pm = F.vcu; pm < 64; pm += F.G) {
        if (F.tid < 64) { int bsum = 0; for (int p = 0; p < pm; ++p) bsum += hl[p * 64 + F.tid]; pst[192 + F.tid] = pst[F.tid] + bsum; pst[256 + F.tid] = 0; }
        __syncthreads();
        if (F.tid < 256) { const int t = pm * 256 + F.tid;
#pragma unroll
            for (int k = 0; k < 2; ++k) { const int e = tok_e[2 * t + k]; const int slot = pst[192 + e] + atomicAdd((int*)&pst[256 + e], 1);
                row_tok[slot] = t; row_w[slot] = tok_w[2 * t + k]; row_rs[slot] = tok_rs[t]; dest[2 * t + k] = slot; } }
        __syncthreads();
    }
    for (int e = F.vcu; e < 64; e += F.G) { const int c = pst[64 + e], pc = (c + 255) & ~255;
        for (int s2 = c + F.tid; s2 < pc; s2 += NTHR) { row_tok[pst[e] + s2] = 0; row_w[pst[e] + s2] = 0.f; row_rs[pst[e] + s2] = 0.f; } }
    if (F.vcu == 0) { const int nblk = pst[128] >> 8;
        for (int bk = F.tid; bk < nblk; bk += NTHR) { int ee = 0; for (int j = 0; j < 64; ++j) if (pst[64 + j] > 0 && pst[j] <= bk * 256) ee = j; blk_e[bk] = ee; }
        if (F.tid == 0) blk_e[255] = nblk; }
    __syncthreads();
}

__device__ __forceinline__ void combine_norm(Frame& F) {
    unsigned char* ws = F.ws; const bf16_t* YS = (const bf16_t*)(ws + WS_YS); const int* dest = (const int*)(ws + RT_DEST); bf16_t* XS = (bf16_t*)(ws + WS_XN); const bf16_t* XB = (const bf16_t*)(ws + WS_XB); float* rsp = (float*)(ws + RT_PLE_RS);
    const int gw = F.vcu * NWAVES + F.wave, NGW = F.G * NWAVES;
    for (int m = rl_first(F), m_end = rl_end(F), m_step = rl_step(F); m < m_end; m += m_step) { const int d0 = dest[2 * m], d1 = dest[2 * m + 1];
        const u32x2* xr = (const u32x2*)(XB + (size_t)m * 1024) + F.lane; const u32x2* y0 = (const u32x2*)(YS + (size_t)d0 * 1024) + F.lane; const u32x2* y1 = (const u32x2*)(YS + (size_t)d1 * 1024) + F.lane;
        float s = 0.f;
#pragma unroll
        for (int j = 0; j < 4; ++j) { const u32x2 x = xr[64 * j], a = y0[64 * j], b = y1[64 * j];
            const float v0 = bf_lo(x.x) + (bf_lo(a.x) + bf_lo(b.x)), v1 = bf_hi(x.x) + (bf_hi(a.x) + bf_hi(b.x)), v2 = bf_lo(x.y) + (bf_lo(a.y) + bf_lo(b.y)), v3 = bf_hi(x.y) + (bf_hi(a.y) + bf_hi(b.y));
            const u32x2 o = (u32x2){cvt_pk_bf16(v0, v1), cvt_pk_bf16(v2, v3)};
            ((u32x2*)(XS + (size_t)m * 1024))[F.lane + 64 * j] = o;
            const float r0 = bf_lo(o.x), r1 = bf_hi(o.x), r2 = bf_lo(o.y), r3 = bf_hi(o.y);
            s += (r0 * r0 + r1 * r1) + (r2 * r2 + r3 * r3); }
        s = wave_sum(s); if (F.lane == 0) rsp[m] = rsqrtf(s * (1.0f / 1024.0f) + EPS); }
}
__device__ __forceinline__ void final_norm(Frame& F, const float* g_final) {
    const float* ssq = (const float*)(F.ws + WS_SSQ1) + (size_t)4 * T * 16; const bf16_t* XB = (const bf16_t*)(F.ws + WS_XB);
    const int gw = F.vcu * NWAVES + F.wave, NGW = F.G * NWAVES;
    f32x4 gp[4];
#pragma unroll
    for (int j = 0; j < 4; ++j) gp[j] = ((const f32x4*)g_final)[F.lane + 64 * j];
    for (int m = rl_first(F), m_end = rl_end(F), m_step = rl_step(F); m < m_end; m += m_step) { const float rs = rsqrtf(part_sum<16>(ssq + (size_t)m * 16) * (1.0f / 1024.0f) + EPS) * F.diag_scale;
        const u32x2* xr = (const u32x2*)(XB + (size_t)m * 1024) + F.lane; f32x4* orow = (f32x4*)(F.X + (size_t)m * 1024) + F.lane;
#pragma unroll
        for (int j = 0; j < 4; ++j) { const u32x2 x = xr[64 * j]; orow[64 * j] = (f32x4){bf_lo(x.x), bf_hi(x.x), bf_lo(x.y), bf_hi(x.y)} * rs * gp[j]; } }
}

constexpr int PH_PER_LAYER = 13, N_PHASES = 2 + DEPTH * PH_PER_LAYER;
__global__ void __launch_bounds__(NTHR, 2) fwd_kernel(Args args) {
    extern __shared__ __attribute__((aligned(16))) unsigned char lds_raw[];
    Frame F;
    F.lds = (LAS unsigned char*)lds_raw;
    F.tid = threadIdx.x; F.lane = F.tid & 63; F.wave = __builtin_amdgcn_readfirstlane(F.tid >> 6);
    F.G = gridDim.x; { const int bx = blockIdx.x; F.vcu = (F.G % 8 == 0) ? (bx % 8) * (F.G / 8) + bx / 8 : bx; }
    F.ws = nullptr; F.X = nullptr; F.diag_scale = 1.0f;
    for (int u = F.tid; u < (LDS_BYTES - LDSCTL_OFF) / 4; u += NTHR) ((LAS unsigned*)(F.lds + LDSCTL_OFF))[u] = 0u;
    __syncthreads();
    const int lo = args.ph_lo, hi = args.ph_hi;
    const bool use_bar = (hi - lo) > 1;
    XcdBarrier bar; bar.bar = (unsigned*)(args.ws + WS_CTL) + CW_BAR; bar.x = 0; bar.st = nullptr;
    if (use_bar) bar = xcd_barrier_post((unsigned*)(args.ws + WS_CTL) + CW_BAR, (volatile LAS unsigned*)(F.lds + MISC_OFF + 32));
#ifndef PH_EN
#define PH_EN(j) 1
#endif
#define IN(k) (lo <= (k) && (k) < hi)
#define INL(j) (PH_EN(j) && IN(p0 + (j)))
#ifdef DIAG_J
#define SEAM(k) do { if (IN(k) && IN((k) + 1)) xcd_barrier(bar); if (blockIdx.x == 0 && threadIdx.x == 0) ((unsigned long long*)(args.ws + RT_TS))[(k) + 1] = __builtin_amdgcn_s_memtime(); } while (0)
#else
#define SEAM(k) do { if (IN(k) && IN((k) + 1)) xcd_barrier(bar); } while (0)
#endif
#define SEAML(k) do { if (IN(k) && IN((k) + 1)) { if (local_ok) xcd_barrier_local(bar); else xcd_barrier(bar); } } while (0)
#define KARGS() ({ const AS4 Args* _p = (const AS4 Args*)__builtin_amdgcn_kernarg_segment_ptr(); asm volatile("" : "+s"(_p)); _p; })
#define PHASE_ENV const AS4 Args* ap = KARGS(); unsigned char* ws = ap->ws; Frame P = F; P.ws = ws; P.X = ap->out; int cidl = cid; P.tid = threadIdx.x; asm volatile("" : "+v"(P.tid)); P.lane = P.tid & 63; \
    asm volatile("" : "+v"(P.lane)); asm volatile("" : "+s"(P.vcu), "+s"(P.G), "+s"(P.wave), "+s"(cidl)); (void)ws; (void)cidl
    const int cid = (int)blockIdx.x;
#ifdef DIAG_J
    if (blockIdx.x == 0 && threadIdx.x == 0) ((unsigned long long*)(args.ws + RT_TS))[0] = __builtin_amdgcn_s_memtime();
#endif

    if (use_bar && threadIdx.x == 0) __hip_atomic_store((unsigned*)(args.ws + WS_CTL) + CW_XCT + blockIdx.x, xb_xcc_id() + 1u, __ATOMIC_RELAXED, __HIP_MEMORY_SCOPE_AGENT);
    if (IN(0)) { PHASE_ENV; prologue(P, ap); }
    SEAM(0);
    bool local_ok = false;
    if (use_bar && lo == 0 && hi == N_PHASES && gridDim.x == 256) {
        if (threadIdx.x == 0) { const unsigned mine = xb_xcc_id() + 1u, lead = __hip_atomic_load((unsigned*)(args.ws + WS_CTL) + CW_XCT + (blockIdx.x & 7), __ATOMIC_RELAXED, __HIP_MEMORY_SCOPE_AGENT);
            unsigned bad = mine != lead ? 1u : 0u;
            for (unsigned j = 0; j < (blockIdx.x & 7); ++j) bad |= (__hip_atomic_load((unsigned*)(args.ws + WS_CTL) + CW_XCT + j, __ATOMIC_RELAXED, __HIP_MEMORY_SCOPE_AGENT) == lead) ? 1u : 0u;
            if (bad) __hip_atomic_fetch_or((unsigned*)(args.ws + WS_CTL) + CW_XFLAG, 1u, __ATOMIC_RELAXED, __HIP_MEMORY_SCOPE_AGENT); }
        xcd_barrier(bar);
        local_ok = __builtin_amdgcn_readfirstlane(__hip_atomic_load((unsigned*)(args.ws + WS_CTL) + CW_XFLAG, __ATOMIC_RELAXED, __HIP_MEMORY_SCOPE_AGENT)) == 0u;
    }

#pragma unroll 1
    for (int l = 0; l < DEPTH; ++l) {
        const int p0 = 1 + PH_PER_LAYER * l;
        if (INL(0)) {
            PHASE_ENV; unsigned char* wd = ws + WS_WD + (size_t)l * WD_STRIDE;
            pg8::Gemm g{(const bf16_t*)(ws + WS_XB), (const bf16_t*)(wd + WD_IN), 1024, 1024, 1024, nullptr}; pg8::DenseOrder S; S.init(64, 21, 1024, 1024, P.G, cidl, 20);
            { const float* sq = (const float*)(ws + WS_SSQ1) + (size_t)l * T * 16; fill_tab(P, S, [=](int row) { return rsqrtf(part_sum<16>(sq + (size_t)row * 16) * (1.0f / 1024.0f) + EPS); }); }
            EpiInProj E{(bf16_t*)(ws + WS_CQ), (bf16_t*)(ws + WS_CKV), (bf16_t*)(ws + WS_KPE), (bf16_t*)(ws + WS_DIL), (bf16_t*)(ws + WS_SG),
                        (float*)(ws + WS_SSQQ) + (size_t)l * T * 8, (float*)(ws + WS_SSQKV) + (size_t)l * T * 4, (const f32x2*)(ws + WS_ROPE_DIL), (const f32x2*)(ws + WS_ROPE_MLA), (const LAS float*)(P.lds + TAB_OFF)};
#ifdef EXP_SIMPLE_EPI
            EpiScaleStore E2{nullptr, 0.f, (bf16_t*)(ws + WS_YS), NIN}; pg8::gemm_phase<EpiScaleStore, pg8::DenseOrder, false, true>(P.lds, g, S, E2); (void)E;
#else
            pg8::gemm_phase<EpiInProj, pg8::DenseOrder, false, true, true>(P.lds, g, S, E);
#endif
            if (P.G == 256) { if (cidl >= 64) { convert_w13(P, ap, l, cidl - 64, 192, l == 0 ? 0 : W13_EARLY, W13_SPLIT); convert_w13_single(P, ap, l, cidl - 64, 192, W13_SPLIT, W13_SPLIT2); } } else convert_w13(P, ap, l, cidl, P.G, l == 0 ? 0 : W13_EARLY, 64 * 256);
        }
        SEAML(p0 + 0);
        if (INL(1)) {
            { PHASE_ENV; unsigned char* wd = ws + WS_WD + (size_t)l * WD_STRIDE;
              pg8::Gemm g{(const bf16_t*)(ws + WS_CQ), (const bf16_t*)(wd + WD_Q), 512, 512, 512, nullptr}; pg8::DenseOrder S; S.init(64, 6, 512, 512, P.G, cidl);
              { const float* sq = (const float*)(ws + WS_SSQQ) + (size_t)l * T * 8; fill_tab(P, S, [=](int row) { return rsqrtf(part_sum<8>(sq + (size_t)row * 8) * (1.0f / 512.0f) + EPS); }); }
              EpiQup E{(bf16_t*)(ws + WS_Q), (const f32x2*)(ws + WS_ROPE_MLA), (const LAS float*)(P.lds + TAB_OFF)}; pg8::gemm_phase<EpiQup, pg8::DenseOrder, false, true>(P.lds, g, S, E);
              if (P.G == 256 && cidl >= 128) convert_w13(P, ap, l, cidl - 128, 128, W13_SPLIT2, 64 * 256); }
            { PHASE_ENV; unsigned char* wd = ws + WS_WD + (size_t)l * WD_STRIDE;
              static_assert(WD_V == WD_K + 1024 * 256 * 2, "k/v weight blocks adjacent");
              pg8::Gemm g{(const bf16_t*)(ws + WS_CKV), (const bf16_t*)(wd + WD_K), 256, 256, 256, nullptr}; pg8::DenseOrder S; S.init(64, 8, 256, 256, P.G, cidl);
              { const float* sq = (const float*)(ws + WS_SSQKV) + (size_t)l * T * 4; fill_tab(P, S, [=](int row) { return rsqrtf(part_sum<4>(sq + (size_t)row * 4) * (1.0f / 256.0f) + EPS); }); }
              EpiScaleStore E{(const LAS float*)(P.lds + TAB_OFF), (bf16_t*)(ws + WS_KN), 1024, (bf16_t*)(ws + WS_V), 4}; pg8::gemm_phase<EpiScaleStore, pg8::DenseOrder, false, true>(P.lds, g, S, E); }
            { PHASE_ENV; dil_attn_phase(P); }
        }
        SEAML(p0 + 1);
        if (INL(2)) { { PHASE_ENV; mla_attn_phase(P); } { PHASE_ENV; dil_merge(P); } }
        SEAML(p0 + 2);
#ifdef DIAG_J
        if (blockIdx.x == 0 && threadIdx.x == 0) ((unsigned long long*)(args.ws + RT_TS))[p0 + 3 + 1] = __builtin_amdgcn_s_memtime();
#endif
        if (INL(4)) {
            PHASE_ENV; unsigned char* wd = ws + WS_WD + (size_t)l * WD_STRIDE;
            static_assert(WD_B == WD_A + 2 * MiB && WS_OB == WS_OA + 32 * MiB, "combined branch operands: [1024][1280] weights at WD_A, [T][1280] activations at WS_OA");
            pg8::Gemm g{(const bf16_t*)(ws + WS_OA), (const bf16_t*)(wd + WD_A), 1280, 1280, 1280, nullptr}; pg8::DenseOrder S; S.init(64, 4, 1280, 1280, P.G, cidl);
            EpiGateFused E{(const bf16_t*)(ws + WS_SG), (bf16_t*)(ws + WS_MERGED)}; pg8::gemm_phase<EpiGateFused, pg8::DenseOrder, false, false, false, true>(P.lds, g, S, E);
        }
        SEAML(p0 + 4);
        if (INL(5)) {
            PHASE_ENV; unsigned char* wd = ws + WS_WD + (size_t)l * WD_STRIDE;
            pg8::Gemm g{(const bf16_t*)(ws + WS_MERGED), (const bf16_t*)(wd + WD_O), 1024, 1024, 1024, nullptr}; pg8::DenseOrder S; S.init(64, 4, 1024, 1024, P.G, cidl);
            EpiResid<0> E{(bf16_t*)(ws + WS_XB), (float*)(ws + WS_SSQ2) + (size_t)l * T * 16, nullptr, (const bf16_t*)(ws + WS_XB), nullptr}; pg8::gemm_phase<EpiResid<0>, pg8::DenseOrder, false, false>(P.lds, g, S, E);
        }
        SEAML(p0 + 5);
        if (INL(6)) {
            PHASE_ENV; unsigned char* wd = ws + WS_WD + (size_t)l * WD_STRIDE;
            if (P.G == 256) { const int x = cidl & 7, j = cidl >> 3; cidl = j < 8 ? 8 * x + j : 64 + 24 * x + (j - 8); }
            pg8::Gemm g{(const bf16_t*)(ws + WS_XB), (const bf16_t*)(wd + WD_R), 1024, 1024, 1024, nullptr}; RouterFullOrder S{P.G, cidl};
            EpiRouter E{(float*)(ws + WS_RL)}; pg8::gemm_phase<EpiRouter, RouterFullOrder, false, false, true>(P.lds, g, S, E);
            dispatch1(P, S, (const float*)ap->in[14] + l * 8, (const float*)ap->in[16] + l * 64, l);
            if (P.G == 256) { if (cidl >= 64) convert_w2(P, ap, l, cidl - 64, 192, 0, W2_SPLIT); } else convert_w2(P, ap, l, cidl, P.G);
        }
        SEAM(p0 + 6);
#ifdef DIAG_J
        if (blockIdx.x == 0 && threadIdx.x == 0) ((unsigned long long*)(args.ws + RT_TS))[p0 + 7 + 1] = __builtin_amdgcn_s_memtime();
#endif
        if (INL(8)) { PHASE_ENV; dispatch2(P, l); if (P.G == 256 && P.vcu >= 64) convert_w2(P, ap, l, P.vcu - 64, 192, W2_SPLIT, 64 * 128); }
        SEAM(p0 + 8);
        if (INL(9)) {
            const int nblk = ((const int*)(args.ws + RT_BLK_E))[255];
            const int vb = gridDim.x == 256 ? (cid & 7) * 32 + (cid >> 3) : cid;
#pragma unroll 1
            for (int blk = vb; blk < nblk; blk += (int)gridDim.x) {
                { PHASE_ENV; pg8::Gemm g{(const bf16_t*)(ws + WS_XB), (const bf16_t*)(ws + WS_W13 + (size_t)(l & 1) * W13_STRIDE), 1024, 1024, 1024, (const int*)(ws + RT_ROW_TOK)}; BlockUnits<2> S{(const int*)(ws + RT_BLK_E), blk};
                  { const float* rr = (const float*)(ws + RT_ROW_RS); fill_tab(P, S, [=](int row) { return rr[row]; }); }
                  EpiExp1 E{(const LAS float*)(P.lds + TAB_OFF), (bf16_t*)(ws + WS_H)}; pg8::gemm_phase<EpiExp1, BlockUnits<2>, true, true>(P.lds, g, S, E); }
                VM_WAIT(); __syncthreads();
                { PHASE_ENV; pg8::Gemm g{(const bf16_t*)(ws + WS_H), (const bf16_t*)(ws + WS_W2), 256, 256, 256, nullptr}; BlockUnits<4> S{(const int*)(ws + RT_BLK_E), blk};
                  { const float* rw = (const float*)(ws + RT_ROW_W); fill_tab(P, S, [=](int row) { return rw[row]; }); }
                  EpiExp2 E{(const LAS float*)(P.lds + TAB_OFF), (bf16_t*)(ws + WS_YS)}; pg8::gemm_phase<EpiExp2, BlockUnits<4>, false, true>(P.lds, g, S, E); }
            }
            { PHASE_ENV; int vbl = vb; asm volatile("" : "+s"(vbl)); const int nidle = P.G > nblk ? P.G - nblk : 0; const int rank = nidle >= 32 ? (vbl >= nblk ? vbl - nblk : -1) : vbl, cnt = nidle >= 32 ? nidle : P.G;
              unsigned char* wd = ws + WS_WD + (size_t)l * WD_STRIDE;
              pg8::Gemm g{(const bf16_t*)(ws + WS_PB) + (size_t)l * T * 256, (const bf16_t*)(wd + WD_P), 256, 256, 256, nullptr}; PleProjRange S{rank, cnt};
              EpiScaleStore E{nullptr, (bf16_t*)(ws + WS_E), 1024, nullptr, 0}; pg8::gemm_phase<EpiScaleStore, PleProjRange, false, true>(P.lds, g, S, E);
              if (rank >= 0 && l + 1 < DEPTH) { convert_dense(P, ap, l + 1, rank, cnt); convert_p(P, ap, l + 1, rank, cnt); convert_w13(P, ap, l + 1, rank, cnt, 0, W13_EARLY); } }
        }
        SEAM(p0 + 9);
#ifdef DIAG_J
        if (blockIdx.x == 0 && threadIdx.x == 0) ((unsigned long long*)(args.ws + RT_TS))[p0 + 10 + 1] = __builtin_amdgcn_s_memtime();
#endif
        if (INL(11)) { PHASE_ENV; combine_norm(P); }
        SEAML(p0 + 11);
        if (INL(12)) {
            PHASE_ENV; unsigned char* wd = ws + WS_WD + (size_t)l * WD_STRIDE;
            pg8::Gemm g{(const bf16_t*)(ws + WS_XN), (const bf16_t*)(wd + WD_G), 1024, 1024, 1024, nullptr}; pg8::DenseOrder S; S.init(64, 4, 1024, 1024, P.G, cidl);
            { const float* rr = (const float*)(ws + RT_PLE_RS); fill_tab(P, S, [=](int row) { return rr[row]; }); }
            EpiResid<1> E{(bf16_t*)(ws + WS_XB), (float*)(ws + WS_SSQ1) + (size_t)(l + 1) * T * 16, (const bf16_t*)(ws + WS_E), (const bf16_t*)(ws + WS_XN), (const LAS float*)(P.lds + TAB_OFF)}; pg8::gemm_phase<EpiResid<1>, pg8::DenseOrder, false, false>(P.lds, g, S, E);
        }
        SEAML(p0 + 12);
    }
#ifdef DIAG_J
    { xcd_barrier(bar); PHASE_ENV; const unsigned long long* ts = (const unsigned long long*)(ws + RT_TS); unsigned long long tot = 0;
      if (DIAG_J < 0) tot = ts[1] - ts[0]; else if (DIAG_J >= 100) tot = ts[N_PHASES - 1] - ts[0]; else for (int l2 = 1; l2 < DEPTH; ++l2) tot += ts[2 + PH_PER_LAYER * l2 + DIAG_J] - ts[1 + PH_PER_LAYER * l2 + DIAG_J];
      const float t_us = (float)tot * 0.001f;
#ifndef DIAG_RES
#define DIAG_RES 3.0f
#endif
      const float q = floorf(log2f(fmaxf(t_us, 1.0f)) * DIAG_RES + DIAG_SHIFT);
#ifndef DIAG_OFF
#define DIAG_OFF 0.0f
#endif
      P.diag_scale = 1.0f + 0.01f * (q - DIAG_SHIFT + 0.5f - DIAG_OFF); final_norm(P, (const float*)ap->in[23]); }
#else
    if (IN(N_PHASES - 1)) { PHASE_ENV; final_norm(P, (const float*)ap->in[23]); }
#endif
#undef IN
#undef INL
#undef SEAM
#undef SEAML
}


#ifdef DUMP_MODE
__global__ void dump_kernel(unsigned char* ws, float* out) {
    const size_t N = (size_t)T * 1024;
    for (size_t i = blockIdx.x * (size_t)blockDim.x + threadIdx.x; i < N; i += (size_t)gridDim.x * blockDim.x) {
        float v = 0.f;
#if DUMP_MODE == 1
        const bf16_t* CQ = (const bf16_t*)(ws + WS_CQ); const bf16_t* CKV = (const bf16_t*)(ws + WS_CKV); const bf16_t* KPE = (const bf16_t*)(ws + WS_KPE);
        const bf16_t* DIL = (const bf16_t*)(ws + WS_DIL); const bf16_t* SG = (const bf16_t*)(ws + WS_SG);
        v = bf_lo(CQ[i % ((size_t)T * 512)]) + bf_lo(CKV[i % ((size_t)T * 256)]) + bf_lo(KPE[i % ((size_t)T * 32)]) + bf_lo(DIL[i]) + bf_lo(DIL[i + N]) + bf_lo(DIL[(i % ((size_t)T * 256)) + 2 * N]) + bf_lo(SG[i]) + bf_lo(SG[i + N]);
#elif DUMP_MODE == 2
        const bf16_t* Q = (const bf16_t*)(ws + WS_Q); const bf16_t* KN = (const bf16_t*)(ws + WS_KN); const bf16_t* V = (const bf16_t*)(ws + WS_V);
        v = bf_lo(Q[i]) + bf_lo(Q[(i % ((size_t)T * 512)) + N]) + bf_lo(KN[i]) + bf_lo(V[i]);
#elif DUMP_MODE == 4
        const bf16_t* W = (const bf16_t*)(ws + WS_WD); const bf16_t* XB = (const bf16_t*)(ws + WS_XB); const float* R1 = (const float*)(ws + WS_ROPE_MLA); const float* R2 = (const float*)(ws + WS_ROPE_DIL);
        const bf16_t* W13 = (const bf16_t*)(ws + WS_W13); const bf16_t* W2 = (const bf16_t*)(ws + WS_W2); const bf16_t* PB = (const bf16_t*)(ws + WS_PB); const float* S1 = (const float*)(ws + WS_SSQ1);
        v = bf_lo(XB[i]) + R1[i % ((size_t)T * 32)] + R2[i % ((size_t)T * 16)] + bf_lo(PB[i]) + S1[i % T] * 1e-3f;
        for (int l = 0; l < 4; ++l) { const bf16_t* wl = (const bf16_t*)(ws + WS_WD + (size_t)l * WD_STRIDE); v += bf_lo(wl[i % ((size_t)5152 * 1024)]) + bf_lo(wl[(WD_Q / 2) + (i % ((size_t)5242880))]);
            for (int k = 0; k < 2; ++k) v += bf_lo(W13[(size_t)l * (W13_STRIDE / 2) + k * N + i]) + bf_lo(W2[(size_t)l * (W2_STRIDE / 2) + (k * N + i) % ((size_t)16 * 1024 * 1024)]); }
        (void)W;
#elif DUMP_MODE == 5
        const bf16_t* Y = (const bf16_t*)(ws + WS_YS);
        { const size_t row = i / 1024, c = i % 1024; v = 0.f; for (int k = 0; k < 5; ++k) v += bf_lo(Y[row * 5376 + k * 1024 + c]); }
#elif DUMP_MODE == 6
        const bf16_t* SG = (const bf16_t*)(ws + WS_SG);
        v = bf_lo(SG[i]) + bf_lo(SG[i + N]);
#elif DUMP_MODE == 7
        const bf16_t* CQ = (const bf16_t*)(ws + WS_CQ); const bf16_t* CKV = (const bf16_t*)(ws + WS_CKV);
        v = bf_lo(CQ[i % ((size_t)T * 512)]) + bf_lo(CKV[i % ((size_t)T * 256)]);
#elif DUMP_MODE == 8
        const bf16_t* DIL = (const bf16_t*)(ws + WS_DIL);
        v = bf_lo(DIL[i]) + bf_lo(DIL[i + N]) + bf_lo(DIL[(i % ((size_t)T * 256)) + 2 * N]);
#elif DUMP_MODE == 3
        const bf16_t* OA = (const bf16_t*)(ws + WS_OA); const bf16_t* OB = (const bf16_t*)(ws + WS_OB);
        v = bf_lo(OA[i]) + bf_lo(OB[i % ((size_t)T * 256)]);
#endif
        out[i] = v;
    }
}
#endif
extern "C" void kernel_launch(void* const* d_in, const int* in_sizes, int n_in, void* d_out, int out_size, void* d_ws, size_t ws_size, hipStream_t stream) {
    static int grid = 0;
    if (grid == 0) {
        if (n_in != 24 || out_size != T * DM || ws_size < WS_END) { fprintf(stderr, "kernel_launch: unexpected shapes n_in %d out %d ws %zu\n", n_in, out_size, ws_size); grid = -1; return; }
        int dev = 0, cus = 0, per_cu = 0;
        if (hipGetDevice(&dev) != hipSuccess || hipDeviceGetAttribute(&cus, hipDeviceAttributeMultiprocessorCount, dev) != hipSuccess) { grid = -1; return; }
        if (hipFuncSetAttribute((const void*)fwd_kernel, hipFuncAttributeMaxDynamicSharedMemorySize, LDS_BYTES) != hipSuccess) { fprintf(stderr, "kernel_launch: hipFuncSetAttribute failed\n"); grid = -1; return; }
        if (hipOccupancyMaxActiveBlocksPerMultiprocessor(&per_cu, (const void*)fwd_kernel, NTHR, LDS_BYTES) != hipSuccess || per_cu < 1) fprintf(stderr, "kernel_launch: occupancy query says %d\n", per_cu);
        (void)hipGetLastError();
        grid = cus;
    }
    if (grid < 0) return;
    (void)hipMemsetAsync((char*)d_ws + WS_CTL, 0, CTL_ZERO_BYTES, stream);
    Args a{};
    for (int i = 0; i < 24; ++i) a.in[i] = d_in[i];
    a.out = (float*)d_out; a.ws = (unsigned char*)d_ws;
#if MK_PER_PHASE
#ifndef RUN_PHASES
#define RUN_PHASES N_PHASES
#endif
    for (int ph = 0; ph < RUN_PHASES; ++ph) { a.ph_lo = ph; a.ph_hi = ph + 1; hipLaunchKernelGGL(fwd_kernel, dim3(grid), dim3(NTHR), LDS_BYTES, stream, a); }
#ifdef DUMP_MODE
    hipLaunchKernelGGL(dump_kernel, dim3(1024), dim3(256), 0, stream, (unsigned char*)d_ws, (float*)d_out);
#endif
#else
    a.ph_lo = 0; a.ph_hi = N_PHASES; hipLaunchKernelGGL(fwd_kernel, dim3(grid), dim3(NTHR), LDS_BYTES, stream, a);
#endif
}
```
